# Optimizing an MI355X kernel written in HIP

```python
import math
import jax, jax.numpy as jnp
from jax import lax
import numpy as np

D_MODEL = 2048
BATCH = 2
SEQ = 16384
DEPTH = 1

ATT_Q_HEADS = 16
ATT_KV_HEADS = 2
ATT_HEAD_DIM = 64
WINDOW = 128
ATT_BLOCK = 128
ATT_Q_W = ATT_Q_HEADS * ATT_HEAD_DIM
ATT_KV_W = ATT_KV_HEADS * ATT_HEAD_DIM
ATT_QKV_W = ATT_Q_W + 2 * ATT_KV_W
REL_BUCKETS = 32
REL_MAX_DIST = 128
HGRN_HEADS = 8
HGRN_DK = 128
HGRN_DV = 128
HGRN_W = HGRN_HEADS * HGRN_DV
HGRN_CHUNK = 64
IN_COLS = ATT_QKV_W + 4 * HGRN_W + 2 * D_MODEL
MOE_GROUPS = 8
MOE_EXPERTS_PER_GROUP = 8
MOE_EXPERTS = MOE_GROUPS * MOE_EXPERTS_PER_GROUP
MOE_TOP_K = 2
MOE_HIDDEN = 512
MOE_BLOCK = 128
PLE_DIM = 256
EPS = 1e-6

kernel_name = 'hybrid_swa_hgrn2_hmoe_block'


def rms_norm(x, gain=None):
    xf = x.astype(jnp.float32)
    y = xf * lax.rsqrt(jnp.mean(xf * xf, axis=-1, keepdims=True) + EPS)
    if gain is not None:
        y = y * gain.astype(jnp.float32)
    return y.astype(x.dtype)


def t5_bucket(dist):
    exact = REL_BUCKETS // 2
    d = jnp.maximum(dist, 0)
    large = exact + (jnp.log(jnp.maximum(d, 1).astype(jnp.float32) / exact)
                     / math.log(REL_MAX_DIST / exact) * (REL_BUCKETS - exact)).astype(jnp.int32)
    large = jnp.minimum(large, REL_BUCKETS - 1)
    return jnp.where(d < exact, d, large)


def sliding_window_attention(q, k, v, sinks, rel_table):
    B, T = q.shape[0], q.shape[1]
    nb = T // ATT_BLOCK
    G = ATT_Q_HEADS // ATT_KV_HEADS
    f32 = jnp.float32
    qb = q.astype(f32).reshape(B, nb, ATT_BLOCK, ATT_KV_HEADS, G, ATT_HEAD_DIM) * (ATT_HEAD_DIM ** -0.5)

    def band(a):
        a = a.astype(f32).reshape(B, nb, ATT_BLOCK, ATT_KV_HEADS, ATT_HEAD_DIM)
        prev = jnp.pad(a[:, :-1], ((0, 0), (1, 0), (0, 0), (0, 0), (0, 0)))
        return jnp.concatenate([prev, a], axis=2)

    kb, vb = band(k), band(v)
    s = jnp.einsum('bnqkgd,bnskd->bnkgqs', qb, kb)
    qi = jnp.arange(ATT_BLOCK)[:, None]
    kj = jnp.arange(2 * ATT_BLOCK)[None, :]
    dist = qi + ATT_BLOCK - kj
    in_window = (dist >= 0) & (dist < WINDOW)
    bias = rel_table.astype(f32)[t5_bucket(dist)]
    bias = jnp.transpose(bias, (2, 0, 1)).reshape(ATT_KV_HEADS, G, ATT_BLOCK, 2 * ATT_BLOCK)
    not_pad = (jnp.arange(nb) > 0)[:, None, None] | (kj >= ATT_BLOCK)[None]
    valid = in_window[None] & not_pad
    s = jnp.where(valid[None, :, None, None], s + bias, -jnp.inf)
    sink = sinks.astype(f32).reshape(ATT_KV_HEADS, G)[..., None, None]
    m = jnp.maximum(jnp.max(s, axis=-1, keepdims=True), sink)
    pr = jnp.exp(s - m)
    denom = jnp.sum(pr, axis=-1, keepdims=True) + jnp.exp(sink - m)
    o = jnp.einsum('bnkgqs,bnskd->bnqkgd', pr / denom, vb)
    return o.reshape(B, T, ATT_Q_W).astype(q.dtype)


def hgrn2(q, f_raw, i, lower_bound):
    B, T = q.shape[0], q.shape[1]
    f32 = jnp.float32
    lb = lower_bound.astype(f32).reshape(HGRN_HEADS, HGRN_DK)
    f = lb + (1.0 - lb) * jax.nn.sigmoid(f_raw.astype(f32))
    k = 1.0 - f
    g = jnp.log(f)
    qs = jax.nn.silu(q.astype(f32))
    nc = T // HGRN_CHUNK

    def chunks(a):
        return a.reshape(B, nc, HGRN_CHUNK, HGRN_HEADS, a.shape[-1]).transpose(1, 0, 3, 2, 4)

    xs = (chunks(qs), chunks(k), chunks(i.astype(f32)), chunks(g))
    causal = jnp.tril(jnp.ones((HGRN_CHUNK, HGRN_CHUNK), dtype=bool))
    ref = HGRN_CHUNK // 2 - 1

    def step(S, inp):
        qc, kc, vc, gc = inp
        b = jnp.cumsum(gc, axis=-2)
        b_ref = b[..., ref:ref + 1, :]
        b_last = b[..., -1:, :]
        o_inter = jnp.einsum('bhtk,bhkv->bhtv', qc * jnp.exp(b), S)
        a = jnp.einsum('bhtk,bhsk->bhts', qc * jnp.exp(b - b_ref), kc * jnp.exp(b_ref - b))
        o_intra = jnp.einsum('bhts,bhsv->bhtv', jnp.where(causal, a, 0.0), vc)
        S = jnp.exp(b_last)[:, :, 0, :, None] * S + jnp.einsum('bhsk,bhsv->bhkv', kc * jnp.exp(b_last - b), vc)
        return S, o_inter + o_intra

    S0 = jnp.zeros((B, HGRN_HEADS, HGRN_DK, HGRN_DV), f32)
    _, o = lax.scan(step, S0, xs)
    return o.transpose(1, 0, 3, 2, 4).reshape(B, T, HGRN_HEADS, HGRN_DV)


def hier_moe(xn, w_coarse, b_coarse, w_fine, b_fine, w_gate, w_up, w_down):
    B, T, D = xn.shape
    n_tok = B * T
    f32 = jnp.float32
    xt = xn.reshape(n_tok, D)
    p_group = jax.nn.softmax((xt @ w_coarse + b_coarse).astype(f32), axis=-1)
    grp = jnp.argmax(p_group, axis=-1).astype(jnp.int32)
    p_sel = jnp.max(p_group, axis=-1)
    fine = (xt @ w_fine + b_fine).astype(f32).reshape(n_tok, MOE_GROUPS, MOE_EXPERTS_PER_GROUP)
    fine = jnp.take_along_axis(fine, grp[:, None, None], axis=1)[:, 0]
    top_v, top_i = lax.top_k(fine, MOE_TOP_K)
    wts = p_sel[:, None] * jax.nn.softmax(top_v, axis=-1)
    expert = grp[:, None] * MOE_EXPERTS_PER_GROUP + top_i.astype(jnp.int32)
    n_asg = n_tok * MOE_TOP_K
    flat_e = expert.reshape(-1)
    flat_t = jnp.repeat(jnp.arange(n_tok, dtype=jnp.int32), MOE_TOP_K)
    flat_w = wts.reshape(-1)
    order = jnp.argsort(flat_e)
    se = flat_e[order]
    counts = jnp.bincount(flat_e, length=MOE_EXPERTS)
    padded = (counts + MOE_BLOCK - 1) // MOE_BLOCK * MOE_BLOCK
    start = jnp.cumsum(counts) - counts
    pad_end = jnp.cumsum(padded)
    pad_start = pad_end - padded
    dest = pad_start[se] + jnp.arange(n_asg, dtype=jnp.int32) - start[se]
    cap = n_asg + MOE_EXPERTS * MOE_BLOCK
    nblk = cap // MOE_BLOCK
    buf_t = jnp.zeros((cap,), jnp.int32).at[dest].set(flat_t[order])
    buf_w = jnp.zeros((cap,), f32).at[dest].set(flat_w[order])
    blk_e = jnp.minimum(jnp.searchsorted(pad_end, jnp.arange(nblk) * MOE_BLOCK, side='right'),
                        MOE_EXPERTS - 1).astype(jnp.int32)

    def run_block(args):
        tok, e, wt = args
        xb = xt[tok]
        hid = jax.nn.silu(xb @ w_gate[e]) * (xb @ w_up[e])
        return ((hid @ w_down[e]) * wt[:, None]).astype(xt.dtype)

    y = lax.map(run_block, (buf_t.reshape(nblk, MOE_BLOCK), blk_e, buf_w.reshape(nblk, MOE_BLOCK)))
    out = jnp.zeros_like(xt).at[buf_t].add(y.reshape(cap, D))
    return out.reshape(B, T, D)


def setup_inputs(seed: int = 0) -> dict:
    key = jax.random.key(seed)
    ks = jax.random.split(key, 24)
    f32 = jnp.float32
    nrm = lambda k, shape, s: (jax.random.normal(k, shape, f32) * s).astype(f32)
    gain = lambda k, shape: 1.0 + 0.05 * jax.random.normal(k, shape, f32)
    D = D_MODEL
    return {
        'x': nrm(ks[0], (BATCH, SEQ, D), 1.0),
        'p': nrm(ks[1], (DEPTH, BATCH, SEQ, PLE_DIM), 1.0),
        'g_mix': gain(ks[2], (DEPTH, D)),
        'w_in': nrm(ks[3], (DEPTH, D, IN_COLS), D ** -0.5),
        'b_qkv': nrm(ks[4], (DEPTH, ATT_QKV_W), 0.02),
        'sinks': nrm(ks[5], (DEPTH, ATT_Q_HEADS), 1.0),
        'rel_bias': nrm(ks[6], (REL_BUCKETS, ATT_Q_HEADS), 0.5),
        'lb_logits': nrm(ks[7], (DEPTH + 1, HGRN_HEADS * HGRN_DK), 0.5),
        'g_hgrn': gain(ks[8], (DEPTH, HGRN_DV)),
        'w_up_att': nrm(ks[9], (DEPTH, ATT_Q_W, D), ATT_Q_W ** -0.5),
        'w_up_rec': nrm(ks[10], (DEPTH, HGRN_W, D), HGRN_W ** -0.5),
        'w_out': nrm(ks[11], (DEPTH, D, D), D ** -0.5),
        'g_ffn': gain(ks[12], (DEPTH, D)),
        'w_coarse': nrm(ks[13], (DEPTH, D, MOE_GROUPS), D ** -0.5),
        'b_coarse': nrm(ks[14], (DEPTH, MOE_GROUPS), 0.01),
        'w_fine': nrm(ks[15], (DEPTH, D, MOE_EXPERTS), D ** -0.5),
        'b_fine': nrm(ks[16], (DEPTH, MOE_EXPERTS), 0.01),
        'w_gate': nrm(ks[17], (DEPTH, MOE_EXPERTS, D, MOE_HIDDEN), D ** -0.5),
        'w_up': nrm(ks[18], (DEPTH, MOE_EXPERTS, D, MOE_HIDDEN), D ** -0.5),
        'w_down': nrm(ks[19], (DEPTH, MOE_EXPERTS, MOE_HIDDEN, D), MOE_HIDDEN ** -0.5),
        'w_ple_in': nrm(ks[20], (DEPTH, PLE_DIM, D), PLE_DIM ** -0.5),
        'g_ple': gain(ks[21], (DEPTH, D)),
        'w_ple_gate': nrm(ks[22], (DEPTH, D, D), D ** -0.5),
        'g_final': gain(ks[23], (D,)),
    }


def reference(x, p, g_mix, w_in, b_qkv, sinks, rel_bias, lb_logits, g_hgrn, w_up_att, w_up_rec,
              w_out, g_ffn, w_coarse, b_coarse, w_fine, b_fine, w_gate, w_up, w_down,
              w_ple_in, g_ple, w_ple_gate, g_final):
    B, T = x.shape[0], x.shape[1]
    lower_bounds = jnp.cumsum(jax.nn.softmax(lb_logits.astype(jnp.float32), axis=0), axis=0)
    h = x
    for layer in range(DEPTH):
        u = rms_norm(h, g_mix[layer])
        z = u @ w_in[layer]
        qkv = z[..., :ATT_QKV_W] + b_qkv[layer]
        qa = qkv[..., :ATT_Q_W].reshape(B, T, ATT_Q_HEADS, ATT_HEAD_DIM)
        ka = qkv[..., ATT_Q_W:ATT_Q_W + ATT_KV_W].reshape(B, T, ATT_KV_HEADS, ATT_HEAD_DIM)
        va = qkv[..., ATT_Q_W + ATT_KV_W:].reshape(B, T, ATT_KV_HEADS, ATT_HEAD_DIM)
        off = ATT_QKV_W
        qr, fr, ir, gr = [z[..., off + j * HGRN_W: off + (j + 1) * HGRN_W].reshape(B, T, HGRN_HEADS, HGRN_DV)
                          for j in range(4)]
        off2 = off + 4 * HGRN_W
        gate_att = jax.nn.sigmoid(z[..., off2:off2 + D_MODEL])
        gate_rec = jax.nn.sigmoid(z[..., off2 + D_MODEL:])
        y_att = sliding_window_attention(qa, ka, va, sinks[layer], rel_bias) @ w_up_att[layer]
        o_rec = hgrn2(qr, fr, ir, lower_bounds[layer])
        o_rec = rms_norm(o_rec, g_hgrn[layer]) * jax.nn.silu(gr.astype(jnp.float32))
        y_rec = o_rec.reshape(B, T, HGRN_W).astype(h.dtype) @ w_up_rec[layer]
        h = h + (gate_att * y_att + gate_rec * y_rec) @ w_out[layer]
        h = h + hier_moe(rms_norm(h, g_ffn[layer]), w_coarse[layer], b_coarse[layer], w_fine[layer],
                         b_fine[layer], w_gate[layer], w_up[layer], w_down[layer])
        ple = rms_norm(p[layer] @ w_ple_in[layer], g_ple[layer])
        h = h + ple * jax.nn.sigmoid(rms_norm(h) @ w_ple_gate[layer])
    return rms_norm(h, g_final)
```

```cpp
#include <hip/hip_runtime.h>
#include <cstdio>
#include <cstdint>

#define GAS __attribute__((address_space(1)))
#define LAS __attribute__((address_space(3)))
typedef unsigned short bf16;
typedef float f32x4 __attribute__((ext_vector_type(4)));
typedef unsigned v4u __attribute__((ext_vector_type(4)));
typedef unsigned v2u __attribute__((ext_vector_type(2)));

constexpr int NTOK = 32768, SEQ = 16384, D = 2048;
constexpr int QW = 1024, KVW = 128, QKVW = 1280, HW = 1024, INC = 9472;
constexpr int NEXP = 64, MH = 512, PLE = 256;
constexpr float EPS = 1e-6f;
constexpr int NWAVES = 8, NTHR = 512;
constexpr size_t HGPS = (size_t)NTOK * 128;
constexpr int HIDCAP = 81920;

constexpr size_t MiB = 1u << 20;
constexpr size_t WS_CTL = 0, CTL_ZERO_BYTES = 1 * MiB;
constexpr size_t WS_SMALL = 1 * MiB;
constexpr size_t WS_LIST = 2 * MiB;
constexpr size_t WS_WIN = 8 * MiB, WS_WUA = 45 * MiB, WS_WUR = 49 * MiB, WS_WOUT = 53 * MiB, WS_WPG = 61 * MiB, WS_WPI = 69 * MiB;
constexpr size_t WS_RA = 70 * MiB;
constexpr size_t WS_RB = 198 * MiB;
constexpr size_t WS_RC = 278 * MiB;
constexpr size_t WS_RD = 534 * MiB;
constexpr size_t WS_RE = 790 * MiB;
constexpr size_t WS_PB = 1046 * MiB;
constexpr size_t WS_SS = 1062 * MiB;
constexpr size_t WS_END = 1074 * MiB;
constexpr int CW_BAR = 4096;
constexpr int CW_CNT = 16384;
constexpr int CW_PACE = 32768;

__device__ __forceinline__ float bf2f(bf16 h) { return __uint_as_float(((unsigned)h) << 16); }
__device__ __forceinline__ unsigned f2bf(float f) { unsigned u = __float_as_uint(f); return (u + 0x7fffu + ((u >> 16) & 1u)) >> 16; }
__device__ __forceinline__ unsigned pk2(float lo, float hi) { return f2bf(lo) | (f2bf(hi) << 16); }
constexpr float LOG2E = 1.4426950408889634f;
__device__ __forceinline__ float fexp2(float x) { return __builtin_amdgcn_exp2f(x); }
__device__ __forceinline__ float fexp(float x) { return __builtin_amdgcn_exp2f(x * LOG2E); }
__device__ __forceinline__ float flog2(float x) { return __builtin_amdgcn_logf(x); }
__device__ __forceinline__ float wave_sum(float v) {
#pragma unroll
    for (int o = 1; o < 64; o <<= 1) v += __shfl_xor(v, o);
    return v;
}

#define XB_TMO      128
#define XB_XCNT(j)  (256  + 64 * (j))
#define XB_XSUB(j)  (1280 + 64 * (j))
#define XB_XGEN(j)  (2304 + 64 * (j))
#define XB_TOP      3328
#define XB_TOPGEN   3392
#define XCD_BAR_WORDS 3456
#define XB_SPIN_CAP (1u << 23)
__device__ __forceinline__ unsigned xb_ld(unsigned* p)              { return __hip_atomic_load(p, __ATOMIC_RELAXED, __HIP_MEMORY_SCOPE_AGENT); }
__device__ __forceinline__ unsigned xb_add(unsigned* p, unsigned v) { return __hip_atomic_fetch_add(p, v, __ATOMIC_RELAXED, __HIP_MEMORY_SCOPE_AGENT); }
__device__ __forceinline__ unsigned xb_xcc_id() { return (unsigned)__builtin_amdgcn_s_getreg((3 << 11) | 20) & 0xFu; }
#define XB_SPIN(cond, bar) do { unsigned _sp = 0; while (cond) { __builtin_amdgcn_s_sleep(1); \
    if ((++_sp & 255u) == 0u) { if (xb_ld(&(bar)[XB_TMO])) break; if (_sp > XB_SPIN_CAP) { atomicAdd(&(bar)[XB_TMO], 1u); break; } } } } while (0)
struct XcdBarrier { unsigned* bar; unsigned x; volatile LAS unsigned* st; };
__device__ __forceinline__ XcdBarrier xcd_barrier_post(unsigned* bar, volatile LAS unsigned* st, const int tid) {
    XcdBarrier b; b.bar = bar; b.x = xb_xcc_id(); b.st = st;
    if (tid == 0) (void)xb_add(&bar[XB_XCNT(b.x)], 1u);
    return b;
}
__device__ __forceinline__ void xcd_barrier_complete(unsigned* bar, unsigned x, unsigned& nloc, unsigned& nx) {
    const unsigned G = gridDim.x * gridDim.y * gridDim.z;
    unsigned sum, cnt, mine, sp = 0u;
    for (;;) {
        sum = 0u; cnt = 0u; mine = 0u;
#pragma unroll
        for (unsigned j = 0; j < 16; ++j) { const unsigned c = xb_ld(&bar[XB_XCNT(j)]); sum += c; cnt += (c > 0u) ? 1u : 0u; mine = (j == x) ? c : mine; }
        if (sum == G) break;
        __builtin_amdgcn_s_sleep(1);
        if ((++sp & 255u) == 0u) { if (xb_ld(&bar[XB_TMO])) break; if (sp > XB_SPIN_CAP) { atomicAdd(&bar[XB_TMO], 1u); break; } }
    }
    nloc = mine > 0u ? mine : 1u; nx = cnt > 0u ? cnt : 1u;
}
__device__ __forceinline__ void xcd_barrier(const XcdBarrier& b, const int tid) {
    asm volatile("s_waitcnt vmcnt(0)" ::: "memory");
    __syncthreads();
    if (tid == 0) {
        unsigned* bar = b.bar;
        __builtin_amdgcn_s_waitcnt(0);
        unsigned nloc = b.st[0], nx = b.st[1];
        if (nloc == 0u) { xcd_barrier_complete(bar, b.x, nloc, nx); b.st[0] = nloc; b.st[1] = nx; }
        const unsigned old = xb_add(&bar[XB_XSUB(b.x)], 1u);
        const unsigned gen = old / nloc;
        if (old + 1u == (gen + 1u) * nloc) {
            __builtin_amdgcn_fence(__ATOMIC_RELEASE, "agent");
            asm volatile("s_waitcnt vmcnt(0)" ::: "memory");
            const unsigned og = xb_add(&bar[XB_TOP], 1u);
            const unsigned tg = og / nx;
            if (og + 1u == (tg + 1u) * nx) xb_add(&bar[XB_TOPGEN], 1u);
            else XB_SPIN(xb_ld(&bar[XB_TOPGEN]) == tg, bar);
            __builtin_amdgcn_fence(__ATOMIC_ACQUIRE, "agent");
            xb_add(&bar[XB_XGEN(b.x)], 1u);
            asm volatile("s_waitcnt vmcnt(0)" ::: "memory");
        } else {
            XB_SPIN(xb_ld(&bar[XB_XGEN(b.x)]) == gen, bar);
            __builtin_amdgcn_fence(__ATOMIC_ACQUIRE, "agent");
            asm volatile("s_waitcnt vmcnt(0)" ::: "memory");
        }
    }
    __syncthreads();
}

struct Args {
    const float* in[24];
    float* out;
    unsigned char* ws;
};
enum { I_X = 0, I_P, I_GMIX, I_WIN, I_BQKV, I_SINKS, I_REL, I_LBL, I_GHGRN, I_WUA, I_WUR, I_WOUT, I_GFFN, I_WCO, I_BCO, I_WFI, I_BFI,
       I_WG, I_WU, I_WD, I_WPI, I_GPLE, I_WPG, I_GFIN };

__device__ __forceinline__ void transpose_item(const float* W, int K, int N, bf16* WT, LAS float* scr, int item, int lane, int gu, int ldw, const float* ks = nullptr) {
    const int nblk = N / 32, kb = item / nblk, nb = item % nblk, k0 = 64 * kb, n0 = 32 * nb;
    const int d0 = gu ? (256 * (n0 >> 7) + 128 * (gu - 1) + (n0 & 127)) : n0;
#pragma unroll 8
    for (int i = 0; i < 32; ++i) { const int kk = 2 * i + (lane >> 5); scr[kk * 33 + (lane & 31)] = __builtin_nontemporal_load(W + (size_t)(k0 + kk) * N + n0 + (lane & 31)); }
    asm volatile("s_waitcnt lgkmcnt(0)" ::: "memory");
    const int c = lane & 7;
    f32x4 k0s = (f32x4){1.f, 1.f, 1.f, 1.f}, k1s = k0s; if (ks) { k0s = *(const f32x4*)(ks + k0 + 8 * c); k1s = *(const f32x4*)(ks + k0 + 8 * c + 4); }
#pragma unroll
    for (int j = 0; j < 4; ++j) { const int n = (lane >> 3) + 8 * j; const LAS float* s = scr + (8 * c) * 33 + n;
        v4u o; o.x = pk2(s[0 * 33] * k0s[0], s[1 * 33] * k0s[1]); o.y = pk2(s[2 * 33] * k0s[2], s[3 * 33] * k0s[3]); o.z = pk2(s[4 * 33] * k1s[0], s[5 * 33] * k1s[1]); o.w = pk2(s[6 * 33] * k1s[2], s[7 * 33] * k1s[3]);
        *(v4u*)(WT + (size_t)(d0 + n) * ldw + k0 + 8 * c) = o; }
    asm volatile("s_waitcnt lgkmcnt(0)" ::: "memory");
}
__device__ __forceinline__ void transpose_all(const float* W, int K, int N, bf16* WT, LAS float* scr, int gw, int ngw, int lane, int ldw) {
    const int nitems = (K / 64) * (N / 32);
    for (int it = gw; it < nitems; it += ngw) transpose_item(W, K, N, WT, scr, it, lane, 0, ldw);
}

namespace pg8 {
typedef short bf16x8 __attribute__((ext_vector_type(8)));
typedef unsigned u32x4 __attribute__((ext_vector_type(4)));
constexpr int BM = 256, BK = 64, HALF = 128, HTB = HALF * BK * 2, STAGE_BYTES = 8 * HTB, NXCD = 8, WGM = 8;
__host__ __device__ __forceinline__ int lds_byte(int r, int c) { const int st = (r >> 4) * 2 + (c >> 5), rr = r & 15, cc = c & 31, ob = rr * 64 + cc * 2; return st * 1024 + (ob ^ (((ob >> 9) & 1) << 5)); }
__host__ __device__ __forceinline__ void stage_rc(int b, int& R, int& C) { const int st = b / 1024, sb = b % 1024, swz = sb ^ (((sb >> 9) & 1) << 5); R = (st >> 1) * 16 + swz / 64; C = (st & 1) * 32 + (swz % 64) / 2; }
__host__ __device__ __forceinline__ int perm32(int rho) { const int n = rho >> 4, i = rho & 15; return 8 * (i >> 2) + 4 * n + (i & 3); }
struct Unit { int pm, pn; const char* a; const char* b; int e, r0, cnt, row0; };
typedef __bf16 bfv2_t __attribute__((ext_vector_type(2))); typedef float fv2_t __attribute__((ext_vector_type(2)));
__device__ __forceinline__ unsigned cvt_pk_bf16(float lo, float hi) { fv2_t v; v.x = lo; v.y = hi; return __builtin_bit_cast(unsigned, __builtin_convertvector(v, bfv2_t)); }

struct StaticOrder {
    int nM, nN, nwg, G, c; const char* A; const char* Bt; size_t tstepA, tstepB;
    __device__ __forceinline__ void init(const bf16* A_, const bf16* Bt_, int M, int N, int lda, int ldb, int G_, int c_) { nM = M / BM; nN = N / BM; nwg = nM * nN; G = G_; c = c_; A = (const char*)A_; Bt = (const char*)Bt_; tstepA = (size_t)BM * lda * 2; tstepB = (size_t)BM * ldb * 2; pace = nullptr; }
    __device__ __forceinline__ bool next(int i, Unit& u) const {
        const long L = (long)i * G + c; if (L >= nwg) return false;
        int wgid = (int)L; { const int q = nwg / NXCD, r = nwg % NXCD, xcd = wgid % NXCD, off = wgid / NXCD; wgid = (xcd < r ? xcd * (q + 1) : r * (q + 1) + (xcd - r) * q) + off; }
        const int nig = WGM * nN, gid = wgid / nig, fm = gid * WGM, gsz = (nM - fm) < WGM ? (nM - fm) : WGM;
        u.pm = fm + ((wgid % nig) % gsz); u.pn = (wgid % nig) / gsz; u.a = A + (size_t)u.pm * tstepA; u.b = Bt + (size_t)u.pn * tstepB; u.e = 0; u.r0 = 0; u.cnt = 0; u.row0 = 0; return true;
    }
    __device__ __forceinline__ unsigned row_off(const Unit&, int) const { return 0u; }
    unsigned* pace;
    __device__ __forceinline__ void pace_arrive_wait(int ui, int wid, int lane) const {
        if (pace == nullptr || wid != 0) return;
        unsigned* p = pace + 64 * (c & 7);
        if (lane == 0) __hip_atomic_fetch_add(p, 1u, __ATOMIC_RELAXED, __HIP_MEMORY_SCOPE_AGENT);
        const unsigned want = (unsigned)(G >> 3) * (unsigned)(ui + 1);
        for (int sp = 0; sp < 4096; ++sp) { if (__hip_atomic_load(p, __ATOMIC_RELAXED, __HIP_MEMORY_SCOPE_AGENT) >= want) break; __builtin_amdgcn_s_sleep(2); }
    }
    __device__ __forceinline__ void pace_finish(int units_done, int wid, int lane) const {
        if (pace == nullptr || wid != 0 || lane != 0) return;
        const int rmax = (nwg + G - 1) / G;
        if (units_done < rmax) __hip_atomic_fetch_add(pace + 64 * (c & 7), (unsigned)(rmax - units_done), __ATOMIC_RELAXED, __HIP_MEMORY_SCOPE_AGENT);
    }
};

struct PairOrder {
    StaticOrder s0; const char* A1; const char* B1;
    __device__ __forceinline__ bool next(int i, Unit& u) const {
        if (!s0.next(i >> 1, u)) return false;
        if (i & 1) { u.a = A1 + (size_t)u.pm * s0.tstepA; u.b = B1 + (size_t)u.pn * s0.tstepB; u.e = 1; }
        return true;
    }
    __device__ __forceinline__ unsigned row_off(const Unit&, int) const { return 0u; }
    __device__ __forceinline__ void pace_arrive_wait(int, int, int) const {}
    __device__ __forceinline__ void pace_finish(int, int, int) const {}
};

template <class Epi, class Sched, bool ALIGN_EPI, bool GATHER, int AIMG = 0>
__device__ __forceinline__ void gemm_phase(LAS unsigned char* lds, const int K, const int lda, const int ldb, const Sched& S, const Epi& E, const int tid) {
    const int wid = __builtin_amdgcn_readfirstlane(tid >> 6), lane = tid & 63, wr = wid >> 2, wc = wid & 3, fr = lane & 15, fq = lane >> 4;
    const int nt = K / BK;
    int Rr[2], Cc[2];
    unsigned voffA[2][2], voffB[2][2], voffAn[2][2];
#pragma unroll
    for (int i = 0; i < 2; ++i) { stage_rc(tid * 16 + i * 8192, Rr[i], Cc[i]); const int Rb = Epi::PERM ? ((Rr[i] & ~31) + perm32(Rr[i] & 31)) : Rr[i];
#pragma unroll
        for (int h = 0; h < 2; ++h) { voffB[h][i] = (unsigned)((h * HALF + Rb) * ldb + Cc[i]) * 2u; voffA[h][i] = (unsigned)((h * HALF + Rr[i]) * lda + Cc[i]) * 2u;
            if (AIMG) { const int R = Rr[i], C = Cc[i]; voffA[h][i] = (unsigned)(((h * 4 + ((R >> 4) & 3)) * 2) * 8192 + (((R >> 6) & 1) * 4 + (C >> 5)) * 1024 + ((((C >> 3) & 3) * 16) + (R & 15)) * 16); }
            voffAn[h][i] = voffA[h][i]; } }
    const size_t kstep = (size_t)(BK * 2);
#define PG8_AOFF(t_) (AIMG ? ((size_t)((t_) >> 2) * 131072 + (size_t)(((t_) >> 1) & 1) * 8192 + (size_t)((t_) & 1) * 2048) : (size_t)(t_) * kstep)
    const unsigned ldsw = (unsigned)wid * 1024u;
    const int aoff = lds_byte(wr * 64 + fr, fq * 8), boff = lds_byte(wc * 32 + fr, fq * 8);
#define PG8_SA(b, h) (((b) * 2 + (h)) * HTB)
#define PG8_SB(b, h) ((4 + (b) * 2 + (h)) * HTB)
#define PG8_STAGE(bufoff, gbase, voff) do { const char* _gb = (const char*)(gbase); asm volatile("" : "+s"(_gb));     \
        _Pragma("unroll") for (int _i = 0; _i < 2; ++_i) \
        __builtin_amdgcn_global_load_lds((const unsigned*)(_gb + (voff)[_i]), (LAS unsigned*)(lds + (bufoff) + ldsw + _i * 8192), 16, 0, 0); } while (0)
#define PG8_LDA(dst, b, h) do { _Pragma("unroll") for (int m = 0; m < 4; ++m) _Pragma("unroll") for (int k = 0; k < 2; ++k) dst[m][k] = *(const LAS bf16x8*)(lds + PG8_SA(b, h) + aoff + m * 2048 + k * 1024); } while (0)
#define PG8_LDB(dst, b, h) do { _Pragma("unroll") for (int n = 0; n < 2; ++n) _Pragma("unroll") for (int k = 0; k < 2; ++k) dst[n][k] = *(const LAS bf16x8*)(lds + PG8_SB(b, h) + boff + n * 2048 + k * 1024); } while (0)
#define PG8_MMA(ai, bj, At, Bt) do { __builtin_amdgcn_s_setprio(1); _Pragma("unroll") for (int m = 0; m < 4; ++m) _Pragma("unroll") for (int n = 0; n < 2; ++n) _Pragma("unroll") for (int k = 0; k < 2; ++k) \
        acc[ai][bj][m][n] = __builtin_amdgcn_mfma_f32_16x16x32_bf16(Bt[n][k], At[m][k], acc[ai][bj][m][n], 0, 0, 0); __builtin_amdgcn_s_setprio(0); } while (0)
#define PG8_WAIT_V(n) asm volatile("s_waitcnt vmcnt(" #n ")" ::: "memory")
#define PG8_WAIT_L(n) asm volatile("s_waitcnt lgkmcnt(" #n ")" ::: "memory")
#define PG8_BAR __builtin_amdgcn_s_barrier()
#define PG8_SCHED __builtin_amdgcn_sched_barrier(0)
    Unit cur, nxt; int ui = 0;
    if (!S.next(0, cur)) return;
    if constexpr (GATHER) {
#pragma unroll
        for (int h = 0; h < 2; ++h)
#pragma unroll
            for (int i = 0; i < 2; ++i) voffA[h][i] = S.row_off(cur, h * HALF + Rr[i]) + (unsigned)Cc[i] * 2u;
    }
    f32x4 acc[2][2][4][2];
#pragma unroll
    for (int a = 0; a < 2; ++a)
#pragma unroll
        for (int b = 0; b < 2; ++b)
#pragma unroll
            for (int m = 0; m < 4; ++m)
#pragma unroll
                for (int n = 0; n < 2; ++n) acc[a][b][m][n] = (f32x4){0.f, 0.f, 0.f, 0.f};
    bf16x8 At[4][2], B0[2][2], B1[2][2];
    const char* cA = cur.a; const char* cB = cur.b;
    PG8_STAGE(PG8_SB(0, 0), cB, voffB[0]); PG8_STAGE(PG8_SB(0, 1), cB, voffB[1]); PG8_STAGE(PG8_SA(0, 0), cA, voffA[0]); PG8_STAGE(PG8_SA(0, 1), cA, voffA[1]);
    if (wr == 1) PG8_BAR;
    PG8_WAIT_V(2); PG8_BAR;
    PG8_STAGE(PG8_SB(1, 0), cB + kstep, voffB[0]); PG8_STAGE(PG8_SA(1, 0), cA + PG8_AOFF(1), voffA[0]); PG8_STAGE(PG8_SB(1, 1), cB + kstep, voffB[1]);
    PG8_WAIT_V(6); PG8_BAR;
    for (;;) {
        const bool has_next = S.next(ui + 1, nxt);
        const char* nA = has_next ? nxt.a : cA; const char* nB = has_next ? nxt.b : cB;
        if constexpr (GATHER) {
#pragma unroll
            for (int h = 0; h < 2; ++h)
#pragma unroll
                for (int i = 0; i < 2; ++i) voffAn[h][i] = has_next ? S.row_off(nxt, h * HALF + Rr[i]) + (unsigned)Cc[i] * 2u : voffA[h][i];
        }
        for (int t = 0; t < nt; t += 2) {
            const bool last = (t == nt - 2);
            if (last) S.pace_arrive_wait(ui, wid, lane);
            const char* a1 = cA + PG8_AOFF(t + 1);
            const char* a2 = last ? nA : cA + PG8_AOFF(t + 2); const char* b2 = last ? nB : cB + (size_t)(t + 2) * kstep;
            const char* a3 = last ? nA + PG8_AOFF(1) : cA + PG8_AOFF(t + 3); const char* b3 = b2 + kstep;
            PG8_LDB(B0, 0, 0); PG8_LDB(B1, 0, 1); PG8_SCHED; PG8_LDA(At, 0, 0); PG8_STAGE(PG8_SA(1, 1), a1, voffA[1]);
            if constexpr (GATHER) { if (last) {
#pragma unroll
                for (int h = 0; h < 2; ++h)
#pragma unroll
                    for (int i = 0; i < 2; ++i) voffA[h][i] = voffAn[h][i]; } }
            PG8_WAIT_V(8); PG8_WAIT_L(0); PG8_BAR; PG8_MMA(0, 0, At, B0); PG8_MMA(0, 1, At, B1); PG8_BAR; PG8_SCHED;
            PG8_LDA(At, 0, 1); PG8_STAGE(PG8_SB(0, 0), b2, voffB[0]); PG8_STAGE(PG8_SB(0, 1), b2, voffB[1]); PG8_STAGE(PG8_SA(0, 0), a2, voffA[0]);
            PG8_WAIT_V(8); PG8_WAIT_L(0); PG8_BAR; PG8_MMA(1, 0, At, B0); PG8_MMA(1, 1, At, B1); PG8_BAR; PG8_SCHED;
            PG8_LDB(B0, 1, 0); PG8_LDB(B1, 1, 1); PG8_SCHED; PG8_LDA(At, 1, 0); PG8_STAGE(PG8_SA(0, 1), a2, voffA[1]);
            PG8_WAIT_V(8); PG8_WAIT_L(0); PG8_BAR; PG8_MMA(0, 0, At, B0); PG8_MMA(0, 1, At, B1); PG8_BAR; PG8_SCHED;
            PG8_LDA(At, 1, 1); PG8_STAGE(PG8_SB(1, 0), b3, voffB[0]); PG8_STAGE(PG8_SB(1, 1), b3, voffB[1]); PG8_STAGE(PG8_SA(1, 0), a3, voffA[0]);
            PG8_WAIT_V(8); PG8_WAIT_L(0); PG8_BAR; PG8_MMA(1, 0, At, B0); PG8_MMA(1, 1, At, B1); PG8_BAR; PG8_SCHED;
        }
        if constexpr (ALIGN_EPI) { if (wr == 0) PG8_BAR; }
        E(acc, cur, wr, wc, fr, fq);
        if (!has_next) { S.pace_finish(ui + 1, wid, lane); break; }
#pragma unroll
        for (int a = 0; a < 2; ++a)
#pragma unroll
            for (int b = 0; b < 2; ++b)
#pragma unroll
                for (int m = 0; m < 4; ++m)
#pragma unroll
                    for (int n = 0; n < 2; ++n) acc[a][b][m][n] = (f32x4){0.f, 0.f, 0.f, 0.f};
        cur = nxt; cA = nA; cB = nB; ++ui;
        if constexpr (ALIGN_EPI) { if (wr == 1) PG8_BAR; }
    }
    PG8_WAIT_V(0);
    if constexpr (!ALIGN_EPI) { if (wr == 0) PG8_BAR; }
    PG8_BAR;
#undef PG8_AOFF
#undef PG8_SA
#undef PG8_SB
#undef PG8_STAGE
#undef PG8_LDA
#undef PG8_LDB
#undef PG8_MMA
#undef PG8_WAIT_V
#undef PG8_WAIT_L
#undef PG8_BAR
#undef PG8_SCHED
}

__device__ __forceinline__ float fsig(float x) { return __builtin_amdgcn_rcpf(1.f + fexp2(x * -LOG2E)); }
__device__ __forceinline__ u32x4 pack8(const f32x4 a, const f32x4 b) { u32x4 w; w.x = cvt_pk_bf16(a[0], a[1]); w.y = cvt_pk_bf16(a[2], a[3]); w.z = cvt_pk_bf16(b[0], b[1]); w.w = cvt_pk_bf16(b[2], b[3]); return w; }
__device__ __forceinline__ void unpack8(const u32x4 w, f32x4& a, f32x4& b) {
    a[0] = __uint_as_float(w.x << 16); a[1] = __uint_as_float(w.x & 0xffff0000u); a[2] = __uint_as_float(w.y << 16); a[3] = __uint_as_float(w.y & 0xffff0000u);
    b[0] = __uint_as_float(w.z << 16); b[1] = __uint_as_float(w.z & 0xffff0000u); b[2] = __uint_as_float(w.w << 16); b[3] = __uint_as_float(w.w & 0xffff0000u); }

template <int MODE>
__device__ __forceinline__ void epiz_body(const f32x4 (&acc)[2][2][4][2], bf16* base, const int ldc, const int row0, const int oc, const float* vec, const int img_off = 0, const size_t bjs = HALF) {
    f32x4 bv[2][2];
#pragma unroll
    for (int bj = 0; bj < 2; ++bj)
#pragma unroll
        for (int n = 0; n < 2; ++n) bv[bj][n] = (MODE == 0 || MODE == 1 || MODE == 3) ? *(const f32x4*)(vec + bj * HALF + 4 * n) : (f32x4){0.f, 0.f, 0.f, 0.f};
#pragma unroll
    for (int ai = 0; ai < 2; ++ai)
#pragma unroll
        for (int m = 0; m < 4; ++m) { bf16* rowp = base + (size_t)(row0 + ai * HALF + m * 16) * ldc + oc;
#pragma unroll
            for (int bj = 0; bj < 2; ++bj) { f32x4 v[2];
#pragma unroll
                for (int n = 0; n < 2; ++n) { f32x4 x = acc[ai][bj][m][n];
                    if (MODE == 0) x = (x + bv[bj][n]) * (0.125f * LOG2E);
                    else if (MODE == 1) x = x + bv[bj][n];
                    else if (MODE == 2) {
#pragma unroll
                        for (int j = 0; j < 4; ++j) x[j] = x[j] * fsig(x[j]); }
                    else if (MODE == 3) {
#pragma unroll
                        for (int j = 0; j < 4; ++j) { const float l = bv[bj][n][j]; x[j] = flog2(l + (1.f - l) * fsig(x[j])); } }
                    else if (MODE == 6) {
#pragma unroll
                        for (int j = 0; j < 4; ++j) x[j] = fsig(x[j]); }
                    v[n] = x; }
                if (MODE == 6) *(u32x4*)((unsigned char*)base + ((ai * 4 + m) * 2 + bj) * 8192 + img_off) = pack8(v[0], v[1]);
                else *(u32x4*)(rowp + bj * bjs) = pack8(v[0], v[1]); } }
}
struct EpiZ {
    static constexpr bool PERM = true;
    const float* bqkv; const float* lb; bf16* Q; bf16* KV; bf16* HG; bf16* GT;
    __device__ __forceinline__ void operator()(const f32x4 (&acc)[2][2][4][2], const Unit& u, int wr, int wc, int fr, int fq) const {
        const int row0 = u.pm * BM + wr * 64 + fr, cb = u.pn * BM + wc * 32 + 8 * fq;
        if (u.pn < 4) epiz_body<0>(acc, Q, QW, row0, cb, bqkv + cb);
        else if (u.pn == 4) epiz_body<1>(acc, KV, 256, row0, cb - QW, bqkv + cb);
        else if (u.pn < 21) { const int ct = (u.pn - 5) * 256; bf16* hb = HG + (size_t)((ct >> 10) * 8 + ((ct >> 7) & 7)) * HGPS; const int oc = wc * 32 + 8 * fq;
            if (u.pn < 9) epiz_body<2>(acc, hb, 128, row0, oc, nullptr, 0, HGPS);
            else if (u.pn < 13) epiz_body<3>(acc, hb, 128, row0, oc, lb + ((cb - QKVW) & 1023), 0, HGPS);
            else if (u.pn < 17) epiz_body<4>(acc, hb, 128, row0, oc, nullptr, 0, HGPS);
            else epiz_body<2>(acc, hb, 128, row0, oc, nullptr, 0, HGPS); }
        else epiz_body<6>(acc, GT + (size_t)(u.pm * 16 + (u.pn - 21)) * 65536, 0, 0, 0, nullptr, (wr * 4 + wc) * 1024 + (fq * 16 + fr) * 16);
    }
};
struct EpiMix {
    static constexpr bool PERM = true;
    const bf16* GT; bf16* MIX; unsigned char* PART;
    template <bool SECOND>
    __device__ __forceinline__ void body(const f32x4 (&acc)[2][2][4][2], const int row0, const int cb, const unsigned char* gimg, unsigned char* pimg, unsigned char* mimg) const {
#pragma unroll
        for (int ai = 0; ai < 2; ++ai)
#pragma unroll
        for (int mh = 0; mh < 2; ++mh) {
            u32x4 g[2][2], o[2][2];
#pragma unroll
            for (int m2 = 0; m2 < 2; ++m2)
#pragma unroll
                for (int bj = 0; bj < 2; ++bj) { const size_t row = (size_t)(row0 + ai * HALF + (2 * mh + m2) * 16); const int c = cb + bj * HALF;
                    g[m2][bj] = __builtin_nontemporal_load((const u32x4*)(gimg + ((ai * 4 + 2 * mh + m2) * 2 + bj) * 8192));
                    if (SECOND) o[m2][bj] = *(const u32x4*)(pimg + ((ai * 4 + 2 * mh + m2) * 2 + bj) * 8192); }
#pragma unroll
            for (int m2 = 0; m2 < 2; ++m2)
#pragma unroll
                for (int bj = 0; bj < 2; ++bj) { const int m = 2 * mh + m2; const size_t row = (size_t)(row0 + ai * HALF + m * 16); const int c = cb + bj * HALF;
                    f32x4 g0, g1; unpack8(g[m2][bj], g0, g1);
                    f32x4 v0 = acc[ai][bj][m][0] * g0, v1 = acc[ai][bj][m][1] * g1;
                    if (SECOND) { f32x4 o0, o1; unpack8(o[m2][bj], o0, o1); v0 += o0; v1 += o1; }
                    if (SECOND) *(u32x4*)(mimg + ((ai * 4 + m) * 2 + bj) * 8192) = pack8(v0, v1); else *(u32x4*)(pimg + ((ai * 4 + m) * 2 + bj) * 8192) = pack8(v0, v1); }
        }
    }
    __device__ __forceinline__ void operator()(const f32x4 (&acc)[2][2][4][2], const Unit& u, int wr, int wc, int fr, int fq) const {
        const int row0 = u.pm * BM + wr * 64 + fr, cb = u.pn * BM + wc * 32 + 8 * fq;
        const unsigned char* gimg = (const unsigned char*)GT + (size_t)(u.pm * 16 + (u.e ? 8 : 0) + u.pn) * 131072 + (wr * 4 + wc) * 1024 + (fq * 16 + fr) * 16;
        unsigned char* pimg = PART + (wr * 4 + wc) * 1024 + (fq * 16 + fr) * 16;
        unsigned char* mimg = (unsigned char*)MIX + (size_t)(u.pm * 8 + u.pn) * 131072 + (wr * 4 + wc) * 1024 + (fq * 16 + fr) * 16;
        if (u.e) body<true>(acc, row0, cb, gimg, pimg, mimg); else body<false>(acc, row0, cb, gimg, pimg, mimg);
    }
};
__device__ __forceinline__ void ss_slot(float s, float* SS, int row, int slot, int fq) {
    s += __shfl_xor(s, 16); s += __shfl_xor(s, 32);
    if (fq == 0) SS[(size_t)row * 32 + slot] = s;
}
struct EpiDelta {
    static constexpr bool PERM = true;
    bf16* DL;
    __device__ __forceinline__ void operator()(const f32x4 (&acc)[2][2][4][2], const Unit& u, int wr, int wc, int fr, int fq) const {
        unsigned char* dimg = (unsigned char*)DL + (size_t)(u.pm * 8 + u.pn) * 131072 + (wr * 4 + wc) * 1024 + (fq * 16 + fr) * 16;
#pragma unroll
        for (int ai = 0; ai < 2; ++ai)
#pragma unroll
            for (int m = 0; m < 4; ++m)
#pragma unroll
                for (int bj = 0; bj < 2; ++bj) *(u32x4*)(dimg + ((ai * 4 + m) * 2 + bj) * 8192) = pack8(acc[ai][bj][m][0], acc[ai][bj][m][1]);
    }
};
struct EpiPleRaw {
    static constexpr bool PERM = true;
    bf16* PL; float* SS;
    __device__ __forceinline__ void operator()(const f32x4 (&acc)[2][2][4][2], const Unit& u, int wr, int wc, int fr, int fq) const {
        const int row0 = u.pm * BM + wr * 64 + fr;
        unsigned char* pimg = (unsigned char*)PL + (size_t)(u.pm * 8 + u.pn) * 131072 + (wr * 4 + wc) * 1024 + (fq * 16 + fr) * 16;
#pragma unroll
        for (int ai = 0; ai < 2; ++ai)
#pragma unroll
            for (int m = 0; m < 4; ++m) { const int row = row0 + ai * HALF + m * 16; float s = 0.f;
#pragma unroll
                for (int bj = 0; bj < 2; ++bj) { const f32x4 a = acc[ai][bj][m][0], b = acc[ai][bj][m][1];
                    s += ((a[0] * a[0] + a[1] * a[1]) + (a[2] * a[2] + a[3] * a[3])) + ((b[0] * b[0] + b[1] * b[1]) + (b[2] * b[2] + b[3] * b[3]));
                    *(u32x4*)(pimg + ((ai * 4 + m) * 2 + bj) * 8192) = pack8(a, b); }
                ss_slot(s, SS, row, u.pn * 4 + wc, fq); }
    }
};
struct EpiPleGate {
    static constexpr bool PERM = true;
    const bf16* H2B; bf16* H3B; const bf16* PL; const float* rstd3; const float* rstdp; const float* gple; float* SS;
    __device__ __forceinline__ void operator()(const f32x4 (&acc)[2][2][4][2], const Unit& u, int wr, int wc, int fr, int fq) const {
        const int row0 = u.pm * BM + wr * 64 + fr, cb = u.pn * BM + wc * 32 + 8 * fq;
        const unsigned char* pimg = (const unsigned char*)PL + (size_t)(u.pm * 8 + u.pn) * 131072 + (wr * 4 + wc) * 1024 + (fq * 16 + fr) * 16;
        f32x4 gp[2][2];
#pragma unroll
        for (int bj = 0; bj < 2; ++bj)
#pragma unroll
            for (int n = 0; n < 2; ++n) gp[bj][n] = *(const f32x4*)(gple + cb + bj * HALF + 4 * n);
#pragma unroll
        for (int ai = 0; ai < 2; ++ai)
#pragma unroll
        for (int mh = 0; mh < 2; ++mh) {
            u32x4 hh[2][2], pp[2][2]; float r3[2], rp[2];
#pragma unroll
            for (int m2 = 0; m2 < 2; ++m2) { const int row = row0 + ai * HALF + (2 * mh + m2) * 16; r3[m2] = rstd3[row]; rp[m2] = rstdp[row];
#pragma unroll
                for (int bj = 0; bj < 2; ++bj) { const size_t o = (size_t)row * D + cb + bj * HALF; hh[m2][bj] = *(const u32x4*)(H2B + o); pp[m2][bj] = __builtin_nontemporal_load((const u32x4*)(pimg + ((ai * 4 + 2 * mh + m2) * 2 + bj) * 8192)); } }
#pragma unroll
            for (int m2 = 0; m2 < 2; ++m2) { const int m = 2 * mh + m2; const int row = row0 + ai * HALF + m * 16; float ss = 0.f;
#pragma unroll
                for (int bj = 0; bj < 2; ++bj) { const size_t o = (size_t)row * D + cb + bj * HALF;
                    f32x4 h0, h1, p0, p1; unpack8(hh[m2][bj], h0, h1); unpack8(pp[m2][bj], p0, p1);
                    f32x4 g0 = acc[ai][bj][m][0] * r3[m2], g1 = acc[ai][bj][m][1] * r3[m2];
#pragma unroll
                    for (int j = 0; j < 4; ++j) { g0[j] = fsig(g0[j]); g1[j] = fsig(g1[j]); }
                    const f32x4 r0 = h0 + p0 * rp[m2] * gp[bj][0] * g0, r1 = h1 + p1 * rp[m2] * gp[bj][1] * g1;
                    ss += ((r0[0] * r0[0] + r0[1] * r0[1]) + (r0[2] * r0[2] + r0[3] * r0[3])) + ((r1[0] * r1[0] + r1[1] * r1[1]) + (r1[2] * r1[2] + r1[3] * r1[3]));
                    *(u32x4*)(H3B + o) = pack8(r0, r1); }
                ss_slot(ss, SS, row, u.pn * 4 + wc, fq); }
        }
    }
};

struct MoeOrder {
    const LAS int* eoff; const LAS int* ecnt; int NT, G, c, total_rb; const char* A; const char* W; size_t wexp, tstepB, arow_bytes; const unsigned short* LIST; int gather;
    __device__ __forceinline__ bool next(int i, Unit& u) const {
        const int it = i * G + c; if (it >= total_rb * NT) return false;
        const int rb = it / NT, pn = it % NT, row0 = rb * BM;
        int e = 0; { int hi = NEXP;
#pragma unroll
            for (int st = 0; st < 6; ++st) { const int mid = (e + hi) >> 1; if (eoff[mid] <= row0) e = mid; else hi = mid; } }
        e = __builtin_amdgcn_readfirstlane(e);
        u.pm = rb; u.pn = pn; u.e = e; u.r0 = __builtin_amdgcn_readfirstlane(row0 - eoff[e]); u.cnt = __builtin_amdgcn_readfirstlane(ecnt[e]); u.row0 = row0;
        u.a = gather ? A : A + (size_t)row0 * arow_bytes; u.b = W + (size_t)e * wexp + (size_t)pn * tstepB; return true;
    }
    __device__ __forceinline__ void pace_arrive_wait(int, int, int) const {}
    __device__ __forceinline__ void pace_finish(int, int, int) const {}
    __device__ __forceinline__ unsigned row_off(const Unit& u, int row) const {
        const unsigned short* lp = LIST + (size_t)u.e * NTOK + u.r0;
        const unsigned tok = (row < u.cnt - u.r0) ? (unsigned)(lp[row] & 0x7fffu) : 0u; return tok * (unsigned)arow_bytes;
    }
};
struct EpiGateUp {
    static constexpr bool PERM = true;
    bf16* HID; const unsigned short* LIST; const float* RSTD2;
    __device__ __forceinline__ void operator()(const f32x4 (&acc)[2][2][4][2], const Unit& u, int wr, int wc, int fr, int fq) const {
        const int row0 = u.row0 + wr * 64 + fr, cb = u.pn * HALF + wc * 32 + 8 * fq;
        const unsigned short* lp = LIST + (size_t)u.e * NTOK + u.r0;
        unsigned tk[2][4]; float rs[2][4];
#pragma unroll
        for (int ai = 0; ai < 2; ++ai)
#pragma unroll
            for (int m = 0; m < 4; ++m) { const int lr = ai * HALF + wr * 64 + m * 16 + fr; tk[ai][m] = (lr < u.cnt - u.r0) ? (unsigned)(lp[lr] & 0x7fffu) : 0u; }
#pragma unroll
        for (int ai = 0; ai < 2; ++ai)
#pragma unroll
            for (int m = 0; m < 4; ++m) rs[ai][m] = RSTD2[tk[ai][m]];
#pragma unroll
        for (int ai = 0; ai < 2; ++ai)
#pragma unroll
            for (int m = 0; m < 4; ++m) { f32x4 v[2];
#pragma unroll
                for (int n = 0; n < 2; ++n) { const f32x4 g = acc[ai][0][m][n] * rs[ai][m], up = acc[ai][1][m][n] * rs[ai][m];
#pragma unroll
                    for (int j = 0; j < 4; ++j) v[n][j] = g[j] * fsig(g[j]) * up[j]; }
                *(u32x4*)(HID + (size_t)(row0 + ai * HALF + m * 16) * MH + cb) = pack8(v[0], v[1]); }
    }
};
struct EpiDown {
    static constexpr bool PERM = true;
    const unsigned short* LIST; const float* TW; bf16* Y;
    __device__ __forceinline__ void operator()(const f32x4 (&acc)[2][2][4][2], const Unit& u, int wr, int wc, int fr, int fq) const {
        const int cb = u.pn * BM + wc * 32 + 8 * fq;
        const unsigned short* lp = LIST + (size_t)u.e * NTOK + u.r0;
        unsigned ent[2][4]; float w[2][4];
#pragma unroll
        for (int ai = 0; ai < 2; ++ai)
#pragma unroll
            for (int m = 0; m < 4; ++m) { const int lr = ai * HALF + wr * 64 + m * 16 + fr; ent[ai][m] = (lr < u.cnt - u.r0) ? (unsigned)lp[lr] : 0x10000u; }
#pragma unroll
        for (int ai = 0; ai < 2; ++ai)
#pragma unroll
            for (int m = 0; m < 4; ++m) w[ai][m] = TW[(ent[ai][m] & 0x7fffu) * 2 + ((ent[ai][m] >> 15) & 1u)];
#pragma unroll
        for (int ai = 0; ai < 2; ++ai)
#pragma unroll
            for (int m = 0; m < 4; ++m) if (!(ent[ai][m] & 0x10000u)) { const unsigned tok = ent[ai][m] & 0x7fffu, k = (ent[ai][m] >> 15) & 1u;
                bf16* yp = Y + (size_t)k * NTOK * D + (size_t)tok * D + cb;
#pragma unroll
                for (int bj = 0; bj < 2; ++bj) *(u32x4*)(yp + bj * HALF) = pack8(acc[ai][bj][m][0] * w[ai][m], acc[ai][bj][m][1] * w[ai][m]); }
    }
};
}

namespace hg {
typedef short s16x4 __attribute__((ext_vector_type(4)));
typedef short bf16x8 __attribute__((ext_vector_type(8)));
typedef __bf16 bfv2 __attribute__((ext_vector_type(2)));
typedef float fv2 __attribute__((ext_vector_type(2)));
constexpr int RS = 272, IMG = 64 * RS;
constexpr int L_QI = 0, L_QR = IMG, L_KR = 2 * IMG, L_KL = 3 * IMG, L_V = 4 * IMG;
constexpr int L_SEG = 5 * IMG, L_D = L_SEG + 4096, L_RED = L_D + 512, L_RSTD = L_RED + 2048, L_END = L_RSTD + 256;
__device__ __forceinline__ unsigned cvtpk(float lo, float hi) { fv2 v; v.x = lo; v.y = hi; return __builtin_bit_cast(unsigned, __builtin_convertvector(v, bfv2)); }
__device__ __forceinline__ float blo(unsigned u) { return __uint_as_float(u << 16); }
__device__ __forceinline__ float bhi(unsigned u) { return __uint_as_float(u & 0xffff0000u); }
__device__ __forceinline__ bf16x8 frag_from2(const f32x4 a, const f32x4 b) { v4u w; w.x = cvtpk(a[0], a[1]); w.y = cvtpk(a[2], a[3]); w.z = cvtpk(b[0], b[1]); w.w = cvtpk(b[2], b[3]); return __builtin_bit_cast(bf16x8, w); }
__device__ __forceinline__ bf16x8 frag_tr2(LAS unsigned char* p0, LAS unsigned char* p1) {
    const s16x4 lo = __builtin_amdgcn_ds_read_tr16_b64_v4i16((LAS s16x4*)p0), hi = __builtin_amdgcn_ds_read_tr16_b64_v4i16((LAS s16x4*)p1);
    return __builtin_shufflevector(lo, hi, 0, 1, 2, 3, 4, 5, 6, 7); }
__device__ __forceinline__ bf16x8 frag_2x8(LAS unsigned char* p0, LAS unsigned char* p1) { v4u w; const v2u a = *(const LAS v2u*)p0, b = *(const LAS v2u*)p1; w.x = a.x; w.y = a.y; w.z = b.x; w.w = b.y; return __builtin_bit_cast(bf16x8, w); }
__device__ __forceinline__ float row_sum16(float s) {
    s += __int_as_float(__builtin_amdgcn_update_dpp(0, __float_as_int(s), 0x128, 0xf, 0xf, false));
    s += __int_as_float(__builtin_amdgcn_update_dpp(0, __float_as_int(s), 0x124, 0xf, 0xf, false));
    s += __int_as_float(__builtin_amdgcn_update_dpp(0, __float_as_int(s), 0x122, 0xf, 0xf, false));
    s += __int_as_float(__builtin_amdgcn_update_dpp(0, __float_as_int(s), 0x121, 0xf, 0xf, false));
    return s; }
#define HG_MFMA(a, b, c) __builtin_amdgcn_mfma_f32_16x16x32_bf16((a), (b), (c), 0, 0, 0)

template <bool P1>
__device__ __forceinline__ void unit(LAS unsigned char* lds, const bf16* HG, bf16* OREC, float* UST, float* DST, const float* ghg, const int u, const int tid) {
    const int lane = tid & 63, w = __builtin_amdgcn_readfirstlane(tid >> 6), r = lane & 15, q = lane >> 4;
    const int bh = u >> 5, j = u & 31, b = bh >> 3, h = bh & 7;
    const size_t row0 = (size_t)b * SEQ + (size_t)j * 512;
    f32x4 Sacc[8];
    float* ust = UST + (size_t)u * 16384 + (size_t)w * 2048 + lane;
#pragma unroll
    for (int kt = 0; kt < 8; ++kt)
#pragma unroll
        for (int rg = 0; rg < 4; ++rg) Sacc[kt][rg] = P1 ? 0.f : ust[(kt * 4 + rg) * 64];
    fv2 btot; btot.x = 0.f; btot.y = 0.f;
    unsigned gq[8], gg[8]; v4u rv[2], rgr[2];
#define HG_LOAD_RAW(c) do { const bf16* gp_ = HG + (size_t)h * HGPS + (row0 + (size_t)(c) * 64 + 8 * w) * 128 + 2 * lane; \
        _Pragma("unroll") for (int i = 0; i < 8; ++i) { if (!P1) { gq[i] = __builtin_nontemporal_load((const unsigned*)(gp_ + (size_t)i * 128)); gg[i] = __builtin_nontemporal_load((const unsigned*)(gp_ + (size_t)i * 128 + 8 * HGPS)); } else gg[i] = *(const unsigned*)(gp_ + (size_t)i * 128 + 8 * HGPS); } \
        _Pragma("unroll") for (int i = 0; i < 2; ++i) { const int ci_ = tid + 512 * i; const bf16* vp_ = HG + (size_t)h * HGPS + (row0 + (size_t)(c) * 64 + (ci_ >> 4)) * 128 + (ci_ & 15) * 8; \
            if (!P1) { rv[i] = __builtin_nontemporal_load((const v4u*)(vp_ + 16 * HGPS)); rgr[i] = __builtin_nontemporal_load((const v4u*)(vp_ + 24 * HGPS)); } else rv[i] = *(const v4u*)(vp_ + 16 * HGPS); } } while (0)
    HG_LOAD_RAW(0);
#pragma unroll 1
    for (int c = 0; c < 8; ++c) {
        const size_t rowc = row0 + (size_t)c * 64;
#pragma unroll
        for (int i = 0; i < 2; ++i) { const int ci = tid + 512 * i; *(LAS v4u*)(lds + L_V + (ci >> 4) * RS + (ci & 15) * 16) = rv[i]; }
        float c0[8], c1[8]; { float r0 = 0.f, r1 = 0.f;
#pragma unroll
            for (int i = 0; i < 8; ++i) { r0 += blo(gg[i]); r1 += bhi(gg[i]); c0[i] = r0; c1[i] = r1; }
            fv2 sv; sv.x = r0; sv.y = r1; *(LAS fv2*)(lds + L_SEG + (w * 128 + 2 * lane) * 4) = sv; }
        v4u grk[2];
        if (!P1) { grk[0] = rgr[0]; grk[1] = rgr[1]; }
        __syncthreads();
        float off0 = 0.f, off1 = 0.f, ref0 = 0.f, ref1 = 0.f, tot0 = 0.f, tot1 = 0.f;
#pragma unroll
        for (int s = 0; s < 8; ++s) { const fv2 sv = *(const LAS fv2*)(lds + L_SEG + (s * 128 + 2 * lane) * 4);
            if (s < w) { off0 += sv.x; off1 += sv.y; } if (s < 4) { ref0 += sv.x; ref1 += sv.y; } tot0 += sv.x; tot1 += sv.y; }
        if (w == 0) { fv2 dv; dv.x = fexp2(tot0); dv.y = fexp2(tot1); *(LAS fv2*)(lds + L_D + 2 * lane * 4) = dv; btot.x += tot0; btot.y += tot1; }
#pragma unroll
        for (int i = 0; i < 8; ++i) {
            const int t = 8 * w + i; const float b0 = off0 + c0[i], b1 = off1 + c1[i];
            const float k0 = 1.f - fexp2(blo(gg[i])), k1 = 1.f - fexp2(bhi(gg[i]));
            *(LAS unsigned*)(lds + L_KL + t * RS + 4 * lane) = cvtpk(k0 * fexp2(tot0 - b0), k1 * fexp2(tot1 - b1));
            if (!P1) { const float q0 = blo(gq[i]), q1 = bhi(gq[i]);
                *(LAS unsigned*)(lds + L_QI + t * RS + 4 * lane) = cvtpk(q0 * fexp2(b0), q1 * fexp2(b1));
                *(LAS unsigned*)(lds + L_QR + t * RS + 4 * lane) = cvtpk(q0 * fexp2(b0 - ref0), q1 * fexp2(b1 - ref1));
                *(LAS unsigned*)(lds + L_KR + t * RS + 4 * lane) = cvtpk(k0 * fexp2(ref0 - b0), k1 * fexp2(ref1 - b1)); }
        }
        __syncthreads();
        if (c + 1 < 8) HG_LOAD_RAW(c + 1);
        bf16x8 Vf[2];
#pragma unroll
        for (int cp = 0; cp < 2; ++cp) { LAS unsigned char* p0 = lds + L_V + (32 * cp + 4 * q + (r >> 2)) * RS + (16 * w + 4 * (r & 3)) * 2; Vf[cp] = frag_tr2(p0, p0 + 16 * RS); }
        f32x4 Oacc[4];
        if (!P1) {
#pragma unroll
            for (int ti = 0; ti < 4; ++ti) Oacc[ti] = (f32x4){0.f, 0.f, 0.f, 0.f};
#pragma unroll
            for (int cc = 0; cc < 4; ++cc) { const bf16x8 Sf = frag_from2(Sacc[2 * cc], Sacc[2 * cc + 1]);
#pragma unroll
                for (int ti = 0; ti < 4; ++ti) { LAS unsigned char* p = lds + L_QI + (16 * ti + r) * RS + 64 * cc + 8 * q; Oacc[ti] = HG_MFMA(frag_2x8(p, p + 32), Sf, Oacc[ti]); } }
#pragma unroll
            for (int ti = 0; ti < 4; ++ti) {
                f32x4 AT[4];
#pragma unroll
                for (int si = 0; si < 4; ++si) { AT[si] = (f32x4){0.f, 0.f, 0.f, 0.f};
                    if (si <= ti) {
#pragma unroll
                        for (int cc = 0; cc < 4; ++cc) { const bf16x8 A = *(const LAS bf16x8*)(lds + L_KR + (16 * si + r) * RS + 64 * cc + 16 * q); const bf16x8 B = *(const LAS bf16x8*)(lds + L_QR + (16 * ti + r) * RS + 64 * cc + 16 * q);
                            AT[si] = HG_MFMA(A, B, AT[si]); }
                        if (si == ti) {
#pragma unroll
                            for (int rg = 0; rg < 4; ++rg) if (4 * q + rg > r) AT[si][rg] = 0.f; }
                    } }
#pragma unroll
                for (int cp = 0; cp < 2; ++cp) if (cp <= (ti >> 1)) Oacc[ti] = HG_MFMA(frag_from2(AT[2 * cp], AT[2 * cp + 1]), Vf[cp], Oacc[ti]);
            }
        }
#pragma unroll
        for (int kt = 0; kt < 8; ++kt) { const f32x4 dv = *(const LAS f32x4*)(lds + L_D + (16 * kt + 4 * q) * 4); Sacc[kt] = Sacc[kt] * dv;
#pragma unroll
            for (int cp = 0; cp < 2; ++cp) { LAS unsigned char* p0 = lds + L_KL + (32 * cp + 4 * q + (r >> 2)) * RS + (16 * kt + 4 * (r & 3)) * 2; Sacc[kt] = HG_MFMA(frag_tr2(p0, p0 + 16 * RS), Vf[cp], Sacc[kt]); } }
        if (P1) { __syncthreads(); }
        else {
#pragma unroll
            for (int ti = 0; ti < 4; ++ti)
#pragma unroll
                for (int rg = 0; rg < 4; ++rg) { float s = Oacc[ti][rg] * Oacc[ti][rg];
                    s = row_sum16(s);
                    if (r == 0) *(LAS float*)(lds + L_RED + ((16 * ti + 4 * q + rg) * 8 + w) * 4) = s; }
            __syncthreads();
            if (tid < 64) { const f32x4 a = *(const LAS f32x4*)(lds + L_RED + tid * 32), bq = *(const LAS f32x4*)(lds + L_RED + tid * 32 + 16);
                *(LAS float*)(lds + L_RSTD + tid * 4) = rsqrtf((((a[0] + a[1]) + (a[2] + a[3])) + ((bq[0] + bq[1]) + (bq[2] + bq[3]))) * (1.f / 128.f) + EPS); }
            __syncthreads();
            { const float gv = ghg[16 * w + r];
#pragma unroll
                for (int ti = 0; ti < 4; ++ti) { const f32x4 rs = *(const LAS f32x4*)(lds + L_RSTD + (16 * ti + 4 * q) * 4);
#pragma unroll
                    for (int rg = 0; rg < 4; ++rg) *(LAS bf16*)(lds + L_QI + (16 * ti + 4 * q + rg) * RS + (16 * w + r) * 2) = (bf16)(cvtpk(Oacc[ti][rg] * rs[rg] * gv, 0.f) & 0xffffu); } }
            __syncthreads();
#pragma unroll
            for (int i = 0; i < 2; ++i) { const int ci = tid + 512 * i, row = ci >> 4, c16 = ci & 15;
                const v4u ov = *(const LAS v4u*)(lds + L_QI + row * RS + c16 * 16); const v4u gv = grk[i]; v4u o;
                o.x = cvtpk(blo(ov.x) * blo(gv.x), bhi(ov.x) * bhi(gv.x)); o.y = cvtpk(blo(ov.y) * blo(gv.y), bhi(ov.y) * bhi(gv.y));
                o.z = cvtpk(blo(ov.z) * blo(gv.z), bhi(ov.z) * bhi(gv.z)); o.w = cvtpk(blo(ov.w) * blo(gv.w), bhi(ov.w) * bhi(gv.w));
                *(v4u*)(OREC + (rowc + row) * HW + h * 128 + c16 * 8) = o; }
        }
    }
    if (P1) {
#pragma unroll
        for (int kt = 0; kt < 8; ++kt)
#pragma unroll
            for (int rg = 0; rg < 4; ++rg) ust[(kt * 4 + rg) * 64] = Sacc[kt][rg];
        if (w == 0) { fv2 dv; dv.x = fexp2(btot.x); dv.y = fexp2(btot.y); *(fv2*)(DST + (size_t)u * 128 + 2 * lane) = dv; }
    }
    __syncthreads();
#undef HG_LOAD_RAW
}
__device__ __forceinline__ void scan(float* UST, const float* DST, int gtid, int nthr) {
    for (int e = gtid; e < 16 * 16384; e += nthr) {
        const int bh = e >> 14, el = e & 16383, ln = el & 63, rg = (el >> 6) & 3, kt = (el >> 8) & 7, k = 16 * kt + 4 * (ln >> 4) + rg;
        float uu[32], dd[32];
        float* p0 = UST + (size_t)bh * 32 * 16384 + el; const float* d0 = DST + (size_t)bh * 32 * 128 + k;
#pragma unroll
        for (int j = 0; j < 32; ++j) { uu[j] = p0[(size_t)j * 16384]; dd[j] = d0[j * 128]; }
        float T = 0.f;
#pragma unroll
        for (int j = 0; j < 32; ++j) { p0[(size_t)j * 16384] = T; T = dd[j] * T + uu[j]; }
    }
}
}

namespace at {
typedef short bf16x8 __attribute__((ext_vector_type(8)));
constexpr int RSK = 144;
constexpr int L_K = 0, L_V = 272 * RSK, L_B = 2 * 272 * RSK, L_O = L_B + 4096, OW = 16 * RSK, L_END = L_O + 8 * OW;
__device__ __forceinline__ void item(LAS unsigned char* lds, bf16* QB, const bf16* KVB, const float* sinks, const float* rel, const int it, const int tid) {
    const int lane = tid & 63, w = __builtin_amdgcn_readfirstlane(tid >> 6), r = lane & 15, q = lane >> 4;
    const int kvh = it & 1, blk = (it >> 1) & 127, b = it >> 8, head = kvh * 8 + w;
    const size_t tok0 = (size_t)b * SEQ + (size_t)blk * 128;
    __syncthreads();
#pragma unroll
    for (int i = 0; i < 4; ++i) { const int ci = tid + 512 * i, row = ci >> 3, c8 = ci & 7; v4u kk = (v4u){0u, 0u, 0u, 0u}, vv = (v4u){0u, 0u, 0u, 0u};
        if (blk > 0 || row >= 128) { const bf16* p = KVB + (tok0 - 128 + row) * 256 + kvh * 64 + c8 * 8; kk = *(const v4u*)p; vv = *(const v4u*)(p + 128); }
        *(LAS v4u*)(lds + L_K + row * RSK + c8 * 16) = kk; *(LAS v4u*)(lds + L_V + row * RSK + c8 * 16) = vv; }
    if (tid < 128) *(LAS v4u*)(lds + L_V + (256 + (tid >> 3)) * RSK + (tid & 7) * 16) = (v4u){0u, 0u, 0u, 0u};
#pragma unroll
    for (int i = 0; i < 2; ++i) { const int e = tid + 512 * i, g = e >> 7, d = e & 127; int bk;
        if (d < 16) bk = d; else { bk = 16 + (int)(__logf((float)d * (1.f / 16.f)) / 2.0794415416798357f * 16.f); if (bk > 31) bk = 31; }
        *(LAS float*)(lds + L_B + e * 4) = rel[bk * 16 + kvh * 8 + g] * LOG2E; }
    __syncthreads();
    float bv[9][4];
#pragma unroll
    for (int kt = 0; kt < 9; ++kt)
#pragma unroll
        for (int rg = 0; rg < 4; ++rg) { const int dist = 128 - 16 * kt + r - 4 * q - rg; const bool ok = dist >= 0 && dist < 128;
            const float bb = *(const LAS float*)(lds + L_B + (w * 128 + (ok ? dist : 0)) * 4); bv[kt][rg] = ok ? bb : -1e30f; }
    const float sink = sinks[head] * LOG2E;
    bf16x8 Qn0, Qn1; { const bf16* qrow = QB + (tok0 + r) * QW + head * 64 + 8 * q; Qn0 = *(const bf16x8*)qrow; Qn1 = *(const bf16x8*)(qrow + 32); }
#pragma unroll 1
    for (int qt = 0; qt < 8; ++qt) {
        const bf16x8 Qf0 = Qn0, Qf1 = Qn1;
        if (qt + 1 < 8) { const bf16* qrow = QB + (tok0 + 16 * (qt + 1) + r) * QW + head * 64 + 8 * q; Qn0 = *(const bf16x8*)qrow; Qn1 = *(const bf16x8*)(qrow + 32); }
        f32x4 ST[9];
#pragma unroll
        for (int kt = 0; kt < 9; ++kt) {
            if (blk == 0 && qt + kt < 8) { ST[kt] = (f32x4){-1e30f, -1e30f, -1e30f, -1e30f}; }
            else { LAS unsigned char* kp = lds + L_K + (16 * (qt + kt) + r) * RSK + 16 * q; f32x4 a = (f32x4){0.f, 0.f, 0.f, 0.f};
                a = __builtin_amdgcn_mfma_f32_16x16x32_bf16(*(const LAS bf16x8*)kp, Qf0, a, 0, 0, 0); a = __builtin_amdgcn_mfma_f32_16x16x32_bf16(*(const LAS bf16x8*)(kp + 64), Qf1, a, 0, 0, 0);
#pragma unroll
                for (int rg = 0; rg < 4; ++rg) ST[kt][rg] = a[rg] + bv[kt][rg]; } }
        float m = sink;
#pragma unroll
        for (int kt = 0; kt < 9; ++kt)
#pragma unroll
            for (int rg = 0; rg < 4; ++rg) m = fmaxf(m, ST[kt][rg]);
        m = fmaxf(m, __shfl_xor(m, 16)); m = fmaxf(m, __shfl_xor(m, 32));
        float l = 0.f;
#pragma unroll
        for (int kt = 0; kt < 9; ++kt)
#pragma unroll
            for (int rg = 0; rg < 4; ++rg) { const float p = fexp2(ST[kt][rg] - m); ST[kt][rg] = p; l += p; }
        l += __shfl_xor(l, 16); l += __shfl_xor(l, 32);
        const float inv = 1.f / (l + fexp2(sink - m));
        f32x4 O[4];
#pragma unroll
        for (int dt = 0; dt < 4; ++dt) O[dt] = (f32x4){0.f, 0.f, 0.f, 0.f};
#pragma unroll
        for (int cp = 0; cp < 5; ++cp) {
            const f32x4 pa = ST[2 * cp] * inv, pb = (2 * cp + 1 < 9) ? ST[(2 * cp + 1 < 9) ? 2 * cp + 1 : 8] * inv : (f32x4){0.f, 0.f, 0.f, 0.f};
            const bf16x8 P = hg::frag_from2(pa, pb);
#pragma unroll
            for (int dt = 0; dt < 4; ++dt) { LAS unsigned char* p0 = lds + L_V + (16 * (qt + 2 * cp) + 4 * q + (r >> 2)) * RSK + (16 * dt + 4 * (r & 3)) * 2;
                O[dt] = __builtin_amdgcn_mfma_f32_16x16x32_bf16(P, hg::frag_tr2(p0, p0 + 16 * RSK), O[dt], 0, 0, 0); } }
        LAS unsigned char* ow = lds + L_O + w * OW;
#pragma unroll
        for (int dt = 0; dt < 4; ++dt)
#pragma unroll
            for (int rg = 0; rg < 4; ++rg) *(LAS bf16*)(ow + (4 * q + rg) * RSK + (16 * dt + r) * 2) = (bf16)(hg::cvtpk(O[dt][rg], 0.f) & 0xffffu);
#pragma unroll
        for (int i = 0; i < 2; ++i) { const int ci = lane + 64 * i, row = ci >> 3, c8 = ci & 7;
            const v4u v = *(const LAS v4u*)(ow + row * RSK + c8 * 16); *(v4u*)(QB + (tok0 + 16 * qt + row) * QW + head * 64 + c8 * 8) = v; }
    }
}
}

namespace rt {
typedef short bf16x8 __attribute__((ext_vector_type(8)));
__device__ __forceinline__ void prep_w(const float* wco, const float* wfi, const float* gf, bf16* WRH, bf16* WRL, int gtid, int nthr) {
    for (int e = gtid; e < 80 * D; e += nthr) { const int n = e >> 11, k = e & 2047;
        const float w = (n < 8) ? wco[k * 8 + n] : (n < 72 ? wfi[k * 64 + (n - 8)] : 0.f); const float v = w * gf[k];
        const unsigned h = hg::cvtpk(v, 0.f) & 0xffffu; const float l = v - __uint_as_float(h << 16);
        WRH[e] = (bf16)h; WRL[e] = (bf16)(hg::cvtpk(l, 0.f) & 0xffffu); }
}
constexpr int RSB = 272, BUFB = 2 * 80 * RSB, L_G = 2 * BUFB, L_LW = L_G + 8192, L_HIST = L_LW + 8 * 5120;
__device__ __forceinline__ void pass(LAS unsigned char* lds, const float* x, const bf16* DL, float* RSTD2, const float* gf, const bf16* WRH, const bf16* WRL, const float* bco, const float* bfi,
                                     bf16* XN, float* TW, const int tl, const bool live, const int tid, int& ea_out, int& eb_out) {
    const int lane = tid & 63, w = __builtin_amdgcn_readfirstlane(tid >> 6), r = lane & 15, q = lane >> 4;
    const int tok = live ? tl * 16 + r : r;
    LAS float* lw = (LAS float*)(lds + L_LW + w * 5120);
    v4u st[5];
#define RT_BLOAD(ck_) do { _Pragma("unroll") for (int i = 0; i < 5; ++i) { const int p_ = tid + 512 * i, mat_ = p_ >= 1280, rem_ = p_ - 1280 * mat_, n_ = rem_ >> 4, j_ = rem_ & 15; \
        st[i] = *(const v4u*)((mat_ ? WRL : WRH) + (size_t)n_ * D + (ck_) * 128 + j_ * 8); } } while (0)
#define RT_BSTORE(buf_) do { _Pragma("unroll") for (int i = 0; i < 5; ++i) { const int p_ = tid + 512 * i, mat_ = p_ >= 1280, rem_ = p_ - 1280 * mat_, n_ = rem_ >> 4, j_ = rem_ & 15; \
        *(LAS v4u*)(lds + (buf_) * BUFB + mat_ * 80 * RSB + n_ * RSB + j_ * 16) = st[i]; } } while (0)
    RT_BLOAD(0);
    const float* xr = x + (size_t)tok * D + 8 * q; bf16* xo = XN + (size_t)tok * D + 8 * q;
    const int tl0 = live ? tl : 0, t0 = (tl0 & 15) * 16;
    const unsigned char* dbase = (const unsigned char*)DL + (size_t)(tl0 >> 4) * 8 * 131072 + (((t0 >> 7) * 4 + ((t0 >> 4) & 3)) * 2) * 8192 + (((t0 >> 6) & 1) * 4) * 1024 + (q * 16 + r) * 16;
    f32x4 X[4][2]; v4u Dl[4];
#define RT_XLOAD(ck_) do { _Pragma("unroll") for (int s_ = 0; s_ < 4; ++s_) { const int c_ = 4 * (ck_) + s_; X[s_][0] = __builtin_nontemporal_load((const f32x4*)(xr + 32 * c_)); \
        X[s_][1] = __builtin_nontemporal_load((const f32x4*)(xr + 32 * c_ + 4)); Dl[s_] = __builtin_nontemporal_load((const v4u*)(dbase + (size_t)(c_ >> 3) * 131072 + ((c_ >> 2) & 1) * 8192 + (c_ & 3) * 1024)); } } while (0)
    RT_XLOAD(0);
    RT_BSTORE(0);
    __syncthreads();
    f32x4 acc[5];
#pragma unroll
    for (int nt = 0; nt < 5; ++nt) acc[nt] = (f32x4){0.f, 0.f, 0.f, 0.f};
    float ssq = 0.f;
#pragma unroll 1
    for (int ck = 0; ck < 16; ++ck) {
        f32x4 Xc[4][2]; v4u Dc[4];
#pragma unroll
        for (int s_ = 0; s_ < 4; ++s_) { Xc[s_][0] = X[s_][0]; Xc[s_][1] = X[s_][1]; Dc[s_] = Dl[s_]; }
        if (ck + 1 < 16) { RT_BLOAD(ck + 1); RT_XLOAD(ck + 1); }
        LAS unsigned char* bb = lds + (ck & 1) * BUFB + r * RSB + 16 * q;
#pragma unroll
        for (int s_ = 0; s_ < 4; ++s_) {
            const int c = 4 * ck + s_;
            f32x4 x0 = Xc[s_][0], x1 = Xc[s_][1]; { f32x4 d0, d1; pg8::unpack8(Dc[s_], d0, d1); x0 += d0; x1 += d1; }
            ssq += ((x0[0] * x0[0] + x0[1] * x0[1]) + (x0[2] * x0[2] + x0[3] * x0[3])) + ((x1[0] * x1[0] + x1[1] * x1[1]) + (x1[2] * x1[2] + x1[3] * x1[3]));
            v4u hi; hi.x = hg::cvtpk(x0[0], x0[1]); hi.y = hg::cvtpk(x0[2], x0[3]); hi.z = hg::cvtpk(x1[0], x1[1]); hi.w = hg::cvtpk(x1[2], x1[3]);
            if (live) *(v4u*)(xo + 32 * c) = hi;
            v4u lo; lo.x = hg::cvtpk(x0[0] - hg::blo(hi.x), x0[1] - hg::bhi(hi.x)); lo.y = hg::cvtpk(x0[2] - hg::blo(hi.y), x0[3] - hg::bhi(hi.y));
            lo.z = hg::cvtpk(x1[0] - hg::blo(hi.z), x1[1] - hg::bhi(hi.z)); lo.w = hg::cvtpk(x1[2] - hg::blo(hi.w), x1[3] - hg::bhi(hi.w));
            const bf16x8 Ah = __builtin_bit_cast(bf16x8, hi), Al = __builtin_bit_cast(bf16x8, lo);
#pragma unroll
            for (int nt = 0; nt < 5; ++nt) { const bf16x8 Bh = *(const LAS bf16x8*)(bb + nt * 16 * RSB + 64 * s_), Bl = *(const LAS bf16x8*)(bb + 80 * RSB + nt * 16 * RSB + 64 * s_);
                acc[nt] = __builtin_amdgcn_mfma_f32_16x16x32_bf16(Ah, Bh, acc[nt], 0, 0, 0); acc[nt] = __builtin_amdgcn_mfma_f32_16x16x32_bf16(Ah, Bl, acc[nt], 0, 0, 0);
                acc[nt] = __builtin_amdgcn_mfma_f32_16x16x32_bf16(Al, Bh, acc[nt], 0, 0, 0); }
        }
        if (ck + 1 < 16) RT_BSTORE((ck + 1) & 1);
        __syncthreads();
    }
#undef RT_BLOAD
#undef RT_BSTORE
#undef RT_XLOAD
    ssq += __shfl_xor(ssq, 16); ssq += __shfl_xor(ssq, 32);
    const float rstd = rsqrtf(ssq * (1.f / D) + EPS);
    if (live && q == 0) RSTD2[tok] = rstd;
#pragma unroll
    for (int nt = 0; nt < 5; ++nt)
#pragma unroll
        for (int rg = 0; rg < 4; ++rg) lw[(4 * q + rg) * 80 + 16 * nt + r] = acc[nt][rg];
    asm volatile("s_waitcnt lgkmcnt(0)" ::: "memory");
    if (live && lane < 16) {
        const LAS float* L = lw + lane * 80;
        float cm = L[0] * rstd + bco[0]; int grp = 0; float cv[8]; cv[0] = cm;
#pragma unroll
        for (int j = 1; j < 8; ++j) { cv[j] = L[j] * rstd + bco[j]; if (cv[j] > cm) { cm = cv[j]; grp = j; } }
        float den = 0.f;
#pragma unroll
        for (int j = 0; j < 8; ++j) den += fexp(cv[j] - cm);
        const float psel = 1.f / den;
        float f[8];
#pragma unroll
        for (int j = 0; j < 8; ++j) f[j] = L[8 + grp * 8 + j] * rstd + bfi[grp * 8 + j];
        int i0 = 0; float f0 = f[0];
#pragma unroll
        for (int j = 1; j < 8; ++j) if (f[j] > f0) { f0 = f[j]; i0 = j; }
        int i1 = -1; float f1 = 0.f;
#pragma unroll
        for (int j = 0; j < 8; ++j) if (j != i0 && (i1 < 0 || f[j] > f1)) { f1 = f[j]; i1 = j; }
        const float e1 = fexp(f1 - f0), w0 = psel / (1.f + e1), w1 = psel * e1 / (1.f + e1);
        ea_out = grp * 8 + i0; eb_out = grp * 8 + i1;
        TW[tok * 2] = w0; TW[tok * 2 + 1] = w1;
    }
}
}

constexpr int LDS_BYTES = 155648;
constexpr int LDS_MISC = 152576;

__global__ void __launch_bounds__(NTHR, 2) fwd_kernel(Args args) {
    extern __shared__ __attribute__((aligned(16))) unsigned char lds_raw[];
    LAS unsigned char* lds = (LAS unsigned char*)lds_raw;
    LAS float* ldsf = (LAS float*)lds;
    volatile LAS unsigned* MISC = (volatile LAS unsigned*)(lds + LDS_MISC);
    int tid = threadIdx.x; asm volatile("" : "+v"(tid));
    int lane = tid & 63, wave = __builtin_amdgcn_readfirstlane(tid >> 6);
#define GRID_SYNC() do { xcd_barrier(bar, tid); asm volatile("" : "+v"(tid)); lane = tid & 63; wave = __builtin_amdgcn_readfirstlane(tid >> 6); gw = bx * NWAVES + wave; } while (0)
    const int G = gridDim.x, bx = blockIdx.x;
    int gw = bx * NWAVES + wave; const int NGW = G * NWAVES;
    unsigned char* ws = args.ws;
    unsigned* ctl = (unsigned*)(ws + WS_CTL);
    if (tid < 64) MISC[tid] = 0u;
    __syncthreads();
    XcdBarrier bar = xcd_barrier_post(ctl + CW_BAR, MISC + 8, tid);

    const float* x = args.in[I_X];
    float* hbuf = args.out;
    float* LB = (float*)(ws + WS_SMALL);
    float* TW = (float*)(ws + WS_SMALL + 65536);
    unsigned short* LIST = (unsigned short*)(ws + WS_LIST);
    bf16* W_IN_T = (bf16*)(ws + WS_WIN); bf16* W_UA_T = (bf16*)(ws + WS_WUA); bf16* W_UR_T = (bf16*)(ws + WS_WUR);
    bf16* W_OUT_T = (bf16*)(ws + WS_WOUT); bf16* W_PG_T = (bf16*)(ws + WS_WPG); bf16* W_PI_T = (bf16*)(ws + WS_WPI);
    bf16* U = (bf16*)(ws + WS_RA); bf16* OREC = (bf16*)(ws + WS_RA); bf16* XN = (bf16*)(ws + WS_RA);
    bf16* QB = (bf16*)(ws + WS_RB); bf16* KVB = (bf16*)(ws + WS_RB + 64 * MiB); bf16* HID = (bf16*)(ws + WS_RB); bf16* PB = (bf16*)(ws + WS_PB);
    bf16* HG = (bf16*)(ws + WS_RC); bf16* MIX = (bf16*)(ws + WS_RC); bf16* Y = (bf16*)(ws + WS_RE);
    bf16* GT = (bf16*)(ws + WS_RD); bf16* W_DN_T = (bf16*)(ws + WS_RD); bf16* PL = (bf16*)(ws + WS_RD + 128 * MiB);
    bf16* W_GU_T = (bf16*)(ws + WS_RE);
    float* RSTDP = (float*)(ws + WS_SMALL + 393216); float* RSTD3 = (float*)(ws + WS_SMALL + 524288); float* RSTD2 = (float*)(ws + WS_SMALL + 655360);
    bf16* DELTA = (bf16*)(ws + WS_RC + 128 * MiB);
    bf16* H3B = (bf16*)(ws + WS_RC);
    bf16* WRH = (bf16*)(ws + 6 * MiB); bf16* WRL = (bf16*)(ws + 6 * MiB + 512 * 1024);
    float* UST = (float*)(ws + WS_RA + 64 * MiB); float* DST = (float*)(ws + WS_RA + 96 * MiB);
    float* SS_H1 = (float*)(ws + WS_SS); float* SS_PL = (float*)(ws + WS_SS + 4 * MiB); float* SS_FIN = (float*)(ws + WS_SS + 8 * MiB);
    unsigned* CNT = ctl + CW_CNT;
    LAS unsigned char* ring = lds;

#ifndef REP_P0
#define REP_P0 1
#endif
#ifndef REP_P1
#define REP_P1 1
#endif
#pragma unroll 1
    for (int rep = 0; rep < REP_P0; ++rep) {
        LAS float* scr = ldsf + wave * 4096;
        transpose_all(args.in[I_WIN], D, INC, W_IN_T, scr, gw, NGW, lane, D);
        transpose_all(args.in[I_WUA], QW, D, W_UA_T, scr, gw, NGW, lane, QW);
        transpose_all(args.in[I_WUR], HW, D, W_UR_T, scr, gw, NGW, lane, HW);
        transpose_all(args.in[I_WOUT], D, D, W_OUT_T, scr, gw, NGW, lane, D);
        transpose_all(args.in[I_WPG], D, D, W_PG_T, scr, gw, NGW, lane, D);
        transpose_all(args.in[I_WPI], PLE, D, W_PI_T, scr, gw, NGW, lane, PLE);
        for (int it = gw; it < (NEXP - 16) * 1024; it += NGW) { const int e = it >> 10, r = it & 1023, mat = r >> 9, item = r & 511;
            transpose_item(args.in[mat ? I_WU : I_WG] + (size_t)e * D * MH, D, MH, W_GU_T + (size_t)e * 1024 * D, scr, item, lane, 1 + mat, D, args.in[I_GFFN]); }
        for (int m = gw; m < NTOK; m += NGW) { const f32x4 pv = __builtin_nontemporal_load((const f32x4*)(args.in[I_P] + (size_t)m * PLE) + lane);
            v2u w; w.x = pk2(pv.x, pv.y); w.y = pk2(pv.z, pv.w); *((v2u*)(PB + (size_t)m * PLE) + lane) = w; }
        const float* gm = args.in[I_GMIX];
        for (int m = gw; m < NTOK; m += NGW) {
            const f32x4* xr = (const f32x4*)(x + (size_t)m * D) + lane;
            f32x4 v[8]; float s = 0.f;
#pragma unroll
            for (int j = 0; j < 8; ++j) { v[j] = __builtin_nontemporal_load(xr + 64 * j); s += (v[j].x * v[j].x + v[j].y * v[j].y) + (v[j].z * v[j].z + v[j].w * v[j].w); }
            const float rstd = rsqrtf(wave_sum(s) * (1.f / D) + EPS);
            v2u* o = (v2u*)(U + (size_t)m * D) + lane;
#pragma unroll
            for (int j = 0; j < 8; ++j) { const f32x4 g = *((const f32x4*)gm + 64 * j + lane); v2u w; w.x = pk2(v[j].x * rstd * g.x, v[j].y * rstd * g.y); w.y = pk2(v[j].z * rstd * g.z, v[j].w * rstd * g.w); o[64 * j] = w; }
        }
        rt::prep_w(args.in[I_WCO], args.in[I_WFI], args.in[I_GFFN], WRH, WRL, bx * NTHR + tid, G * NTHR);
        const float* lbl = args.in[I_LBL];
        for (int j = bx * NTHR + tid; j < HW; j += G * NTHR) LB[j] = 1.f / (1.f + __expf(lbl[HW + j] - lbl[j]));
    }
    GRID_SYNC();

#pragma unroll 1
    for (int rep = 0; rep < REP_P1; ++rep) {
        pg8::StaticOrder S; S.init(U, W_IN_T, NTOK, INC, D, D, G, bx);
        pg8::EpiZ E{args.in[I_BQKV], LB, QB, KVB, HG, GT};
        pg8::gemm_phase<pg8::EpiZ, pg8::StaticOrder, true, false>(ring, D, D, D, S, E, tid);
        const int nshort = G - (S.nwg % G);
        if (S.nwg % G != 0 && bx >= S.nwg % G) { LAS float* scr = ldsf + wave * 4096; const int sw = (bx - S.nwg % G) * NWAVES + wave, nsw = nshort * NWAVES;
            for (int it = sw; it < 16 * 1024; it += nsw) { const int e = (NEXP - 16) + (it >> 10), r = it & 1023, mat = r >> 9, item = r & 511;
                transpose_item(args.in[mat ? I_WU : I_WG] + (size_t)e * D * MH, D, MH, W_GU_T + (size_t)e * 1024 * D, scr, item, lane, 1 + mat, D, args.in[I_GFFN]); } }
        else if (S.nwg % G == 0) { LAS float* scr = ldsf + wave * 4096;
            for (int it = gw; it < 16 * 1024; it += NGW) { const int e = (NEXP - 16) + (it >> 10), r = it & 1023, mat = r >> 9, item = r & 511;
                transpose_item(args.in[mat ? I_WU : I_WG] + (size_t)e * D * MH, D, MH, W_GU_T + (size_t)e * 1024 * D, scr, item, lane, 1 + mat, D, args.in[I_GFFN]); } }
    }
    GRID_SYNC();

    for (int u = bx; u < 512; u += G) hg::unit<true>(lds, HG, OREC, UST, DST, args.in[I_GHGRN], u, tid);
    for (int it = bx; it < 2 * 128 * 2; it += G) at::item(lds, QB, KVB, args.in[I_SINKS], args.in[I_REL], it, tid);
    GRID_SYNC();

    hg::scan(UST, DST, bx * NTHR + tid, G * NTHR);
    GRID_SYNC();
    for (int u = bx; u < 512; u += G) hg::unit<false>(lds, HG, OREC, UST, DST, args.in[I_GHGRN], u, tid);
    GRID_SYNC();

    {
        pg8::PairOrder S; S.s0.init(QB, W_UA_T, NTOK, D, QW, QW, G, bx); S.A1 = (const char*)OREC; S.B1 = (const char*)W_UR_T;
        pg8::EpiMix E{GT, MIX, (unsigned char*)UST + (size_t)bx * 131072};
        pg8::gemm_phase<pg8::EpiMix, pg8::PairOrder, true, false>(ring, QW, QW, QW, S, E, tid);
    }
    GRID_SYNC();

    {
        pg8::StaticOrder S; S.init(MIX, W_OUT_T, NTOK, D, D, D, G, bx);
        pg8::EpiDelta E{DELTA};
        pg8::gemm_phase<pg8::EpiDelta, pg8::StaticOrder, true, false, 1>(ring, D, D, D, S, E, tid);
    }
    GRID_SYNC();

    {
        {
            LAS float* scr = ldsf + wave * 4096;
            for (int it = gw; it < NEXP * 512; it += NGW) { const int e = it >> 9, item = it & 511;
                transpose_item(args.in[I_WD] + (size_t)e * MH * D, MH, D, W_DN_T + (size_t)e * D * MH, scr, item, lane, 0, MH); }
        }
        __syncthreads();
        LAS unsigned* hist = (LAS unsigned*)(lds + rt::L_HIST);
        for (int i = 0; i * NGW < NTOK / 16; ++i) {
            const int tl = gw + i * NGW; const bool live = tl < NTOK / 16;
            __syncthreads();
            if (tid < 64) hist[tid] = 0u;
            int ea = 0, eb = 0; unsigned ra = 0u, rb = 0u;
            rt::pass(lds, x, DELTA, RSTD2, args.in[I_GFFN], WRH, WRL, args.in[I_BCO], args.in[I_BFI], XN, TW, tl, live, tid, ea, eb);
            if (live && lane < 16) { ra = atomicAdd((unsigned*)(hist + ea), 1u); rb = atomicAdd((unsigned*)(hist + eb), 1u); }
            __syncthreads();
            if (tid < 64) { const unsigned c = hist[tid]; hist[64 + tid] = c ? atomicAdd(CNT + 64 * tid, c) : 0u; }
            __syncthreads();
            if (live && lane < 16) { const int m = tl * 16 + lane;
                LIST[(size_t)ea * NTOK + hist[64 + ea] + ra] = (unsigned short)m; LIST[(size_t)eb * NTOK + hist[64 + eb] + rb] = (unsigned short)(m | 0x8000); }
        }
    }
    GRID_SYNC();

    LAS int* eoff = (LAS int*)(lds + 150528);
    LAS int* ecnt = (LAS int*)(lds + 150528 + 512);
    if (tid < 64) {
        const int c = (int)__hip_atomic_load(CNT + 64 * tid, __ATOMIC_RELAXED, __HIP_MEMORY_SCOPE_AGENT); int v = (c + 255) & ~255;
#pragma unroll
        for (int d = 1; d < 64; d <<= 1) { const int t = __shfl_up(v, d); if (lane >= d) v += t; }
        ecnt[tid] = c; eoff[tid] = v - ((c + 255) & ~255); if (tid == 63) eoff[NEXP] = v;
    }
    __syncthreads();
    const int vcu = (G % 8 == 0) ? (bx % 8) * (G / 8) + bx / 8 : bx;
    const int nrb = eoff[NEXP] / 256;
    {
        pg8::MoeOrder S{eoff, ecnt, 4, G, vcu, nrb, (const char*)XN, (const char*)W_GU_T, (size_t)1024 * D * 2, (size_t)256 * D * 2, (size_t)D * 2, LIST, 1};
        pg8::EpiGateUp E{HID, LIST, RSTD2};
        pg8::gemm_phase<pg8::EpiGateUp, pg8::MoeOrder, true, true>(ring, D, D, D, S, E, tid);
    }
    GRID_SYNC();
    {
        pg8::MoeOrder S{eoff, ecnt, 8, G, vcu, nrb, (const char*)HID, (const char*)W_DN_T, (size_t)D * MH * 2, (size_t)256 * MH * 2, (size_t)MH * 2, LIST, 0};
        pg8::EpiDown E{LIST, TW, Y};
        pg8::gemm_phase<pg8::EpiDown, pg8::MoeOrder, true, false>(ring, MH, MH, MH, S, E, tid);
    }
    {
        pg8::StaticOrder S; S.init(PB, W_PI_T, NTOK, D, PLE, PLE, G, bx);
        pg8::EpiPleRaw E{PL, SS_PL};
        pg8::gemm_phase<pg8::EpiPleRaw, pg8::StaticOrder, true, false>(ring, PLE, PLE, PLE, S, E, tid);
    }
    GRID_SYNC();

    {
        for (int m = gw; m < NTOK; m += NGW) {
            const v2u* hb = (const v2u*)(XN + (size_t)m * D) + lane;
            const v2u* y0 = (const v2u*)(Y + (size_t)m * D) + lane; const v2u* y1 = (const v2u*)(Y + (size_t)NTOK * D + (size_t)m * D) + lane;
            v2u* o = (v2u*)(XN + (size_t)m * D) + lane;
            float s = 0.f;
#pragma unroll
            for (int j = 0; j < 8; ++j) { const v2u a = __builtin_nontemporal_load(y0 + 64 * j), c = __builtin_nontemporal_load(y1 + 64 * j), dd = __builtin_nontemporal_load(hb + 64 * j);
                f32x4 v; v.x = __uint_as_float(dd.x << 16); v.y = __uint_as_float(dd.x & 0xffff0000u); v.z = __uint_as_float(dd.y << 16); v.w = __uint_as_float(dd.y & 0xffff0000u);
                v.x += __uint_as_float(a.x << 16) + __uint_as_float(c.x << 16); v.y += __uint_as_float(a.x & 0xffff0000u) + __uint_as_float(c.x & 0xffff0000u);
                v.z += __uint_as_float(a.y << 16) + __uint_as_float(c.y << 16); v.w += __uint_as_float(a.y & 0xffff0000u) + __uint_as_float(c.y & 0xffff0000u);
                s += (v.x * v.x + v.y * v.y) + (v.z * v.z + v.w * v.w);
                v2u w; w.x = hg::cvtpk(v.x, v.y); w.y = hg::cvtpk(v.z, v.w); o[64 * j] = w; }
            const float ssum = wave_sum(s);
            const float sp = wave_sum(lane < 32 ? SS_PL[(size_t)m * 32 + lane] : 0.f);
            if (lane == 0) { RSTD3[m] = rsqrtf(ssum * (1.f / D) + EPS); RSTDP[m] = rsqrtf(sp * (1.f / D) + EPS); }
        }
    }
    GRID_SYNC();

    {
        pg8::StaticOrder S; S.init(XN, W_PG_T, NTOK, D, D, D, G, bx);
        pg8::EpiPleGate E{XN, H3B, PL, RSTD3, RSTDP, args.in[I_GPLE], SS_FIN};
        pg8::gemm_phase<pg8::EpiPleGate, pg8::StaticOrder, true, false>(ring, D, D, D, S, E, tid);
    }
    GRID_SYNC();

    {
        const float* gfin = args.in[I_GFIN];
        f32x4 gv[8];
#pragma unroll
        for (int j = 0; j < 8; ++j) gv[j] = *((const f32x4*)gfin + 64 * j + lane);
        for (int m = gw; m < NTOK; m += 2 * NGW) {
            const int m1 = (m + NGW < NTOK) ? m + NGW : m;
            f32x4* o0 = (f32x4*)(hbuf + (size_t)m * D) + lane; f32x4* o1 = (f32x4*)(hbuf + (size_t)m1 * D) + lane;
            const v2u* h0 = (const v2u*)(H3B + (size_t)m * D) + lane; const v2u* h1 = (const v2u*)(H3B + (size_t)m1 * D) + lane;
            v2u a0[8], a1[8];
#pragma unroll
            for (int j = 0; j < 8; ++j) { a0[j] = __builtin_nontemporal_load(h0 + 64 * j); a1[j] = __builtin_nontemporal_load(h1 + 64 * j); }
            const float s0 = wave_sum(lane < 32 ? SS_FIN[(size_t)m * 32 + lane] : 0.f), s1 = wave_sum(lane < 32 ? SS_FIN[(size_t)m1 * 32 + lane] : 0.f);
            const float r0 = rsqrtf(s0 * (1.f / D) + EPS), r1 = rsqrtf(s1 * (1.f / D) + EPS);
#pragma unroll
            for (int j = 0; j < 8; ++j) { f32x4 y;
                y.x = __uint_as_float(a0[j].x << 16) * r0 * gv[j].x; y.y = __uint_as_float(a0[j].x & 0xffff0000u) * r0 * gv[j].y; y.z = __uint_as_float(a0[j].y << 16) * r0 * gv[j].z; y.w = __uint_as_float(a0[j].y & 0xffff0000u) * r0 * gv[j].w;
                __builtin_nontemporal_store(y, o0 + 64 * j);
                y.x = __uint_as_float(a1[j].x << 16) * r1 * gv[j].x; y.y = __uint_as_float(a1[j].x & 0xffff0000u) * r1 * gv[j].y; y.z = __uint_as_float(a1[j].y << 16) * r1 * gv[j].z; y.w = __uint_as_float(a1[j].y & 0xffff0000u) * r1 * gv[j].w;
                __builtin_nontemporal_store(y, o1 + 64 * j); }
        }
    }
}

extern "C" void kernel_launch(void* const* d_in, const int* in_sizes, int n_in, void* d_out, int out_size, void* d_ws, size_t ws_size, hipStream_t stream) {
    static int grid = 0;
    if (grid == 0) {
        if (n_in != 24 || out_size != NTOK * D || ws_size < WS_END) { fprintf(stderr, "kernel_launch: unexpected shapes (n_in %d, out %d, ws %zu)\n", n_in, out_size, ws_size); grid = -1; return; }
        int dev = 0, cus = 0;
        if (hipGetDevice(&dev) != hipSuccess || hipDeviceGetAttribute(&cus, hipDeviceAttributeMultiprocessorCount, dev) != hipSuccess) { grid = -1; return; }
        if (hipFuncSetAttribute((const void*)fwd_kernel, hipFuncAttributeMaxDynamicSharedMemorySize, LDS_BYTES) != hipSuccess) { fprintf(stderr, "kernel_launch: hipFuncSetAttribute failed\n"); grid = -1; return; }
        int per_cu = 0;
        if (hipOccupancyMaxActiveBlocksPerMultiprocessor(&per_cu, (const void*)fwd_kernel, NTHR, LDS_BYTES) != hipSuccess || per_cu < 1) { fprintf(stderr, "kernel_launch: occupancy query says %d\n", per_cu); }
        (void)hipGetLastError();
        grid = cus;
    }
    if (grid < 0) return;
    if (hipMemsetAsync((char*)d_ws + WS_CTL, 0, CTL_ZERO_BYTES, stream) != hipSuccess) return;
    Args a{};
    for (int i = 0; i < 24; ++i) a.in[i] = (const float*)d_in[i];
    a.out = (float*)d_out; a.ws = (unsigned char*)d_ws;
    hipLaunchKernelGGL(fwd_kernel, dim3(grid), dim3(NTHR), LDS_BYTES, stream, a);
}
```

```cpp
#include <hip/hip_runtime.h>
#include <cstdio>
#include <cstdint>

#define GAS __attribute__((address_space(1)))
#define LAS __attribute__((address_space(3)))
typedef unsigned short bf16;
typedef float f32x4 __attribute__((ext_vector_type(4)));
typedef unsigned v4u __attribute__((ext_vector_type(4)));
typedef unsigned v2u __attribute__((ext_vector_type(2)));

constexpr int NTOK = 32768, SEQ = 16384, D = 2048;
constexpr int QW = 1024, KVW = 128, QKVW = 1280, HW = 1024, INC = 9472;
constexpr int NEXP = 64, MH = 512, PLE = 256;
constexpr float EPS = 1e-6f;
constexpr int NWAVES = 8, NTHR = 512;
constexpr size_t HGPS = (size_t)NTOK * 128;
constexpr int HIDCAP = 81920;

constexpr size_t MiB = 1u << 20;
constexpr size_t WS_CTL = 0, CTL_ZERO_BYTES = 1 * MiB;
constexpr size_t WS_SMALL = 1 * MiB;
constexpr size_t WS_LIST = 2 * MiB;
constexpr size_t WS_WIN = 8 * MiB, WS_WUA = 45 * MiB, WS_WUR = 49 * MiB, WS_WOUT = 53 * MiB, WS_WPG = 61 * MiB, WS_WPI = 69 * MiB;
constexpr size_t WS_RA = 70 * MiB;
constexpr size_t WS_RB = 198 * MiB;
constexpr size_t WS_RC = 278 * MiB;
constexpr size_t WS_RD = 534 * MiB;
constexpr size_t WS_RE = 790 * MiB;
constexpr size_t WS_PB = 1046 * MiB;
constexpr size_t WS_SS = 1062 * MiB;
constexpr size_t WS_END = 1074 * MiB;
constexpr int CW_BAR = 4096;
constexpr int CW_CNT = 16384;
constexpr int CW_PACE = 32768;

__device__ __forceinline__ float bf2f(bf16 h) { return __uint_as_float(((unsigned)h) << 16); }
__device__ __forceinline__ unsigned f2bf(float f) { unsigned u = __float_as_uint(f); return (u + 0x7fffu + ((u >> 16) & 1u)) >> 16; }
__device__ __forceinline__ unsigned pk2(float lo, float hi) { return f2bf(lo) | (f2bf(hi) << 16); }
constexpr float LOG2E = 1.4426950408889634f;
__device__ __forceinline__ float fexp2(float x) { return __builtin_amdgcn_exp2f(x); }
__device__ __forceinline__ float fexp(float x) { return __builtin_amdgcn_exp2f(x * LOG2E); }
__device__ __forceinline__ float flog2(float x) { return __builtin_amdgcn_logf(x); }
__device__ __forceinline__ float wave_sum(float v) {
#pragma unroll
    for (int o = 1; o < 64; o <<= 1) v += __shfl_xor(v, o);
    return v;
}

#define XB_TMO      128
#define XB_XCNT(j)  (256  + 64 * (j))
#define XB_XSUB(j)  (1280 + 64 * (j))
#define XB_XGEN(j)  (2304 + 64 * (j))
#define XB_TOP      3328
#define XB_TOPGEN   3392
#define XCD_BAR_WORDS 3456
#define XB_SPIN_CAP (1u << 23)
__device__ __forceinline__ unsigned xb_ld(unsigned* p)              { return __hip_atomic_load(p, __ATOMIC_RELAXED, __HIP_MEMORY_SCOPE_AGENT); }
__device__ __forceinline__ unsigned xb_add(unsigned* p, unsigned v) { return __hip_atomic_fetch_add(p, v, __ATOMIC_RELAXED, __HIP_MEMORY_SCOPE_AGENT); }
__device__ __forceinline__ unsigned xb_xcc_id() { return (unsigned)__builtin_amdgcn_s_getreg((3 << 11) | 20) & 0xFu; }
#define XB_SPIN(cond, bar) do { unsigned _sp = 0; while (cond) { __builtin_amdgcn_s_sleep(1); \
    if ((++_sp & 255u) == 0u) { if (xb_ld(&(bar)[XB_TMO])) break; if (_sp > XB_SPIN_CAP) { atomicAdd(&(bar)[XB_TMO], 1u); break; } } } } while (0)
struct XcdBarrier { unsigned* bar; unsigned x; volatile LAS unsigned* st; };
__device__ __forceinline__ XcdBarrier xcd_barrier_post(unsigned* bar, volatile LAS unsigned* st, const int tid) {
    XcdBarrier b; b.bar = bar; b.x = xb_xcc_id(); b.st = st;
    if (tid == 0) (void)xb_add(&bar[XB_XCNT(b.x)], 1u);
    return b;
}
__device__ __forceinline__ void xcd_barrier_complete(unsigned* bar, unsigned x, unsigned& nloc, unsigned& nx) {
    const unsigned G = gridDim.x * gridDim.y * gridDim.z;
    unsigned sum, cnt, mine, sp = 0u;
    for (;;) {
        sum = 0u; cnt = 0u; mine = 0u;
#pragma unroll
        for (unsigned j = 0; j < 16; ++j) { const unsigned c = xb_ld(&bar[XB_XCNT(j)]); sum += c; cnt += (c > 0u) ? 1u : 0u; mine = (j == x) ? c : mine; }
        if (sum == G) break;
        __builtin_amdgcn_s_sleep(1);
        if ((++sp & 255u) == 0u) { if (xb_ld(&bar[XB_TMO])) break; if (sp > XB_SPIN_CAP) { atomicAdd(&bar[XB_TMO], 1u); break; } }
    }
    nloc = mine > 0u ? mine : 1u; nx = cnt > 0u ? cnt : 1u;
}
__device__ __forceinline__ void xcd_barrier(const XcdBarrier& b, const int tid) {
    asm volatile("s_waitcnt vmcnt(0)" ::: "memory");
    __syncthreads();
    if (tid == 0) {
        unsigned* bar = b.bar;
        __builtin_amdgcn_s_waitcnt(0);
        unsigned nloc = b.st[0], nx = b.st[1];
        if (nloc == 0u) { xcd_barrier_complete(bar, b.x, nloc, nx); b.st[0] = nloc; b.st[1] = nx; }
        const unsigned old = xb_add(&bar[XB_XSUB(b.x)], 1u);
        const unsigned gen = old / nloc;
        if (old + 1u == (gen + 1u) * nloc) {
            __builtin_amdgcn_fence(__ATOMIC_RELEASE, "agent");
            asm volatile("s_waitcnt vmcnt(0)" ::: "memory");
            const unsigned og = xb_add(&bar[XB_TOP], 1u);
            const unsigned tg = og / nx;
            if (og + 1u == (tg + 1u) * nx) xb_add(&bar[XB_TOPGEN], 1u);
            else XB_SPIN(xb_ld(&bar[XB_TOPGEN]) == tg, bar);
            __builtin_amdgcn_fence(__ATOMIC_ACQUIRE, "agent");
            xb_add(&bar[XB_XGEN(b.x)], 1u);
            asm volatile("s_waitcnt vmcnt(0)" ::: "memory");
        } else {
            XB_SPIN(xb_ld(&bar[XB_XGEN(b.x)]) == gen, bar);
            __builtin_amdgcn_fence(__ATOMIC_ACQUIRE, "agent");
            asm volatile("s_waitcnt vmcnt(0)" ::: "memory");
        }
    }
    __syncthreads();
}

struct Args {
    const float* in[24];
    float* out;
    unsigned char* ws;
};
enum { I_X = 0, I_P, I_GMIX, I_WIN, I_BQKV, I_SINKS, I_REL, I_LBL, I_GHGRN, I_WUA, I_WUR, I_WOUT, I_GFFN, I_WCO, I_BCO, I_WFI, I_BFI,
       I_WG, I_WU, I_WD, I_WPI, I_GPLE, I_WPG, I_GFIN };

__device__ __forceinline__ void transpose_item(const float* W, int K, int N, bf16* WT, LAS float* scr, int item, int lane, int gu, int ldw, const float* ks = nullptr) {
    const int nblk = N / 32, kb = item / nblk, nb = item % nblk, k0 = 64 * kb, n0 = 32 * nb;
    const int d0 = gu ? (256 * (n0 >> 7) + 128 * (gu - 1) + (n0 & 127)) : n0;
#pragma unroll 8
    for (int i = 0; i < 32; ++i) { const int kk = 2 * i + (lane >> 5); scr[kk * 33 + (lane & 31)] = __builtin_nontemporal_load(W + (size_t)(k0 + kk) * N + n0 + (lane & 31)); }
    asm volatile("s_waitcnt lgkmcnt(0)" ::: "memory");
    const int c = lane & 7;
    f32x4 k0s = (f32x4){1.f, 1.f, 1.f, 1.f}, k1s = k0s; if (ks) { k0s = *(const f32x4*)(ks + k0 + 8 * c); k1s = *(const f32x4*)(ks + k0 + 8 * c + 4); }
#pragma unroll
    for (int j = 0; j < 4; ++j) { const int n = (lane >> 3) + 8 * j; const LAS float* s = scr + (8 * c) * 33 + n;
        v4u o; o.x = pk2(s[0 * 33] * k0s[0], s[1 * 33] * k0s[1]); o.y = pk2(s[2 * 33] * k0s[2], s[3 * 33] * k0s[3]); o.z = pk2(s[4 * 33] * k1s[0], s[5 * 33] * k1s[1]); o.w = pk2(s[6 * 33] * k1s[2], s[7 * 33] * k1s[3]);
        *(v4u*)(WT + (size_t)(d0 + n) * ldw + k0 + 8 * c) = o; }
    asm volatile("s_waitcnt lgkmcnt(0)" ::: "memory");
}
__device__ __forceinline__ void transpose_all(const float* W, int K, int N, bf16* WT, LAS float* scr, int gw, int ngw, int lane, int ldw) {
    const int nitems = (K / 64) * (N / 32);
    for (int it = gw; it < nitems; it += ngw) transpose_item(W, K, N, WT, scr, it, lane, 0, ldw);
}

namespace pg8 {
typedef short bf16x8 __attribute__((ext_vector_type(8)));
typedef unsigned u32x4 __attribute__((ext_vector_type(4)));
constexpr int BM = 256, BK = 64, HALF = 128, HTB = HALF * BK * 2, STAGE_BYTES = 8 * HTB, NXCD = 8, WGM = 8;
__host__ __device__ __forceinline__ int lds_byte(int r, int c) { const int st = (r >> 4) * 2 + (c >> 5), rr = r & 15, cc = c & 31, ob = rr * 64 + cc * 2; return st * 1024 + (ob ^ (((ob >> 9) & 1) << 5)); }
__host__ __device__ __forceinline__ void stage_rc(int b, int& R, int& C) { const int st = b / 1024, sb = b % 1024, swz = sb ^ (((sb >> 9) & 1) << 5); R = (st >> 1) * 16 + swz / 64; C = (st & 1) * 32 + (swz % 64) / 2; }
__host__ __device__ __forceinline__ int perm32(int rho) { const int n = rho >> 4, i = rho & 15; return 8 * (i >> 2) + 4 * n + (i & 3); }
struct Unit { int pm, pn; const char* a; const char* b; int e, r0, cnt, row0; };
typedef __bf16 bfv2_t __attribute__((ext_vector_type(2))); typedef float fv2_t __attribute__((ext_vector_type(2)));
__device__ __forceinline__ unsigned cvt_pk_bf16(float lo, float hi) { fv2_t v; v.x = lo; v.y = hi; return __builtin_bit_cast(unsigned, __builtin_convertvector(v, bfv2_t)); }

struct StaticOrder {
    int nM, nN, nwg, G, c; const char* A; const char* Bt; size_t tstepA, tstepB;
    __device__ __forceinline__ void init(const bf16* A_, const bf16* Bt_, int M, int N, int lda, int ldb, int G_, int c_) { nM = M / BM; nN = N / BM; nwg = nM * nN; G = G_; c = c_; A = (const char*)A_; Bt = (const char*)Bt_; tstepA = (size_t)BM * lda * 2; tstepB = (size_t)BM * ldb * 2; pace = nullptr; }
    __device__ __forceinline__ bool next(int i, Unit& u) const {
        const long L = (long)i * G + c; if (L >= nwg) return false;
        int wgid = (int)L; { const int q = nwg / NXCD, r = nwg % NXCD, xcd = wgid % NXCD, off = wgid / NXCD; wgid = (xcd < r ? xcd * (q + 1) : r * (q + 1) + (xcd - r) * q) + off; }
        const int nig = WGM * nN, gid = wgid / nig, fm = gid * WGM, gsz = (nM - fm) < WGM ? (nM - fm) : WGM;
        u.pm = fm + ((wgid % nig) % gsz); u.pn = (wgid % nig) / gsz; u.a = A + (size_t)u.pm * tstepA; u.b = Bt + (size_t)u.pn * tstepB; u.e = 0; u.r0 = 0; u.cnt = 0; u.row0 = 0; return true;
    }
    __device__ __forceinline__ unsigned row_off(const Unit&, int) const { return 0u; }
    unsigned* pace;
    __device__ __forceinline__ void pace_arrive_wait(int ui, int wid, int lane) const {
        if (pace == nullptr || wid != 0) return;
        unsigned* p = pace + 64 * (c & 7);
        if (lane == 0) __hip_atomic_fetch_add(p, 1u, __ATOMIC_RELAXED, __HIP_MEMORY_SCOPE_AGENT);
        const unsigned want = (unsigned)(G >> 3) * (unsigned)(ui + 1);
        for (int sp = 0; sp < 4096; ++sp) { if (__hip_atomic_load(p, __ATOMIC_RELAXED, __HIP_MEMORY_SCOPE_AGENT) >= want) break; __builtin_amdgcn_s_sleep(2); }
    }
    __device__ __forceinline__ void pace_finish(int units_done, int wid, int lane) const {
        if (pace == nullptr || wid != 0 || lane != 0) return;
        const int rmax = (nwg + G - 1) / G;
        if (units_done < rmax) __hip_atomic_fetch_add(pace + 64 * (c & 7), (unsigned)(rmax - units_done), __ATOMIC_RELAXED, __HIP_MEMORY_SCOPE_AGENT);
    }
};

struct PairOrder {
    StaticOrder s0; const char* A1; const char* B1;
    __device__ __forceinline__ bool next(int i, Unit& u) const {
        if (!s0.next(i >> 1, u)) return false;
        if (i & 1) { u.a = A1 + (size_t)u.pm * s0.tstepA; u.b = B1 + (size_t)u.pn * s0.tstepB; u.e = 1; }
        return true;
    }
    __device__ __forceinline__ unsigned row_off(const Unit&, int) const { return 0u; }
    __device__ __forceinline__ void pace_arrive_wait(int, int, int) const {}
    __device__ __forceinline__ void pace_finish(int, int, int) const {}
};

template <class Epi, class Sched, bool ALIGN_EPI, bool GATHER>
__device__ __forceinline__ void gemm_phase(LAS unsigned char* lds, const int K, const int lda, const int ldb, const Sched& S, const Epi& E, const int tid) {
    const int wid = __builtin_amdgcn_readfirstlane(tid >> 6), lane = tid & 63, wr = wid >> 2, wc = wid & 3, fr = lane & 15, fq = lane >> 4;
    const int nt = K / BK;
    int Rr[2], Cc[2];
    unsigned voffA[2][2], voffB[2][2], voffAn[2][2];
#pragma unroll
    for (int i = 0; i < 2; ++i) { stage_rc(tid * 16 + i * 8192, Rr[i], Cc[i]); const int Rb = Epi::PERM ? ((Rr[i] & ~31) + perm32(Rr[i] & 31)) : Rr[i];
#pragma unroll
        for (int h = 0; h < 2; ++h) { voffB[h][i] = (unsigned)((h * HALF + Rb) * ldb + Cc[i]) * 2u; voffA[h][i] = (unsigned)((h * HALF + Rr[i]) * lda + Cc[i]) * 2u; voffAn[h][i] = voffA[h][i]; } }
    const size_t kstep = (size_t)(BK * 2);
    const unsigned ldsw = (unsigned)wid * 1024u;
    const int aoff = lds_byte(wr * 64 + fr, fq * 8), boff = lds_byte(wc * 32 + fr, fq * 8);
#define PG8_SA(b, h) (((b) * 2 + (h)) * HTB)
#define PG8_SB(b, h) ((4 + (b) * 2 + (h)) * HTB)
#define PG8_STAGE(bufoff, gbase, voff) do { const char* _gb = (const char*)(gbase); asm volatile("" : "+s"(_gb));     \
        _Pragma("unroll") for (int _i = 0; _i < 2; ++_i) \
        __builtin_amdgcn_global_load_lds((const unsigned*)(_gb + (voff)[_i]), (LAS unsigned*)(lds + (bufoff) + ldsw + _i * 8192), 16, 0, 0); } while (0)
#define PG8_LDA(dst, b, h) do { _Pragma("unroll") for (int m = 0; m < 4; ++m) _Pragma("unroll") for (int k = 0; k < 2; ++k) dst[m][k] = *(const LAS bf16x8*)(lds + PG8_SA(b, h) + aoff + m * 2048 + k * 1024); } while (0)
#define PG8_LDB(dst, b, h) do { _Pragma("unroll") for (int n = 0; n < 2; ++n) _Pragma("unroll") for (int k = 0; k < 2; ++k) dst[n][k] = *(const LAS bf16x8*)(lds + PG8_SB(b, h) + boff + n * 2048 + k * 1024); } while (0)
#define PG8_MMA(ai, bj, At, Bt) do { __builtin_amdgcn_s_setprio(1); _Pragma("unroll") for (int m = 0; m < 4; ++m) _Pragma("unroll") for (int n = 0; n < 2; ++n) _Pragma("unroll") for (int k = 0; k < 2; ++k) \
        acc[ai][bj][m][n] = __builtin_amdgcn_mfma_f32_16x16x32_bf16(Bt[n][k], At[m][k], acc[ai][bj][m][n], 0, 0, 0); __builtin_amdgcn_s_setprio(0); } while (0)
#define PG8_WAIT_V(n) asm volatile("s_waitcnt vmcnt(" #n ")" ::: "memory")
#define PG8_WAIT_L(n) asm volatile("s_waitcnt lgkmcnt(" #n ")" ::: "memory")
#define PG8_BAR __builtin_amdgcn_s_barrier()
#define PG8_SCHED __builtin_amdgcn_sched_barrier(0)
    Unit cur, nxt; int ui = 0;
    if (!S.next(0, cur)) return;
    if constexpr (GATHER) {
#pragma unroll
        for (int h = 0; h < 2; ++h)
#pragma unroll
            for (int i = 0; i < 2; ++i) voffA[h][i] = S.row_off(cur, h * HALF + Rr[i]) + (unsigned)Cc[i] * 2u;
    }
    f32x4 acc[2][2][4][2];
#pragma unroll
    for (int a = 0; a < 2; ++a)
#pragma unroll
        for (int b = 0; b < 2; ++b)
#pragma unroll
            for (int m = 0; m < 4; ++m)
#pragma unroll
                for (int n = 0; n < 2; ++n) acc[a][b][m][n] = (f32x4){0.f, 0.f, 0.f, 0.f};
    bf16x8 At[4][2], B0[2][2], B1[2][2];
    const char* cA = cur.a; const char* cB = cur.b;
    PG8_STAGE(PG8_SB(0, 0), cB, voffB[0]); PG8_STAGE(PG8_SB(0, 1), cB, voffB[1]); PG8_STAGE(PG8_SA(0, 0), cA, voffA[0]); PG8_STAGE(PG8_SA(0, 1), cA, voffA[1]);
    if (wr == 1) PG8_BAR;
    PG8_WAIT_V(2); PG8_BAR;
    PG8_STAGE(PG8_SB(1, 0), cB + kstep, voffB[0]); PG8_STAGE(PG8_SA(1, 0), cA + kstep, voffA[0]); PG8_STAGE(PG8_SB(1, 1), cB + kstep, voffB[1]);
    PG8_WAIT_V(6); PG8_BAR;
    for (;;) {
        const bool has_next = S.next(ui + 1, nxt);
        const char* nA = has_next ? nxt.a : cA; const char* nB = has_next ? nxt.b : cB;
        if constexpr (GATHER) {
#pragma unroll
            for (int h = 0; h < 2; ++h)
#pragma unroll
                for (int i = 0; i < 2; ++i) voffAn[h][i] = has_next ? S.row_off(nxt, h * HALF + Rr[i]) + (unsigned)Cc[i] * 2u : voffA[h][i];
        }
        for (int t = 0; t < nt; t += 2) {
            const bool last = (t == nt - 2);
            if (last) S.pace_arrive_wait(ui, wid, lane);
            const char* a1 = cA + (size_t)(t + 1) * kstep;
            const char* a2 = last ? nA : cA + (size_t)(t + 2) * kstep; const char* b2 = last ? nB : cB + (size_t)(t + 2) * kstep;
            const char* a3 = a2 + kstep; const char* b3 = b2 + kstep;
            PG8_LDB(B0, 0, 0); PG8_LDB(B1, 0, 1); PG8_SCHED; PG8_LDA(At, 0, 0); PG8_STAGE(PG8_SA(1, 1), a1, voffA[1]);
            if constexpr (GATHER) { if (last) {
#pragma unroll
                for (int h = 0; h < 2; ++h)
#pragma unroll
                    for (int i = 0; i < 2; ++i) voffA[h][i] = voffAn[h][i]; } }
            PG8_WAIT_V(8); PG8_WAIT_L(0); PG8_BAR; PG8_MMA(0, 0, At, B0); PG8_MMA(0, 1, At, B1); PG8_BAR; PG8_SCHED;
            PG8_LDA(At, 0, 1); PG8_STAGE(PG8_SB(0, 0), b2, voffB[0]); PG8_STAGE(PG8_SB(0, 1), b2, voffB[1]); PG8_STAGE(PG8_SA(0, 0), a2, voffA[0]);
            PG8_WAIT_V(8); PG8_WAIT_L(0); PG8_BAR; PG8_MMA(1, 0, At, B0); PG8_MMA(1, 1, At, B1); PG8_BAR; PG8_SCHED;
            PG8_LDB(B0, 1, 0); PG8_LDB(B1, 1, 1); PG8_SCHED; PG8_LDA(At, 1, 0); PG8_STAGE(PG8_SA(0, 1), a2, voffA[1]);
            PG8_WAIT_V(8); PG8_WAIT_L(0); PG8_BAR; PG8_MMA(0, 0, At, B0); PG8_MMA(0, 1, At, B1); PG8_BAR; PG8_SCHED;
            PG8_LDA(At, 1, 1); PG8_STAGE(PG8_SB(1, 0), b3, voffB[0]); PG8_STAGE(PG8_SB(1, 1), b3, voffB[1]); PG8_STAGE(PG8_SA(1, 0), a3, voffA[0]);
            PG8_WAIT_V(8); PG8_WAIT_L(0); PG8_BAR; PG8_MMA(1, 0, At, B0); PG8_MMA(1, 1, At, B1); PG8_BAR; PG8_SCHED;
        }
        if constexpr (ALIGN_EPI) { if (wr == 0) PG8_BAR; }
        E(acc, cur, wr, wc, fr, fq);
        if (!has_next) { S.pace_finish(ui + 1, wid, lane); break; }
#pragma unroll
        for (int a = 0; a < 2; ++a)
#pragma unroll
            for (int b = 0; b < 2; ++b)
#pragma unroll
                for (int m = 0; m < 4; ++m)
#pragma unroll
                    for (int n = 0; n < 2; ++n) acc[a][b][m][n] = (f32x4){0.f, 0.f, 0.f, 0.f};
        cur = nxt; cA = nA; cB = nB; ++ui;
        if constexpr (ALIGN_EPI) { if (wr == 1) PG8_BAR; }
    }
    PG8_WAIT_V(0);
    if constexpr (!ALIGN_EPI) { if (wr == 0) PG8_BAR; }
    PG8_BAR;
#undef PG8_SA
#undef PG8_SB
#undef PG8_STAGE
#undef PG8_LDA
#undef PG8_LDB
#undef PG8_MMA
#undef PG8_WAIT_V
#undef PG8_WAIT_L
#undef PG8_BAR
#undef PG8_SCHED
}

__device__ __forceinline__ float fsig(float x) { return __builtin_amdgcn_rcpf(1.f + fexp2(x * -LOG2E)); }
__device__ __forceinline__ u32x4 pack8(const f32x4 a, const f32x4 b) { u32x4 w; w.x = cvt_pk_bf16(a[0], a[1]); w.y = cvt_pk_bf16(a[2], a[3]); w.z = cvt_pk_bf16(b[0], b[1]); w.w = cvt_pk_bf16(b[2], b[3]); return w; }
__device__ __forceinline__ void unpack8(const u32x4 w, f32x4& a, f32x4& b) {
    a[0] = __uint_as_float(w.x << 16); a[1] = __uint_as_float(w.x & 0xffff0000u); a[2] = __uint_as_float(w.y << 16); a[3] = __uint_as_float(w.y & 0xffff0000u);
    b[0] = __uint_as_float(w.z << 16); b[1] = __uint_as_float(w.z & 0xffff0000u); b[2] = __uint_as_float(w.w << 16); b[3] = __uint_as_float(w.w & 0xffff0000u); }

template <int MODE>
__device__ __forceinline__ void epiz_body(const f32x4 (&acc)[2][2][4][2], bf16* base, const int ldc, const int row0, const int oc, const float* vec, const int img_off = 0, const size_t bjs = HALF) {
    f32x4 bv[2][2];
#pragma unroll
    for (int bj = 0; bj < 2; ++bj)
#pragma unroll
        for (int n = 0; n < 2; ++n) bv[bj][n] = (MODE == 0 || MODE == 1 || MODE == 3) ? *(const f32x4*)(vec + bj * HALF + 4 * n) : (f32x4){0.f, 0.f, 0.f, 0.f};
#pragma unroll
    for (int ai = 0; ai < 2; ++ai)
#pragma unroll
        for (int m = 0; m < 4; ++m) { bf16* rowp = base + (size_t)(row0 + ai * HALF + m * 16) * ldc + oc;
#pragma unroll
            for (int bj = 0; bj < 2; ++bj) { f32x4 v[2];
#pragma unroll
                for (int n = 0; n < 2; ++n) { f32x4 x = acc[ai][bj][m][n];
                    if (MODE == 0) x = (x + bv[bj][n]) * (0.125f * LOG2E);
                    else if (MODE == 1) x = x + bv[bj][n];
                    else if (MODE == 2) {
#pragma unroll
                        for (int j = 0; j < 4; ++j) x[j] = x[j] * fsig(x[j]); }
                    else if (MODE == 3) {
#pragma unroll
                        for (int j = 0; j < 4; ++j) { const float l = bv[bj][n][j]; x[j] = flog2(l + (1.f - l) * fsig(x[j])); } }
                    else if (MODE == 6) {
#pragma unroll
                        for (int j = 0; j < 4; ++j) x[j] = fsig(x[j]); }
                    v[n] = x; }
                if (MODE == 6) *(u32x4*)((unsigned char*)base + ((ai * 4 + m) * 2 + bj) * 8192 + img_off) = pack8(v[0], v[1]);
                else *(u32x4*)(rowp + bj * bjs) = pack8(v[0], v[1]); } }
}
struct EpiZ {
    static constexpr bool PERM = true;
    const float* bqkv; const float* lb; bf16* Q; bf16* KV; bf16* HG; bf16* GT;
    __device__ __forceinline__ void operator()(const f32x4 (&acc)[2][2][4][2], const Unit& u, int wr, int wc, int fr, int fq) const {
        const int row0 = u.pm * BM + wr * 64 + fr, cb = u.pn * BM + wc * 32 + 8 * fq;
        if (u.pn < 4) epiz_body<0>(acc, Q, QW, row0, cb, bqkv + cb);
        else if (u.pn == 4) epiz_body<1>(acc, KV, 256, row0, cb - QW, bqkv + cb);
        else if (u.pn < 21) { const int ct = (u.pn - 5) * 256; bf16* hb = HG + (size_t)((ct >> 10) * 8 + ((ct >> 7) & 7)) * HGPS; const int oc = wc * 32 + 8 * fq;
            if (u.pn < 9) epiz_body<2>(acc, hb, 128, row0, oc, nullptr, 0, HGPS);
            else if (u.pn < 13) epiz_body<3>(acc, hb, 128, row0, oc, lb + ((cb - QKVW) & 1023), 0, HGPS);
            else if (u.pn < 17) epiz_body<4>(acc, hb, 128, row0, oc, nullptr, 0, HGPS);
            else epiz_body<2>(acc, hb, 128, row0, oc, nullptr, 0, HGPS); }
        else epiz_body<6>(acc, GT + (size_t)(u.pm * 16 + (u.pn - 21)) * 65536, 0, 0, 0, nullptr, (wr * 4 + wc) * 1024 + (fq * 16 + fr) * 16);
    }
};
struct EpiMix {
    static constexpr bool PERM = true;
    const bf16* GT; bf16* MIX; unsigned char* PART;
    template <bool SECOND>
    __device__ __forceinline__ void body(const f32x4 (&acc)[2][2][4][2], const int row0, const int cb, const unsigned char* gimg, unsigned char* pimg) const {
#pragma unroll
        for (int ai = 0; ai < 2; ++ai)
#pragma unroll
        for (int mh = 0; mh < 2; ++mh) {
            u32x4 g[2][2], o[2][2];
#pragma unroll
            for (int m2 = 0; m2 < 2; ++m2)
#pragma unroll
                for (int bj = 0; bj < 2; ++bj) { const size_t row = (size_t)(row0 + ai * HALF + (2 * mh + m2) * 16); const int c = cb + bj * HALF;
                    g[m2][bj] = __builtin_nontemporal_load((const u32x4*)(gimg + ((ai * 4 + 2 * mh + m2) * 2 + bj) * 8192));
                    if (SECOND) o[m2][bj] = *(const u32x4*)(pimg + ((ai * 4 + 2 * mh + m2) * 2 + bj) * 8192); }
#pragma unroll
            for (int m2 = 0; m2 < 2; ++m2)
#pragma unroll
                for (int bj = 0; bj < 2; ++bj) { const int m = 2 * mh + m2; const size_t row = (size_t)(row0 + ai * HALF + m * 16); const int c = cb + bj * HALF;
                    f32x4 g0, g1; unpack8(g[m2][bj], g0, g1);
                    f32x4 v0 = acc[ai][bj][m][0] * g0, v1 = acc[ai][bj][m][1] * g1;
                    if (SECOND) { f32x4 o0, o1; unpack8(o[m2][bj], o0, o1); v0 += o0; v1 += o1; }
                    if (SECOND) *(u32x4*)(MIX + row * D + c) = pack8(v0, v1); else *(u32x4*)(pimg + ((ai * 4 + m) * 2 + bj) * 8192) = pack8(v0, v1); }
        }
    }
    __device__ __forceinline__ void operator()(const f32x4 (&acc)[2][2][4][2], const Unit& u, int wr, int wc, int fr, int fq) const {
        const int row0 = u.pm * BM + wr * 64 + fr, cb = u.pn * BM + wc * 32 + 8 * fq;
        const unsigned char* gimg = (const unsigned char*)GT + (size_t)(u.pm * 16 + (u.e ? 8 : 0) + u.pn) * 131072 + (wr * 4 + wc) * 1024 + (fq * 16 + fr) * 16;
        unsigned char* pimg = PART + (wr * 4 + wc) * 1024 + (fq * 16 + fr) * 16;
        if (u.e) body<true>(acc, row0, cb, gimg, pimg); else body<false>(acc, row0, cb, gimg, pimg);
    }
};
__device__ __forceinline__ void ss_slot(float s, float* SS, int row, int slot, int fq) {
    s += __shfl_xor(s, 16); s += __shfl_xor(s, 32);
    if (fq == 0) SS[(size_t)row * 32 + slot] = s;
}
struct EpiDelta {
    static constexpr bool PERM = true;
    bf16* DL;
    __device__ __forceinline__ void operator()(const f32x4 (&acc)[2][2][4][2], const Unit& u, int wr, int wc, int fr, int fq) const {
        unsigned char* dimg = (unsigned char*)DL + (size_t)(u.pm * 8 + u.pn) * 131072 + (wr * 4 + wc) * 1024 + (fq * 16 + fr) * 16;
#pragma unroll
        for (int ai = 0; ai < 2; ++ai)
#pragma unroll
            for (int m = 0; m < 4; ++m)
#pragma unroll
                for (int bj = 0; bj < 2; ++bj) *(u32x4*)(dimg + ((ai * 4 + m) * 2 + bj) * 8192) = pack8(acc[ai][bj][m][0], acc[ai][bj][m][1]);
    }
};
struct EpiPleRaw {
    static constexpr bool PERM = true;
    bf16* PL; float* SS;
    __device__ __forceinline__ void operator()(const f32x4 (&acc)[2][2][4][2], const Unit& u, int wr, int wc, int fr, int fq) const {
        const int row0 = u.pm * BM + wr * 64 + fr;
        unsigned char* pimg = (unsigned char*)PL + (size_t)(u.pm * 8 + u.pn) * 131072 + (wr * 4 + wc) * 1024 + (fq * 16 + fr) * 16;
#pragma unroll
        for (int ai = 0; ai < 2; ++ai)
#pragma unroll
            for (int m = 0; m < 4; ++m) { const int row = row0 + ai * HALF + m * 16; float s = 0.f;
#pragma unroll
                for (int bj = 0; bj < 2; ++bj) { const f32x4 a = acc[ai][bj][m][0], b = acc[ai][bj][m][1];
                    s += ((a[0] * a[0] + a[1] * a[1]) + (a[2] * a[2] + a[3] * a[3])) + ((b[0] * b[0] + b[1] * b[1]) + (b[2] * b[2] + b[3] * b[3]));
                    *(u32x4*)(pimg + ((ai * 4 + m) * 2 + bj) * 8192) = pack8(a, b); }
                ss_slot(s, SS, row, u.pn * 4 + wc, fq); }
    }
};
struct EpiPleGate {
    static constexpr bool PERM = true;
    bf16* UPD; const bf16* PL; const float* rstd3; const float* rstdp; const float* gple;
    __device__ __forceinline__ void operator()(const f32x4 (&acc)[2][2][4][2], const Unit& u, int wr, int wc, int fr, int fq) const {
        const int row0 = u.pm * BM + wr * 64 + fr, cb = u.pn * BM + wc * 32 + 8 * fq;
        const unsigned char* pimg = (const unsigned char*)PL + (size_t)(u.pm * 8 + u.pn) * 131072 + (wr * 4 + wc) * 1024 + (fq * 16 + fr) * 16;
        f32x4 gp[2][2];
#pragma unroll
        for (int bj = 0; bj < 2; ++bj)
#pragma unroll
            for (int n = 0; n < 2; ++n) gp[bj][n] = *(const f32x4*)(gple + cb + bj * HALF + 4 * n);
#pragma unroll
        for (int ai = 0; ai < 2; ++ai) {
            u32x4 pp[4][2]; float r3[4], rp[4];
#pragma unroll
            for (int m = 0; m < 4; ++m) { const int row = row0 + ai * HALF + m * 16; r3[m] = rstd3[row]; rp[m] = rstdp[row];
#pragma unroll
                for (int bj = 0; bj < 2; ++bj) pp[m][bj] = __builtin_nontemporal_load((const u32x4*)(pimg + ((ai * 4 + m) * 2 + bj) * 8192)); }
#pragma unroll
            for (int m = 0; m < 4; ++m) { const int row = row0 + ai * HALF + m * 16;
#pragma unroll
                for (int bj = 0; bj < 2; ++bj) { const size_t o = (size_t)row * D + cb + bj * HALF;
                    f32x4 p0, p1; unpack8(pp[m][bj], p0, p1);
                    f32x4 g0 = acc[ai][bj][m][0] * r3[m], g1 = acc[ai][bj][m][1] * r3[m];
#pragma unroll
                    for (int j = 0; j < 4; ++j) { g0[j] = fsig(g0[j]); g1[j] = fsig(g1[j]); }
                    *(u32x4*)(UPD + o) = pack8(p0 * rp[m] * gp[bj][0] * g0, p1 * rp[m] * gp[bj][1] * g1); } }
        }
    }
};

struct MoeOrder {
    const LAS int* eoff; const LAS int* ecnt; int NT, G, c, total_rb; const char* A; const char* W; size_t wexp, tstepB, arow_bytes; const unsigned short* LIST; int gather;
    __device__ __forceinline__ bool next(int i, Unit& u) const {
        const int it = i * G + c; if (it >= total_rb * NT) return false;
        const int rb = it / NT, pn = it % NT, row0 = rb * BM;
        int e = 0; { int hi = NEXP;
#pragma unroll
            for (int st = 0; st < 6; ++st) { const int mid = (e + hi) >> 1; if (eoff[mid] <= row0) e = mid; else hi = mid; } }
        e = __builtin_amdgcn_readfirstlane(e);
        u.pm = rb; u.pn = pn; u.e = e; u.r0 = __builtin_amdgcn_readfirstlane(row0 - eoff[e]); u.cnt = __builtin_amdgcn_readfirstlane(ecnt[e]); u.row0 = row0;
        u.a = gather ? A : A + (size_t)row0 * arow_bytes; u.b = W + (size_t)e * wexp + (size_t)pn * tstepB; return true;
    }
    __device__ __forceinline__ void pace_arrive_wait(int, int, int) const {}
    __device__ __forceinline__ void pace_finish(int, int, int) const {}
    __device__ __forceinline__ unsigned row_off(const Unit& u, int row) const {
        const unsigned short* lp = LIST + (size_t)u.e * NTOK + u.r0;
        const unsigned tok = (row < u.cnt - u.r0) ? (unsigned)(lp[row] & 0x7fffu) : 0u; return tok * (unsigned)arow_bytes;
    }
};
struct EpiGateUp {
    static constexpr bool PERM = true;
    bf16* HID; const unsigned short* LIST; const float* RSTD2;
    __device__ __forceinline__ void operator()(const f32x4 (&acc)[2][2][4][2], const Unit& u, int wr, int wc, int fr, int fq) const {
        const int row0 = u.row0 + wr * 64 + fr, cb = u.pn * HALF + wc * 32 + 8 * fq;
        const unsigned short* lp = LIST + (size_t)u.e * NTOK + u.r0;
        unsigned tk[2][4]; float rs[2][4];
#pragma unroll
        for (int ai = 0; ai < 2; ++ai)
#pragma unroll
            for (int m = 0; m < 4; ++m) { const int lr = ai * HALF + wr * 64 + m * 16 + fr; tk[ai][m] = (lr < u.cnt - u.r0) ? (unsigned)(lp[lr] & 0x7fffu) : 0u; }
#pragma unroll
        for (int ai = 0; ai < 2; ++ai)
#pragma unroll
            for (int m = 0; m < 4; ++m) rs[ai][m] = RSTD2[tk[ai][m]];
#pragma unroll
        for (int ai = 0; ai < 2; ++ai)
#pragma unroll
            for (int m = 0; m < 4; ++m) { f32x4 v[2];
#pragma unroll
                for (int n = 0; n < 2; ++n) { const f32x4 g = acc[ai][0][m][n] * rs[ai][m], up = acc[ai][1][m][n] * rs[ai][m];
#pragma unroll
                    for (int j = 0; j < 4; ++j) v[n][j] = g[j] * fsig(g[j]) * up[j]; }
                *(u32x4*)(HID + (size_t)(row0 + ai * HALF + m * 16) * MH + cb) = pack8(v[0], v[1]); }
    }
};
struct EpiDown {
    static constexpr bool PERM = true;
    const unsigned short* LIST; const float* TW; bf16* Y;
    __device__ __forceinline__ void operator()(const f32x4 (&acc)[2][2][4][2], const Unit& u, int wr, int wc, int fr, int fq) const {
        const int cb = u.pn * BM + wc * 32 + 8 * fq;
        const unsigned short* lp = LIST + (size_t)u.e * NTOK + u.r0;
        unsigned ent[2][4]; float w[2][4];
#pragma unroll
        for (int ai = 0; ai < 2; ++ai)
#pragma unroll
            for (int m = 0; m < 4; ++m) { const int lr = ai * HALF + wr * 64 + m * 16 + fr; ent[ai][m] = (lr < u.cnt - u.r0) ? (unsigned)lp[lr] : 0x10000u; }
#pragma unroll
        for (int ai = 0; ai < 2; ++ai)
#pragma unroll
            for (int m = 0; m < 4; ++m) w[ai][m] = TW[(ent[ai][m] & 0x7fffu) * 2 + ((ent[ai][m] >> 15) & 1u)];
#pragma unroll
        for (int ai = 0; ai < 2; ++ai)
#pragma unroll
            for (int m = 0; m < 4; ++m) if (!(ent[ai][m] & 0x10000u)) { const unsigned tok = ent[ai][m] & 0x7fffu, k = (ent[ai][m] >> 15) & 1u;
                bf16* yp = Y + (size_t)k * NTOK * D + (size_t)tok * D + cb;
#pragma unroll
                for (int bj = 0; bj < 2; ++bj) *(u32x4*)(yp + bj * HALF) = pack8(acc[ai][bj][m][0] * w[ai][m], acc[ai][bj][m][1] * w[ai][m]); }
    }
};
}

namespace hg {
typedef short s16x4 __attribute__((ext_vector_type(4)));
typedef short bf16x8 __attribute__((ext_vector_type(8)));
typedef __bf16 bfv2 __attribute__((ext_vector_type(2)));
typedef float fv2 __attribute__((ext_vector_type(2)));
constexpr int RS = 272, IMG = 64 * RS;
constexpr int L_QI = 0, L_QR = IMG, L_KR = 2 * IMG, L_KL = 3 * IMG, L_V = 4 * IMG;
constexpr int L_SEG = 5 * IMG, L_D = L_SEG + 4096, L_RED = L_D + 512, L_RSTD = L_RED + 2048, L_END = L_RSTD + 256;
__device__ __forceinline__ unsigned cvtpk(float lo, float hi) { fv2 v; v.x = lo; v.y = hi; return __builtin_bit_cast(unsigned, __builtin_convertvector(v, bfv2)); }
__device__ __forceinline__ float blo(unsigned u) { return __uint_as_float(u << 16); }
__device__ __forceinline__ float bhi(unsigned u) { return __uint_as_float(u & 0xffff0000u); }
__device__ __forceinline__ bf16x8 frag_from2(const f32x4 a, const f32x4 b) { v4u w; w.x = cvtpk(a[0], a[1]); w.y = cvtpk(a[2], a[3]); w.z = cvtpk(b[0], b[1]); w.w = cvtpk(b[2], b[3]); return __builtin_bit_cast(bf16x8, w); }
__device__ __forceinline__ bf16x8 frag_tr2(LAS unsigned char* p0, LAS unsigned char* p1) {
    const s16x4 lo = __builtin_amdgcn_ds_read_tr16_b64_v4i16((LAS s16x4*)p0), hi = __builtin_amdgcn_ds_read_tr16_b64_v4i16((LAS s16x4*)p1);
    return __builtin_shufflevector(lo, hi, 0, 1, 2, 3, 4, 5, 6, 7); }
__device__ __forceinline__ bf16x8 frag_2x8(LAS unsigned char* p0, LAS unsigned char* p1) { v4u w; const v2u a = *(const LAS v2u*)p0, b = *(const LAS v2u*)p1; w.x = a.x; w.y = a.y; w.z = b.x; w.w = b.y; return __builtin_bit_cast(bf16x8, w); }
__device__ __forceinline__ float row_sum16(float s) {
    s += __int_as_float(__builtin_amdgcn_update_dpp(0, __float_as_int(s), 0x128, 0xf, 0xf, false));
    s += __int_as_float(__builtin_amdgcn_update_dpp(0, __float_as_int(s), 0x124, 0xf, 0xf, false));
    s += __int_as_float(__builtin_amdgcn_update_dpp(0, __float_as_int(s), 0x122, 0xf, 0xf, false));
    s += __int_as_float(__builtin_amdgcn_update_dpp(0, __float_as_int(s), 0x121, 0xf, 0xf, false));
    return s; }
#define HG_MFMA(a, b, c) __builtin_amdgcn_mfma_f32_16x16x32_bf16((a), (b), (c), 0, 0, 0)

template <bool P1>
__device__ __forceinline__ void unit(LAS unsigned char* lds, const bf16* HG, bf16* OREC, float* UST, float* DST, const float* ghg, const int u, const int tid) {
    const int lane = tid & 63, w = __builtin_amdgcn_readfirstlane(tid >> 6), r = lane & 15, q = lane >> 4;
    const int bh = u >> 5, j = u & 31, b = bh >> 3, h = bh & 7;
    const size_t row0 = (size_t)b * SEQ + (size_t)j * 512;
    f32x4 Sacc[8];
    float* ust = UST + (size_t)u * 16384 + (size_t)w * 2048 + lane;
#pragma unroll
    for (int kt = 0; kt < 8; ++kt)
#pragma unroll
        for (int rg = 0; rg < 4; ++rg) Sacc[kt][rg] = P1 ? 0.f : ust[(kt * 4 + rg) * 64];
    fv2 btot; btot.x = 0.f; btot.y = 0.f;
    unsigned gq[8], gg[8]; v4u rv[2], rgr[2];
#define HG_LOAD_RAW(c) do { const bf16* gp_ = HG + (size_t)h * HGPS + (row0 + (size_t)(c) * 64 + 8 * w) * 128 + 2 * lane; \
        _Pragma("unroll") for (int i = 0; i < 8; ++i) { if (!P1) { gq[i] = __builtin_nontemporal_load((const unsigned*)(gp_ + (size_t)i * 128)); gg[i] = __builtin_nontemporal_load((const unsigned*)(gp_ + (size_t)i * 128 + 8 * HGPS)); } else gg[i] = *(const unsigned*)(gp_ + (size_t)i * 128 + 8 * HGPS); } \
        _Pragma("unroll") for (int i = 0; i < 2; ++i) { const int ci_ = tid + 512 * i; const bf16* vp_ = HG + (size_t)h * HGPS + (row0 + (size_t)(c) * 64 + (ci_ >> 4)) * 128 + (ci_ & 15) * 8; \
            if (!P1) { rv[i] = __builtin_nontemporal_load((const v4u*)(vp_ + 16 * HGPS)); rgr[i] = __builtin_nontemporal_load((const v4u*)(vp_ + 24 * HGPS)); } else rv[i] = *(const v4u*)(vp_ + 16 * HGPS); } } while (0)
    HG_LOAD_RAW(0);
#pragma unroll 1
    for (int c = 0; c < 8; ++c) {
        const size_t rowc = row0 + (size_t)c * 64;
#pragma unroll
        for (int i = 0; i < 2; ++i) { const int ci = tid + 512 * i; *(LAS v4u*)(lds + L_V + (ci >> 4) * RS + (ci & 15) * 16) = rv[i]; }
        float c0[8], c1[8]; { float r0 = 0.f, r1 = 0.f;
#pragma unroll
            for (int i = 0; i < 8; ++i) { r0 += blo(gg[i]); r1 += bhi(gg[i]); c0[i] = r0; c1[i] = r1; }
            fv2 sv; sv.x = r0; sv.y = r1; *(LAS fv2*)(lds + L_SEG + (w * 128 + 2 * lane) * 4) = sv; }
        v4u grk[2];
        if (!P1) { grk[0] = rgr[0]; grk[1] = rgr[1]; }
        __syncthreads();
        float off0 = 0.f, off1 = 0.f, ref0 = 0.f, ref1 = 0.f, tot0 = 0.f, tot1 = 0.f;
#pragma unroll
        for (int s = 0; s < 8; ++s) { const fv2 sv = *(const LAS fv2*)(lds + L_SEG + (s * 128 + 2 * lane) * 4);
            if (s < w) { off0 += sv.x; off1 += sv.y; } if (s < 4) { ref0 += sv.x; ref1 += sv.y; } tot0 += sv.x; tot1 += sv.y; }
        if (w == 0) { fv2 dv; dv.x = fexp2(tot0); dv.y = fexp2(tot1); *(LAS fv2*)(lds + L_D + 2 * lane * 4) = dv; btot.x += tot0; btot.y += tot1; }
#pragma unroll
        for (int i = 0; i < 8; ++i) {
            const int t = 8 * w + i; const float b0 = off0 + c0[i], b1 = off1 + c1[i];
            const float k0 = 1.f - fexp2(blo(gg[i])), k1 = 1.f - fexp2(bhi(gg[i]));
            *(LAS unsigned*)(lds + L_KL + t * RS + 4 * lane) = cvtpk(k0 * fexp2(tot0 - b0), k1 * fexp2(tot1 - b1));
            if (!P1) { const float q0 = blo(gq[i]), q1 = bhi(gq[i]);
                *(LAS unsigned*)(lds + L_QI + t * RS + 4 * lane) = cvtpk(q0 * fexp2(b0), q1 * fexp2(b1));
                *(LAS unsigned*)(lds + L_QR + t * RS + 4 * lane) = cvtpk(q0 * fexp2(b0 - ref0), q1 * fexp2(b1 - ref1));
                *(LAS unsigned*)(lds + L_KR + t * RS + 4 * lane) = cvtpk(k0 * fexp2(ref0 - b0), k1 * fexp2(ref1 - b1)); }
        }
        __syncthreads();
        if (c + 1 < 8) HG_LOAD_RAW(c + 1);
        bf16x8 Vf[2];
#pragma unroll
        for (int cp = 0; cp < 2; ++cp) { LAS unsigned char* p0 = lds + L_V + (32 * cp + 4 * q + (r >> 2)) * RS + (16 * w + 4 * (r & 3)) * 2; Vf[cp] = frag_tr2(p0, p0 + 16 * RS); }
        f32x4 Oacc[4];
        if (!P1) {
#pragma unroll
            for (int ti = 0; ti < 4; ++ti) Oacc[ti] = (f32x4){0.f, 0.f, 0.f, 0.f};
#pragma unroll
            for (int cc = 0; cc < 4; ++cc) { const bf16x8 Sf = frag_from2(Sacc[2 * cc], Sacc[2 * cc + 1]);
#pragma unroll
                for (int ti = 0; ti < 4; ++ti) { LAS unsigned char* p = lds + L_QI + (16 * ti + r) * RS + 64 * cc + 8 * q; Oacc[ti] = HG_MFMA(frag_2x8(p, p + 32), Sf, Oacc[ti]); } }
#pragma unroll
            for (int ti = 0; ti < 4; ++ti) {
                f32x4 AT[4];
#pragma unroll
                for (int si = 0; si < 4; ++si) { AT[si] = (f32x4){0.f, 0.f, 0.f, 0.f};
                    if (si <= ti) {
#pragma unroll
                        for (int cc = 0; cc < 4; ++cc) { const bf16x8 A = *(const LAS bf16x8*)(lds + L_KR + (16 * si + r) * RS + 64 * cc + 16 * q); const bf16x8 B = *(const LAS bf16x8*)(lds + L_QR + (16 * ti + r) * RS + 64 * cc + 16 * q);
                            AT[si] = HG_MFMA(A, B, AT[si]); }
                        if (si == ti) {
#pragma unroll
                            for (int rg = 0; rg < 4; ++rg) if (4 * q + rg > r) AT[si][rg] = 0.f; }
                    } }
#pragma unroll
                for (int cp = 0; cp < 2; ++cp) if (cp <= (ti >> 1)) Oacc[ti] = HG_MFMA(frag_from2(AT[2 * cp], AT[2 * cp + 1]), Vf[cp], Oacc[ti]);
            }
        }
#pragma unroll
        for (int kt = 0; kt < 8; ++kt) { const f32x4 dv = *(const LAS f32x4*)(lds + L_D + (16 * kt + 4 * q) * 4); Sacc[kt] = Sacc[kt] * dv;
#pragma unroll
            for (int cp = 0; cp < 2; ++cp) { LAS unsigned char* p0 = lds + L_KL + (32 * cp + 4 * q + (r >> 2)) * RS + (16 * kt + 4 * (r & 3)) * 2; Sacc[kt] = HG_MFMA(frag_tr2(p0, p0 + 16 * RS), Vf[cp], Sacc[kt]); } }
        if (P1) { __syncthreads(); }
        else {
#pragma unroll
            for (int ti = 0; ti < 4; ++ti)
#pragma unroll
                for (int rg = 0; rg < 4; ++rg) { float s = Oacc[ti][rg] * Oacc[ti][rg];
                    s = row_sum16(s);
                    if (r == 0) *(LAS float*)(lds + L_RED + ((16 * ti + 4 * q + rg) * 8 + w) * 4) = s; }
            __syncthreads();
            if (tid < 64) { const f32x4 a = *(const LAS f32x4*)(lds + L_RED + tid * 32), bq = *(const LAS f32x4*)(lds + L_RED + tid * 32 + 16);
                *(LAS float*)(lds + L_RSTD + tid * 4) = rsqrtf((((a[0] + a[1]) + (a[2] + a[3])) + ((bq[0] + bq[1]) + (bq[2] + bq[3]))) * (1.f / 128.f) + EPS); }
            __syncthreads();
            { const float gv = ghg[16 * w + r];
#pragma unroll
                for (int ti = 0; ti < 4; ++ti) { const f32x4 rs = *(const LAS f32x4*)(lds + L_RSTD + (16 * ti + 4 * q) * 4);
#pragma unroll
                    for (int rg = 0; rg < 4; ++rg) *(LAS bf16*)(lds + L_QI + (16 * ti + 4 * q + rg) * RS + (16 * w + r) * 2) = (bf16)(cvtpk(Oacc[ti][rg] * rs[rg] * gv, 0.f) & 0xffffu); } }
            __syncthreads();
#pragma unroll
            for (int i = 0; i < 2; ++i) { const int ci = tid + 512 * i, row = ci >> 4, c16 = ci & 15;
                const v4u ov = *(const LAS v4u*)(lds + L_QI + row * RS + c16 * 16); const v4u gv = grk[i]; v4u o;
                o.x = cvtpk(blo(ov.x) * blo(gv.x), bhi(ov.x) * bhi(gv.x)); o.y = cvtpk(blo(ov.y) * blo(gv.y), bhi(ov.y) * bhi(gv.y));
                o.z = cvtpk(blo(ov.z) * blo(gv.z), bhi(ov.z) * bhi(gv.z)); o.w = cvtpk(blo(ov.w) * blo(gv.w), bhi(ov.w) * bhi(gv.w));
                *(v4u*)(OREC + (rowc + row) * HW + h * 128 + c16 * 8) = o; }
        }
    }
    if (P1) {
#pragma unroll
        for (int kt = 0; kt < 8; ++kt)
#pragma unroll
            for (int rg = 0; rg < 4; ++rg) ust[(kt * 4 + rg) * 64] = Sacc[kt][rg];
        if (w == 0) { fv2 dv; dv.x = fexp2(btot.x); dv.y = fexp2(btot.y); *(fv2*)(DST + (size_t)u * 128 + 2 * lane) = dv; }
    }
    __syncthreads();
#undef HG_LOAD_RAW
}
__device__ __forceinline__ void scan(float* UST, const float* DST, int gtid, int nthr) {
    for (int e = gtid; e < 16 * 16384; e += nthr) {
        const int bh = e >> 14, el = e & 16383, ln = el & 63, rg = (el >> 6) & 3, kt = (el >> 8) & 7, k = 16 * kt + 4 * (ln >> 4) + rg;
        float uu[32], dd[32];
        float* p0 = UST + (size_t)bh * 32 * 16384 + el; const float* d0 = DST + (size_t)bh * 32 * 128 + k;
#pragma unroll
        for (int j = 0; j < 32; ++j) { uu[j] = p0[(size_t)j * 16384]; dd[j] = d0[j * 128]; }
        float T = 0.f;
#pragma unroll
        for (int j = 0; j < 32; ++j) { p0[(size_t)j * 16384] = T; T = dd[j] * T + uu[j]; }
    }
}
}

namespace at {
typedef short bf16x8 __attribute__((ext_vector_type(8)));
constexpr int RSK = 144;
constexpr int L_K = 0, L_V = 272 * RSK, L_B = 2 * 272 * RSK, L_O = L_B + 4096, OW = 16 * RSK, L_END = L_O + 8 * OW;
__device__ __forceinline__ void item(LAS unsigned char* lds, bf16* QB, const bf16* KVB, const float* sinks, const float* rel, const int it, const int tid) {
    const int lane = tid & 63, w = __builtin_amdgcn_readfirstlane(tid >> 6), r = lane & 15, q = lane >> 4;
    const int kvh = it & 1, blk = (it >> 1) & 127, b = it >> 8, head = kvh * 8 + w;
    const size_t tok0 = (size_t)b * SEQ + (size_t)blk * 128;
    __syncthreads();
#pragma unroll
    for (int i = 0; i < 4; ++i) { const int ci = tid + 512 * i, row = ci >> 3, c8 = ci & 7; v4u kk = (v4u){0u, 0u, 0u, 0u}, vv = (v4u){0u, 0u, 0u, 0u};
        if (blk > 0 || row >= 128) { const bf16* p = KVB + (tok0 - 128 + row) * 256 + kvh * 64 + c8 * 8; kk = *(const v4u*)p; vv = *(const v4u*)(p + 128); }
        *(LAS v4u*)(lds + L_K + row * RSK + c8 * 16) = kk; *(LAS v4u*)(lds + L_V + row * RSK + c8 * 16) = vv; }
    if (tid < 128) *(LAS v4u*)(lds + L_V + (256 + (tid >> 3)) * RSK + (tid & 7) * 16) = (v4u){0u, 0u, 0u, 0u};
#pragma unroll
    for (int i = 0; i < 2; ++i) { const int e = tid + 512 * i, g = e >> 7, d = e & 127; int bk;
        if (d < 16) bk = d; else { bk = 16 + (int)(__logf((float)d * (1.f / 16.f)) / 2.0794415416798357f * 16.f); if (bk > 31) bk = 31; }
        *(LAS float*)(lds + L_B + e * 4) = rel[bk * 16 + kvh * 8 + g] * LOG2E; }
    __syncthreads();
    float bv[9][4];
#pragma unroll
    for (int kt = 0; kt < 9; ++kt)
#pragma unroll
        for (int rg = 0; rg < 4; ++rg) { const int dist = 128 - 16 * kt + r - 4 * q - rg; const bool ok = dist >= 0 && dist < 128;
            const float bb = *(const LAS float*)(lds + L_B + (w * 128 + (ok ? dist : 0)) * 4); bv[kt][rg] = ok ? bb : -1e30f; }
    const float sink = sinks[head] * LOG2E;
    bf16x8 Qn0, Qn1; { const bf16* qrow = QB + (tok0 + r) * QW + head * 64 + 8 * q; Qn0 = *(const bf16x8*)qrow; Qn1 = *(const bf16x8*)(qrow + 32); }
#pragma unroll 1
    for (int qt = 0; qt < 8; ++qt) {
        const bf16x8 Qf0 = Qn0, Qf1 = Qn1;
        if (qt + 1 < 8) { const bf16* qrow = QB + (tok0 + 16 * (qt + 1) + r) * QW + head * 64 + 8 * q; Qn0 = *(const bf16x8*)qrow; Qn1 = *(const bf16x8*)(qrow + 32); }
        f32x4 ST[9];
#pragma unroll
        for (int kt = 0; kt < 9; ++kt) {
            if (blk == 0 && qt + kt < 8) { ST[kt] = (f32x4){-1e30f, -1e30f, -1e30f, -1e30f}; }
            else { LAS unsigned char* kp = lds + L_K + (16 * (qt + kt) + r) * RSK + 16 * q; f32x4 a = (f32x4){0.f, 0.f, 0.f, 0.f};
                a = __builtin_amdgcn_mfma_f32_16x16x32_bf16(*(const LAS bf16x8*)kp, Qf0, a, 0, 0, 0); a = __builtin_amdgcn_mfma_f32_16x16x32_bf16(*(const LAS bf16x8*)(kp + 64), Qf1, a, 0, 0, 0);
#pragma unroll
                for (int rg = 0; rg < 4; ++rg) ST[kt][rg] = a[rg] + bv[kt][rg]; } }
        float m = sink;
#pragma unroll
        for (int kt = 0; kt < 9; ++kt)
#pragma unroll
            for (int rg = 0; rg < 4; ++rg) m = fmaxf(m, ST[kt][rg]);
        m = fmaxf(m, __shfl_xor(m, 16)); m = fmaxf(m, __shfl_xor(m, 32));
        float l = 0.f;
#pragma unroll
        for (int kt = 0; kt < 9; ++kt)
#pragma unroll
            for (int rg = 0; rg < 4; ++rg) { const float p = fexp2(ST[kt][rg] - m); ST[kt][rg] = p; l += p; }
        l += __shfl_xor(l, 16); l += __shfl_xor(l, 32);
        const float inv = 1.f / (l + fexp2(sink - m));
        f32x4 O[4];
#pragma unroll
        for (int dt = 0; dt < 4; ++dt) O[dt] = (f32x4){0.f, 0.f, 0.f, 0.f};
#pragma unroll
        for (int cp = 0; cp < 5; ++cp) {
            const f32x4 pa = ST[2 * cp] * inv, pb = (2 * cp + 1 < 9) ? ST[(2 * cp + 1 < 9) ? 2 * cp + 1 : 8] * inv : (f32x4){0.f, 0.f, 0.f, 0.f};
            const bf16x8 P = hg::frag_from2(pa, pb);
#pragma unroll
            for (int dt = 0; dt < 4; ++dt) { LAS unsigned char* p0 = lds + L_V + (16 * (qt + 2 * cp) + 4 * q + (r >> 2)) * RSK + (16 * dt + 4 * (r & 3)) * 2;
                O[dt] = __builtin_amdgcn_mfma_f32_16x16x32_bf16(P, hg::frag_tr2(p0, p0 + 16 * RSK), O[dt], 0, 0, 0); } }
        LAS unsigned char* ow = lds + L_O + w * OW;
#pragma unroll
        for (int dt = 0; dt < 4; ++dt)
#pragma unroll
            for (int rg = 0; rg < 4; ++rg) *(LAS bf16*)(ow + (4 * q + rg) * RSK + (16 * dt + r) * 2) = (bf16)(hg::cvtpk(O[dt][rg], 0.f) & 0xffffu);
#pragma unroll
        for (int i = 0; i < 2; ++i) { const int ci = lane + 64 * i, row = ci >> 3, c8 = ci & 7;
            const v4u v = *(const LAS v4u*)(ow + row * RSK + c8 * 16); *(v4u*)(QB + (tok0 + 16 * qt + row) * QW + head * 64 + c8 * 8) = v; }
    }
}
}

namespace rt {
typedef short bf16x8 __attribute__((ext_vector_type(8)));
__device__ __forceinline__ void prep_w(const float* wco, const float* wfi, const float* gf, bf16* WRH, bf16* WRL, int gtid, int nthr) {
    for (int e = gtid; e < 80 * D; e += nthr) { const int n = e >> 11, k = e & 2047;
        const float w = (n < 8) ? wco[k * 8 + n] : (n < 72 ? wfi[k * 64 + (n - 8)] : 0.f); const float v = w * gf[k];
        const unsigned h = hg::cvtpk(v, 0.f) & 0xffffu; const float l = v - __uint_as_float(h << 16);
        WRH[e] = (bf16)h; WRL[e] = (bf16)(hg::cvtpk(l, 0.f) & 0xffffu); }
}
constexpr int RSB = 272, BUFB = 2 * 80 * RSB, L_G = 2 * BUFB, L_LW = L_G + 8192, L_HIST = L_LW + 8 * 5120;
__device__ __forceinline__ void pass(LAS unsigned char* lds, const float* x, const bf16* DL, float* RSTD2, const float* gf, const bf16* WRH, const bf16* WRL, const float* bco, const float* bfi,
                                     bf16* XN, float* TW, const int tl, const bool live, const int tid, int& ea_out, int& eb_out) {
    const int lane = tid & 63, w = __builtin_amdgcn_readfirstlane(tid >> 6), r = lane & 15, q = lane >> 4;
    const int tok = live ? tl * 16 + r : r;
    LAS float* lw = (LAS float*)(lds + L_LW + w * 5120);
    v4u st[5];
#define RT_BLOAD(ck_) do { _Pragma("unroll") for (int i = 0; i < 5; ++i) { const int p_ = tid + 512 * i, mat_ = p_ >= 1280, rem_ = p_ - 1280 * mat_, n_ = rem_ >> 4, j_ = rem_ & 15; \
        st[i] = *(const v4u*)((mat_ ? WRL : WRH) + (size_t)n_ * D + (ck_) * 128 + j_ * 8); } } while (0)
#define RT_BSTORE(buf_) do { _Pragma("unroll") for (int i = 0; i < 5; ++i) { const int p_ = tid + 512 * i, mat_ = p_ >= 1280, rem_ = p_ - 1280 * mat_, n_ = rem_ >> 4, j_ = rem_ & 15; \
        *(LAS v4u*)(lds + (buf_) * BUFB + mat_ * 80 * RSB + n_ * RSB + j_ * 16) = st[i]; } } while (0)
    RT_BLOAD(0);
    const float* xr = x + (size_t)tok * D + 8 * q; bf16* xo = XN + (size_t)tok * D + 8 * q;
    const int tl0 = live ? tl : 0, t0 = (tl0 & 15) * 16;
    const unsigned char* dbase = (const unsigned char*)DL + (size_t)(tl0 >> 4) * 8 * 131072 + (((t0 >> 7) * 4 + ((t0 >> 4) & 3)) * 2) * 8192 + (((t0 >> 6) & 1) * 4) * 1024 + (q * 16 + r) * 16;
    f32x4 X[4][2]; v4u Dl[4];
#define RT_XLOAD(ck_) do { _Pragma("unroll") for (int s_ = 0; s_ < 4; ++s_) { const int c_ = 4 * (ck_) + s_; X[s_][0] = __builtin_nontemporal_load((const f32x4*)(xr + 32 * c_)); \
        X[s_][1] = __builtin_nontemporal_load((const f32x4*)(xr + 32 * c_ + 4)); Dl[s_] = __builtin_nontemporal_load((const v4u*)(dbase + (size_t)(c_ >> 3) * 131072 + ((c_ >> 2) & 1) * 8192 + (c_ & 3) * 1024)); } } while (0)
    RT_XLOAD(0);
    RT_BSTORE(0);
    __syncthreads();
    f32x4 acc[5];
#pragma unroll
    for (int nt = 0; nt < 5; ++nt) acc[nt] = (f32x4){0.f, 0.f, 0.f, 0.f};
    float ssq = 0.f;
#pragma unroll 1
    for (int ck = 0; ck < 16; ++ck) {
        f32x4 Xc[4][2]; v4u Dc[4];
#pragma unroll
        for (int s_ = 0; s_ < 4; ++s_) { Xc[s_][0] = X[s_][0]; Xc[s_][1] = X[s_][1]; Dc[s_] = Dl[s_]; }
        if (ck + 1 < 16) { RT_BLOAD(ck + 1); RT_XLOAD(ck + 1); }
        LAS unsigned char* bb = lds + (ck & 1) * BUFB + r * RSB + 16 * q;
#pragma unroll
        for (int s_ = 0; s_ < 4; ++s_) {
            const int c = 4 * ck + s_;
            f32x4 x0 = Xc[s_][0], x1 = Xc[s_][1]; { f32x4 d0, d1; pg8::unpack8(Dc[s_], d0, d1); x0 += d0; x1 += d1; }
            ssq += ((x0[0] * x0[0] + x0[1] * x0[1]) + (x0[2] * x0[2] + x0[3] * x0[3])) + ((x1[0] * x1[0] + x1[1] * x1[1]) + (x1[2] * x1[2] + x1[3] * x1[3]));
            v4u hi; hi.x = hg::cvtpk(x0[0], x0[1]); hi.y = hg::cvtpk(x0[2], x0[3]); hi.z = hg::cvtpk(x1[0], x1[1]); hi.w = hg::cvtpk(x1[2], x1[3]);
            if (live) *(v4u*)(xo + 32 * c) = hi;
            v4u lo; lo.x = hg::cvtpk(x0[0] - hg::blo(hi.x), x0[1] - hg::bhi(hi.x)); lo.y = hg::cvtpk(x0[2] - hg::blo(hi.y), x0[3] - hg::bhi(hi.y));
            lo.z = hg::cvtpk(x1[0] - hg::blo(hi.z), x1[1] - hg::bhi(hi.z)); lo.w = hg::cvtpk(x1[2] - hg::blo(hi.w), x1[3] - hg::bhi(hi.w));
            const bf16x8 Ah = __builtin_bit_cast(bf16x8, hi), Al = __builtin_bit_cast(bf16x8, lo);
#pragma unroll
            for (int nt = 0; nt < 5; ++nt) { const bf16x8 Bh = *(const LAS bf16x8*)(bb + nt * 16 * RSB + 64 * s_), Bl = *(const LAS bf16x8*)(bb + 80 * RSB + nt * 16 * RSB + 64 * s_);
                acc[nt] = __builtin_amdgcn_mfma_f32_16x16x32_bf16(Ah, Bh, acc[nt], 0, 0, 0); acc[nt] = __builtin_amdgcn_mfma_f32_16x16x32_bf16(Ah, Bl, acc[nt], 0, 0, 0);
                acc[nt] = __builtin_amdgcn_mfma_f32_16x16x32_bf16(Al, Bh, acc[nt], 0, 0, 0); }
        }
        if (ck + 1 < 16) RT_BSTORE((ck + 1) & 1);
        __syncthreads();
    }
#undef RT_BLOAD
#undef RT_BSTORE
#undef RT_XLOAD
    ssq += __shfl_xor(ssq, 16); ssq += __shfl_xor(ssq, 32);
    const float rstd = rsqrtf(ssq * (1.f / D) + EPS);
    if (live && q == 0) RSTD2[tok] = rstd;
#pragma unroll
    for (int nt = 0; nt < 5; ++nt)
#pragma unroll
        for (int rg = 0; rg < 4; ++rg) lw[(4 * q + rg) * 80 + 16 * nt + r] = acc[nt][rg];
    asm volatile("s_waitcnt lgkmcnt(0)" ::: "memory");
    if (live && lane < 16) {
        const LAS float* L = lw + lane * 80;
        float cm = L[0] * rstd + bco[0]; int grp = 0; float cv[8]; cv[0] = cm;
#pragma unroll
        for (int j = 1; j < 8; ++j) { cv[j] = L[j] * rstd + bco[j]; if (cv[j] > cm) { cm = cv[j]; grp = j; } }
        float den = 0.f;
#pragma unroll
        for (int j = 0; j < 8; ++j) den += fexp(cv[j] - cm);
        const float psel = 1.f / den;
        float f[8];
#pragma unroll
        for (int j = 0; j < 8; ++j) f[j] = L[8 + grp * 8 + j] * rstd + bfi[grp * 8 + j];
        int i0 = 0; float f0 = f[0];
#pragma unroll
        for (int j = 1; j < 8; ++j) if (f[j] > f0) { f0 = f[j]; i0 = j; }
        int i1 = -1; float f1 = 0.f;
#pragma unroll
        for (int j = 0; j < 8; ++j) if (j != i0 && (i1 < 0 || f[j] > f1)) { f1 = f[j]; i1 = j; }
        const float e1 = fexp(f1 - f0), w0 = psel / (1.f + e1), w1 = psel * e1 / (1.f + e1);
        ea_out = grp * 8 + i0; eb_out = grp * 8 + i1;
        TW[tok * 2] = w0; TW[tok * 2 + 1] = w1;
    }
}
}

constexpr int LDS_BYTES = 155648;
constexpr int LDS_MISC = 152576;

__global__ void __launch_bounds__(NTHR, 2) fwd_kernel(Args args) {
    extern __shared__ __attribute__((aligned(16))) unsigned char lds_raw[];
    LAS unsigned char* lds = (LAS unsigned char*)lds_raw;
    LAS float* ldsf = (LAS float*)lds;
    volatile LAS unsigned* MISC = (volatile LAS unsigned*)(lds + LDS_MISC);
    int tid = threadIdx.x; asm volatile("" : "+v"(tid));
    int lane = tid & 63, wave = __builtin_amdgcn_readfirstlane(tid >> 6);
#define GRID_SYNC() do { xcd_barrier(bar, tid); asm volatile("" : "+v"(tid)); lane = tid & 63; wave = __builtin_amdgcn_readfirstlane(tid >> 6); gw = bx * NWAVES + wave; } while (0)
    const int G = gridDim.x, bx = blockIdx.x;
    int gw = bx * NWAVES + wave; const int NGW = G * NWAVES;
    unsigned char* ws = args.ws;
    unsigned* ctl = (unsigned*)(ws + WS_CTL);
    if (tid < 64) MISC[tid] = 0u;
    __syncthreads();
    XcdBarrier bar = xcd_barrier_post(ctl + CW_BAR, MISC + 8, tid);

    const float* x = args.in[I_X];
    float* hbuf = args.out;
    float* LB = (float*)(ws + WS_SMALL);
    float* TW = (float*)(ws + WS_SMALL + 65536);
    unsigned short* LIST = (unsigned short*)(ws + WS_LIST);
    bf16* W_IN_T = (bf16*)(ws + WS_WIN); bf16* W_UA_T = (bf16*)(ws + WS_WUA); bf16* W_UR_T = (bf16*)(ws + WS_WUR);
    bf16* W_OUT_T = (bf16*)(ws + WS_WOUT); bf16* W_PG_T = (bf16*)(ws + WS_WPG); bf16* W_PI_T = (bf16*)(ws + WS_WPI);
    bf16* U = (bf16*)(ws + WS_RA); bf16* OREC = (bf16*)(ws + WS_RA); bf16* XN = (bf16*)(ws + WS_RA);
    bf16* QB = (bf16*)(ws + WS_RB); bf16* KVB = (bf16*)(ws + WS_RB + 64 * MiB); bf16* HID = (bf16*)(ws + WS_RB); bf16* PB = (bf16*)(ws + WS_PB);
    bf16* HG = (bf16*)(ws + WS_RC); bf16* MIX = (bf16*)(ws + WS_RC); bf16* Y = (bf16*)(ws + WS_RE);
    bf16* GT = (bf16*)(ws + WS_RD); bf16* W_DN_T = (bf16*)(ws + WS_RD); bf16* PL = (bf16*)(ws + WS_RD + 128 * MiB);
    bf16* W_GU_T = (bf16*)(ws + WS_RE);
    float* RSTDP = (float*)(ws + WS_SMALL + 393216); float* RSTD3 = (float*)(ws + WS_SMALL + 524288); float* RSTD2 = (float*)(ws + WS_SMALL + 655360);
    bf16* DELTA = (bf16*)(ws + WS_RC + 128 * MiB);
    bf16* H3B = (bf16*)(ws + WS_RC);
    bf16* WRH = (bf16*)(ws + 6 * MiB); bf16* WRL = (bf16*)(ws + 6 * MiB + 512 * 1024);
    float* UST = (float*)(ws + WS_RA + 64 * MiB); float* DST = (float*)(ws + WS_RA + 96 * MiB);
    float* SS_H1 = (float*)(ws + WS_SS); float* SS_PL = (float*)(ws + WS_SS + 4 * MiB); float* SS_FIN = (float*)(ws + WS_SS + 8 * MiB);
    unsigned* CNT = ctl + CW_CNT;
    LAS unsigned char* ring = lds;

#ifndef REP_P0
#define REP_P0 1
#endif
#ifndef REP_P1
#define REP_P1 1
#endif
#pragma unroll 1
    for (int rep = 0; rep < REP_P0; ++rep) {
        LAS float* scr = ldsf + wave * 4096;
        transpose_all(args.in[I_WIN], D, INC, W_IN_T, scr, gw, NGW, lane, D);
        transpose_all(args.in[I_WUA], QW, D, W_UA_T, scr, gw, NGW, lane, QW);
        transpose_all(args.in[I_WUR], HW, D, W_UR_T, scr, gw, NGW, lane, HW);
        transpose_all(args.in[I_WOUT], D, D, W_OUT_T, scr, gw, NGW, lane, D);
        transpose_all(args.in[I_WPG], D, D, W_PG_T, scr, gw, NGW, lane, D);
        transpose_all(args.in[I_WPI], PLE, D, W_PI_T, scr, gw, NGW, lane, PLE);
        for (int it = gw; it < (NEXP - 16) * 1024; it += NGW) { const int e = it >> 10, r = it & 1023, mat = r >> 9, item = r & 511;
            transpose_item(args.in[mat ? I_WU : I_WG] + (size_t)e * D * MH, D, MH, W_GU_T + (size_t)e * 1024 * D, scr, item, lane, 1 + mat, D, args.in[I_GFFN]); }
        for (int m = gw; m < NTOK; m += NGW) { const f32x4 pv = __builtin_nontemporal_load((const f32x4*)(args.in[I_P] + (size_t)m * PLE) + lane);
            v2u w; w.x = pk2(pv.x, pv.y); w.y = pk2(pv.z, pv.w); *((v2u*)(PB + (size_t)m * PLE) + lane) = w; }
        const float* gm = args.in[I_GMIX];
        for (int m = gw; m < NTOK; m += NGW) {
            const f32x4* xr = (const f32x4*)(x + (size_t)m * D) + lane;
            f32x4 v[8]; float s = 0.f;
#pragma unroll
            for (int j = 0; j < 8; ++j) { v[j] = __builtin_nontemporal_load(xr + 64 * j); s += (v[j].x * v[j].x + v[j].y * v[j].y) + (v[j].z * v[j].z + v[j].w * v[j].w); }
            const float rstd = rsqrtf(wave_sum(s) * (1.f / D) + EPS);
            v2u* o = (v2u*)(U + (size_t)m * D) + lane;
#pragma unroll
            for (int j = 0; j < 8; ++j) { const f32x4 g = *((const f32x4*)gm + 64 * j + lane); v2u w; w.x = pk2(v[j].x * rstd * g.x, v[j].y * rstd * g.y); w.y = pk2(v[j].z * rstd * g.z, v[j].w * rstd * g.w); o[64 * j] = w; }
        }
        rt::prep_w(args.in[I_WCO], args.in[I_WFI], args.in[I_GFFN], WRH, WRL, bx * NTHR + tid, G * NTHR);
        const float* lbl = args.in[I_LBL];
        for (int j = bx * NTHR + tid; j < HW; j += G * NTHR) LB[j] = 1.f / (1.f + __expf(lbl[HW + j] - lbl[j]));
    }
    GRID_SYNC();

#pragma unroll 1
    for (int rep = 0; rep < REP_P1; ++rep) {
        pg8::StaticOrder S; S.init(U, W_IN_T, NTOK, INC, D, D, G, bx);
        pg8::EpiZ E{args.in[I_BQKV], LB, QB, KVB, HG, GT};
        pg8::gemm_phase<pg8::EpiZ, pg8::StaticOrder, true, false>(ring, D, D, D, S, E, tid);
        const int nshort = G - (S.nwg % G);
        if (S.nwg % G != 0 && bx >= S.nwg % G) { LAS float* scr = ldsf + wave * 4096; const int sw = (bx - S.nwg % G) * NWAVES + wave, nsw = nshort * NWAVES;
            for (int it = sw; it < 16 * 1024; it += nsw) { const int e = (NEXP - 16) + (it >> 10), r = it & 1023, mat = r >> 9, item = r & 511;
                transpose_item(args.in[mat ? I_WU : I_WG] + (size_t)e * D * MH, D, MH, W_GU_T + (size_t)e * 1024 * D, scr, item, lane, 1 + mat, D, args.in[I_GFFN]); } }
        else if (S.nwg % G == 0) { LAS float* scr = ldsf + wave * 4096;
            for (int it = gw; it < 16 * 1024; it += NGW) { const int e = (NEXP - 16) + (it >> 10), r = it & 1023, mat = r >> 9, item = r & 511;
                transpose_item(args.in[mat ? I_WU : I_WG] + (size_t)e * D * MH, D, MH, W_GU_T + (size_t)e * 1024 * D, scr, item, lane, 1 + mat, D, args.in[I_GFFN]); } }
    }
    GRID_SYNC();

    for (int u = bx; u < 512; u += G) hg::unit<true>(lds, HG, OREC, UST, DST, args.in[I_GHGRN], u, tid);
    for (int it = bx; it < 2 * 128 * 2; it += G) at::item(lds, QB, KVB, args.in[I_SINKS], args.in[I_REL], it, tid);
    GRID_SYNC();

    hg::scan(UST, DST, bx * NTHR + tid, G * NTHR);
    GRID_SYNC();
    for (int u = bx; u < 512; u += G) hg::unit<false>(lds, HG, OREC, UST, DST, args.in[I_GHGRN], u, tid);
    GRID_SYNC();

    {
        pg8::PairOrder S; S.s0.init(QB, W_UA_T, NTOK, D, QW, QW, G, bx); S.A1 = (const char*)OREC; S.B1 = (const char*)W_UR_T;
        pg8::EpiMix E{GT, MIX, (unsigned char*)UST + (size_t)bx * 131072};
        pg8::gemm_phase<pg8::EpiMix, pg8::PairOrder, true, false>(ring, QW, QW, QW, S, E, tid);
    }
    GRID_SYNC();

    {
        pg8::StaticOrder S; S.init(MIX, W_OUT_T, NTOK, D, D, D, G, bx);
        pg8::EpiDelta E{DELTA};
        pg8::gemm_phase<pg8::EpiDelta, pg8::StaticOrder, true, false>(ring, D, D, D, S, E, tid);
    }
    GRID_SYNC();

    {
        {
            LAS float* scr = ldsf + wave * 4096;
            for (int it = gw; it < NEXP * 512; it += NGW) { const int e = it >> 9, item = it & 511;
                transpose_item(args.in[I_WD] + (size_t)e * MH * D, MH, D, W_DN_T + (size_t)e * D * MH, scr, item, lane, 0, MH); }
        }
        __syncthreads();
        LAS unsigned* hist = (LAS unsigned*)(lds + rt::L_HIST);
        for (int i = 0; i * NGW < NTOK / 16; ++i) {
            const int tl = gw + i * NGW; const bool live = tl < NTOK / 16;
            __syncthreads();
            if (tid < 64) hist[tid] = 0u;
            int ea = 0, eb = 0; unsigned ra = 0u, rb = 0u;
            rt::pass(lds, x, DELTA, RSTD2, args.in[I_GFFN], WRH, WRL, args.in[I_BCO], args.in[I_BFI], XN, TW, tl, live, tid, ea, eb);
            if (live && lane < 16) { ra = atomicAdd((unsigned*)(hist + ea), 1u); rb = atomicAdd((unsigned*)(hist + eb), 1u); }
            __syncthreads();
            if (tid < 64) { const unsigned c = hist[tid]; hist[64 + tid] = c ? atomicAdd(CNT + 64 * tid, c) : 0u; }
            __syncthreads();
            if (live && lane < 16) { const int m = tl * 16 + lane;
                LIST[(size_t)ea * NTOK + hist[64 + ea] + ra] = (unsigned short)m; LIST[(size_t)eb * NTOK + hist[64 + eb] + rb] = (unsigned short)(m | 0x8000); }
        }
    }
    GRID_SYNC();

    LAS int* eoff = (LAS int*)(lds + 150528);
    LAS int* ecnt = (LAS int*)(lds + 150528 + 512);
    if (tid < 64) {
        const int c = (int)__hip_atomic_load(CNT + 64 * tid, __ATOMIC_RELAXED, __HIP_MEMORY_SCOPE_AGENT); int v = (c + 255) & ~255;
#pragma unroll
        for (int d = 1; d < 64; d <<= 1) { const int t = __shfl_up(v, d); if (lane >= d) v += t; }
        ecnt[tid] = c; eoff[tid] = v - ((c + 255) & ~255); if (tid == 63) eoff[NEXP] = v;
    }
    __syncthreads();
    const int vcu = (G % 8 == 0) ? (bx % 8) * (G / 8) + bx / 8 : bx;
    const int nrb = eoff[NEXP] / 256;
    {
        pg8::MoeOrder S{eoff, ecnt, 4, G, vcu, nrb, (const char*)XN, (const char*)W_GU_T, (size_t)1024 * D * 2, (size_t)256 * D * 2, (size_t)D * 2, LIST, 1};
        pg8::EpiGateUp E{HID, LIST, RSTD2};
        pg8::gemm_phase<pg8::EpiGateUp, pg8::MoeOrder, true, true>(ring, D, D, D, S, E, tid);
    }
    GRID_SYNC();
    {
        pg8::MoeOrder S{eoff, ecnt, 8, G, vcu, nrb, (const char*)HID, (const char*)W_DN_T, (size_t)D * MH * 2, (size_t)256 * MH * 2, (size_t)MH * 2, LIST, 0};
        pg8::EpiDown E{LIST, TW, Y};
        pg8::gemm_phase<pg8::EpiDown, pg8::MoeOrder, true, false>(ring, MH, MH, MH, S, E, tid);
    }
    {
        pg8::StaticOrder S; S.init(PB, W_PI_T, NTOK, D, PLE, PLE, G, bx);
        pg8::EpiPleRaw E{PL, SS_PL};
        pg8::gemm_phase<pg8::EpiPleRaw, pg8::StaticOrder, true, false>(ring, PLE, PLE, PLE, S, E, tid);
    }
    GRID_SYNC();

    {
        for (int m = gw; m < NTOK; m += NGW) {
            const v2u* hb = (const v2u*)(XN + (size_t)m * D) + lane;
            const v2u* y0 = (const v2u*)(Y + (size_t)m * D) + lane; const v2u* y1 = (const v2u*)(Y + (size_t)NTOK * D + (size_t)m * D) + lane;
            v2u* o = (v2u*)(XN + (size_t)m * D) + lane;
            float s = 0.f;
#pragma unroll
            for (int j = 0; j < 8; ++j) { const v2u a = __builtin_nontemporal_load(y0 + 64 * j), c = __builtin_nontemporal_load(y1 + 64 * j), dd = __builtin_nontemporal_load(hb + 64 * j);
                f32x4 v; v.x = __uint_as_float(dd.x << 16); v.y = __uint_as_float(dd.x & 0xffff0000u); v.z = __uint_as_float(dd.y << 16); v.w = __uint_as_float(dd.y & 0xffff0000u);
                v.x += __uint_as_float(a.x << 16) + __uint_as_float(c.x << 16); v.y += __uint_as_float(a.x & 0xffff0000u) + __uint_as_float(c.x & 0xffff0000u);
                v.z += __uint_as_float(a.y << 16) + __uint_as_float(c.y << 16); v.w += __uint_as_float(a.y & 0xffff0000u) + __uint_as_float(c.y & 0xffff0000u);
                s += (v.x * v.x + v.y * v.y) + (v.z * v.z + v.w * v.w);
                v2u w; w.x = hg::cvtpk(v.x, v.y); w.y = hg::cvtpk(v.z, v.w); o[64 * j] = w; }
            const float ssum = wave_sum(s);
            const float sp = wave_sum(lane < 32 ? SS_PL[(size_t)m * 32 + lane] : 0.f);
            if (lane == 0) { RSTD3[m] = rsqrtf(ssum * (1.f / D) + EPS); RSTDP[m] = rsqrtf(sp * (1.f / D) + EPS); }
        }
    }
    GRID_SYNC();

    {
        pg8::StaticOrder S; S.init(XN, W_PG_T, NTOK, D, D, D, G, bx);
        pg8::EpiPleGate E{H3B, PL, RSTD3, RSTDP, args.in[I_GPLE]};
        pg8::gemm_phase<pg8::EpiPleGate, pg8::StaticOrder, true, false>(ring, D, D, D, S, E, tid);
    }
    GRID_SYNC();

    {
        const float* gfin = args.in[I_GFIN];
        f32x4 gv[8];
#pragma unroll
        for (int j = 0; j < 8; ++j) gv[j] = *((const f32x4*)gfin + 64 * j + lane);
        for (int m = gw; m < NTOK; m += 2 * NGW) {
            const int m1 = (m + NGW < NTOK) ? m + NGW : m;
            f32x4* o0 = (f32x4*)(hbuf + (size_t)m * D) + lane; f32x4* o1 = (f32x4*)(hbuf + (size_t)m1 * D) + lane;
            const v2u* u0 = (const v2u*)(H3B + (size_t)m * D) + lane; const v2u* u1 = (const v2u*)(H3B + (size_t)m1 * D) + lane;
            const v2u* h0 = (const v2u*)(XN + (size_t)m * D) + lane; const v2u* h1 = (const v2u*)(XN + (size_t)m1 * D) + lane;
            v2u a0[8], a1[8], b0[8], b1[8];
#pragma unroll
            for (int j = 0; j < 8; ++j) { a0[j] = __builtin_nontemporal_load(u0 + 64 * j); a1[j] = __builtin_nontemporal_load(u1 + 64 * j); b0[j] = __builtin_nontemporal_load(h0 + 64 * j); b1[j] = __builtin_nontemporal_load(h1 + 64 * j); }
            f32x4 y0[8], y1[8]; float s0 = 0.f, s1 = 0.f;
#pragma unroll
            for (int j = 0; j < 8; ++j) {
                y0[j].x = __uint_as_float(a0[j].x << 16) + __uint_as_float(b0[j].x << 16); y0[j].y = __uint_as_float(a0[j].x & 0xffff0000u) + __uint_as_float(b0[j].x & 0xffff0000u);
                y0[j].z = __uint_as_float(a0[j].y << 16) + __uint_as_float(b0[j].y << 16); y0[j].w = __uint_as_float(a0[j].y & 0xffff0000u) + __uint_as_float(b0[j].y & 0xffff0000u);
                y1[j].x = __uint_as_float(a1[j].x << 16) + __uint_as_float(b1[j].x << 16); y1[j].y = __uint_as_float(a1[j].x & 0xffff0000u) + __uint_as_float(b1[j].x & 0xffff0000u);
                y1[j].z = __uint_as_float(a1[j].y << 16) + __uint_as_float(b1[j].y << 16); y1[j].w = __uint_as_float(a1[j].y & 0xffff0000u) + __uint_as_float(b1[j].y & 0xffff0000u);
                s0 += (y0[j].x * y0[j].x + y0[j].y * y0[j].y) + (y0[j].z * y0[j].z + y0[j].w * y0[j].w); s1 += (y1[j].x * y1[j].x + y1[j].y * y1[j].y) + (y1[j].z * y1[j].z + y1[j].w * y1[j].w); }
            const float r0 = rsqrtf(wave_sum(s0) * (1.f / D) + EPS), r1 = rsqrtf(wave_sum(s1) * (1.f / D) + EPS);
#pragma unroll
            for (int j = 0; j < 8; ++j) { __builtin_nontemporal_store(y0[j] * r0 * gv[j], o0 + 64 * j); __builtin_nontemporal_store(y1[j] * r1 * gv[j], o1 + 64 * j); }
        }
    }
}

extern "C" void kernel_launch(void* const* d_in, const int* in_sizes, int n_in, void* d_out, int out_size, void* d_ws, size_t ws_size, hipStream_t stream) {
    static int grid = 0;
    if (grid == 0) {
        if (n_in != 24 || out_size != NTOK * D || ws_size < WS_END) { fprintf(stderr, "kernel_launch: unexpected shapes (n_in %d, out %d, ws %zu)\n", n_in, out_size, ws_size); grid = -1; return; }
        int dev = 0, cus = 0;
        if (hipGetDevice(&dev) != hipSuccess || hipDeviceGetAttribute(&cus, hipDeviceAttributeMultiprocessorCount, dev) != hipSuccess) { grid = -1; return; }
        if (hipFuncSetAttribute((const void*)fwd_kernel, hipFuncAttributeMaxDynamicSharedMemorySize, LDS_BYTES) != hipSuccess) { fprintf(stderr, "kernel_launch: hipFuncSetAttribute failed\n"); grid = -1; return; }
        int per_cu = 0;
        if (hipOccupancyMaxActiveBlocksPerMultiprocessor(&per_cu, (const void*)fwd_kernel, NTHR, LDS_BYTES) != hipSuccess || per_cu < 1) { fprintf(stderr, "kernel_launch: occupancy query says %d\n", per_cu); }
        (void)hipGetLastError();
        grid = cus;
    }
    if (grid < 0) return;
    if (hipMemsetAsync((char*)d_ws + WS_CTL, 0, CTL_ZERO_BYTES, stream) != hipSuccess) return;
    Args a{};
    for (int i = 0; i < 24; ++i) a.in[i] = (const float*)d_in[i];
    a.out = (float*)d_out; a.ws = (unsigned char*)d_ws;
    hipLaunchKernelGGL(fwd_kernel, dim3(grid), dim3(NTHR), LDS_BYTES, stream, a);
}
```

```cpp
#include <hip/hip_runtime.h>
#include <cstdio>
#include <cstdint>

#define GAS __attribute__((address_space(1)))
#define LAS __attribute__((address_space(3)))
typedef unsigned short bf16;
typedef float f32x4 __attribute__((ext_vector_type(4)));
typedef unsigned v4u __attribute__((ext_vector_type(4)));
typedef unsigned v2u __attribute__((ext_vector_type(2)));

constexpr int NTOK = 32768, SEQ = 16384, D = 2048;
constexpr int QW = 1024, KVW = 128, QKVW = 1280, HW = 1024, INC = 9472;
constexpr int NEXP = 64, MH = 512, PLE = 256;
constexpr float EPS = 1e-6f;
constexpr int NWAVES = 8, NTHR = 512;
constexpr size_t HGPS = (size_t)NTOK * 128;
constexpr int HIDCAP = 81920;

constexpr size_t MiB = 1u << 20;
constexpr size_t WS_CTL = 0, CTL_ZERO_BYTES = 1 * MiB;
constexpr size_t WS_SMALL = 1 * MiB;
constexpr size_t WS_LIST = 2 * MiB;
constexpr size_t WS_WIN = 8 * MiB, WS_WUA = 45 * MiB, WS_WUR = 49 * MiB, WS_WOUT = 53 * MiB, WS_WPG = 61 * MiB, WS_WPI = 69 * MiB;
constexpr size_t WS_RA = 70 * MiB;
constexpr size_t WS_RB = 198 * MiB;
constexpr size_t WS_RC = 278 * MiB;
constexpr size_t WS_RD = 534 * MiB;
constexpr size_t WS_RE = 790 * MiB;
constexpr size_t WS_PB = 1046 * MiB;
constexpr size_t WS_SS = 1062 * MiB;
constexpr size_t WS_END = 1074 * MiB;
constexpr int CW_BAR = 4096;
constexpr int CW_CNT = 16384;
constexpr int CW_PACE = 32768;

__device__ __forceinline__ float bf2f(bf16 h) { return __uint_as_float(((unsigned)h) << 16); }
__device__ __forceinline__ unsigned f2bf(float f) { unsigned u = __float_as_uint(f); return (u + 0x7fffu + ((u >> 16) & 1u)) >> 16; }
__device__ __forceinline__ unsigned pk2(float lo, float hi) { return f2bf(lo) | (f2bf(hi) << 16); }
constexpr float LOG2E = 1.4426950408889634f;
__device__ __forceinline__ float fexp2(float x) { return __builtin_amdgcn_exp2f(x); }
__device__ __forceinline__ float fexp(float x) { return __builtin_amdgcn_exp2f(x * LOG2E); }
__device__ __forceinline__ float flog2(float x) { return __builtin_amdgcn_logf(x); }
__device__ __forceinline__ float wave_sum(float v) {
#pragma unroll
    for (int o = 1; o < 64; o <<= 1) v += __shfl_xor(v, o);
    return v;
}

#define XB_TMO      128
#define XB_XCNT(j)  (256  + 64 * (j))
#define XB_XSUB(j)  (1280 + 64 * (j))
#define XB_XGEN(j)  (2304 + 64 * (j))
#define XB_TOP      3328
#define XB_TOPGEN   3392
#define XCD_BAR_WORDS 3456
#define XB_SPIN_CAP (1u << 23)
__device__ __forceinline__ unsigned xb_ld(unsigned* p)              { return __hip_atomic_load(p, __ATOMIC_RELAXED, __HIP_MEMORY_SCOPE_AGENT); }
__device__ __forceinline__ unsigned xb_add(unsigned* p, unsigned v) { return __hip_atomic_fetch_add(p, v, __ATOMIC_RELAXED, __HIP_MEMORY_SCOPE_AGENT); }
__device__ __forceinline__ unsigned xb_xcc_id() { return (unsigned)__builtin_amdgcn_s_getreg((3 << 11) | 20) & 0xFu; }
#define XB_SPIN(cond, bar) do { unsigned _sp = 0; while (cond) { __builtin_amdgcn_s_sleep(1); \
    if ((++_sp & 255u) == 0u) { if (xb_ld(&(bar)[XB_TMO])) break; if (_sp > XB_SPIN_CAP) { atomicAdd(&(bar)[XB_TMO], 1u); break; } } } } while (0)
struct XcdBarrier { unsigned* bar; unsigned x; volatile LAS unsigned* st; };
__device__ __forceinline__ XcdBarrier xcd_barrier_post(unsigned* bar, volatile LAS unsigned* st, const int tid) {
    XcdBarrier b; b.bar = bar; b.x = xb_xcc_id(); b.st = st;
    if (tid == 0) (void)xb_add(&bar[XB_XCNT(b.x)], 1u);
    return b;
}
__device__ __forceinline__ void xcd_barrier_complete(unsigned* bar, unsigned x, unsigned& nloc, unsigned& nx) {
    const unsigned G = gridDim.x * gridDim.y * gridDim.z;
    unsigned sum, cnt, mine, sp = 0u;
    for (;;) {
        sum = 0u; cnt = 0u; mine = 0u;
#pragma unroll
        for (unsigned j = 0; j < 16; ++j) { const unsigned c = xb_ld(&bar[XB_XCNT(j)]); sum += c; cnt += (c > 0u) ? 1u : 0u; mine = (j == x) ? c : mine; }
        if (sum == G) break;
        __builtin_amdgcn_s_sleep(1);
        if ((++sp & 255u) == 0u) { if (xb_ld(&bar[XB_TMO])) break; if (sp > XB_SPIN_CAP) { atomicAdd(&bar[XB_TMO], 1u); break; } }
    }
    nloc = mine > 0u ? mine : 1u; nx = cnt > 0u ? cnt : 1u;
}
__device__ __forceinline__ void xcd_barrier(const XcdBarrier& b, const int tid) {
    asm volatile("s_waitcnt vmcnt(0)" ::: "memory");
    __syncthreads();
    if (tid == 0) {
        unsigned* bar = b.bar;
        __builtin_amdgcn_s_waitcnt(0);
        unsigned nloc = b.st[0], nx = b.st[1];
        if (nloc == 0u) { xcd_barrier_complete(bar, b.x, nloc, nx); b.st[0] = nloc; b.st[1] = nx; }
        const unsigned old = xb_add(&bar[XB_XSUB(b.x)], 1u);
        const unsigned gen = old / nloc;
        if (old + 1u == (gen + 1u) * nloc) {
            __builtin_amdgcn_fence(__ATOMIC_RELEASE, "agent");
            asm volatile("s_waitcnt vmcnt(0)" ::: "memory");
            const unsigned og = xb_add(&bar[XB_TOP], 1u);
            const unsigned tg = og / nx;
            if (og + 1u == (tg + 1u) * nx) xb_add(&bar[XB_TOPGEN], 1u);
            else XB_SPIN(xb_ld(&bar[XB_TOPGEN]) == tg, bar);
            __builtin_amdgcn_fence(__ATOMIC_ACQUIRE, "agent");
            xb_add(&bar[XB_XGEN(b.x)], 1u);
            asm volatile("s_waitcnt vmcnt(0)" ::: "memory");
        } else {
            XB_SPIN(xb_ld(&bar[XB_XGEN(b.x)]) == gen, bar);
            __builtin_amdgcn_fence(__ATOMIC_ACQUIRE, "agent");
            asm volatile("s_waitcnt vmcnt(0)" ::: "memory");
        }
    }
    __syncthreads();
}

struct Args {
    const float* in[24];
    float* out;
    unsigned char* ws;
};
enum { I_X = 0, I_P, I_GMIX, I_WIN, I_BQKV, I_SINKS, I_REL, I_LBL, I_GHGRN, I_WUA, I_WUR, I_WOUT, I_GFFN, I_WCO, I_BCO, I_WFI, I_BFI,
       I_WG, I_WU, I_WD, I_WPI, I_GPLE, I_WPG, I_GFIN };

__device__ __forceinline__ void transpose_item(const float* W, int K, int N, bf16* WT, LAS float* scr, int item, int lane, int gu, int ldw, const float* ks = nullptr) {
    const int nblk = N / 32, kb = item / nblk, nb = item % nblk, k0 = 64 * kb, n0 = 32 * nb;
    const int d0 = gu ? (256 * (n0 >> 7) + 64 * ((n0 & 127) >> 5) + 32 * (gu - 1)) : n0;
#pragma unroll 8
    for (int i = 0; i < 32; ++i) { const int kk = 2 * i + (lane >> 5); scr[kk * 33 + (lane & 31)] = __builtin_nontemporal_load(W + (size_t)(k0 + kk) * N + n0 + (lane & 31)); }
    asm volatile("s_waitcnt lgkmcnt(0)" ::: "memory");
    const int c = lane & 7;
    f32x4 k0s = (f32x4){1.f, 1.f, 1.f, 1.f}, k1s = k0s; if (ks) { k0s = *(const f32x4*)(ks + k0 + 8 * c); k1s = *(const f32x4*)(ks + k0 + 8 * c + 4); }
#pragma unroll
    for (int j = 0; j < 4; ++j) { const int n = (lane >> 3) + 8 * j; const LAS float* s = scr + (8 * c) * 33 + n;
        v4u o; o.x = pk2(s[0 * 33] * k0s[0], s[1 * 33] * k0s[1]); o.y = pk2(s[2 * 33] * k0s[2], s[3 * 33] * k0s[3]); o.z = pk2(s[4 * 33] * k1s[0], s[5 * 33] * k1s[1]); o.w = pk2(s[6 * 33] * k1s[2], s[7 * 33] * k1s[3]);
        *(v4u*)(WT + (size_t)(d0 + n) * ldw + k0 + 8 * c) = o; }
    asm volatile("s_waitcnt lgkmcnt(0)" ::: "memory");
}
__device__ __forceinline__ void transpose_all(const float* W, int K, int N, bf16* WT, LAS float* scr, int gw, int ngw, int lane, int ldw) {
    const int nitems = (K / 64) * (N / 32);
    for (int it = gw; it < nitems; it += ngw) transpose_item(W, K, N, WT, scr, it, lane, 0, ldw);
}

namespace pg8 {
typedef short bf16x8 __attribute__((ext_vector_type(8)));
typedef unsigned u32x4 __attribute__((ext_vector_type(4)));
constexpr int BM = 256, BK = 64, HALF = 128, HTB = HALF * BK * 2, STAGE_BYTES = 8 * HTB, NXCD = 8, WGM = 8;
__host__ __device__ __forceinline__ int lds_byte(int r, int c) { const int st = (r >> 4) * 2 + (c >> 5), rr = r & 15, cc = c & 31, ob = rr * 64 + cc * 2; return st * 1024 + (ob ^ (((ob >> 9) & 1) << 5)); }
__host__ __device__ __forceinline__ void stage_rc(int b, int& R, int& C) { const int st = b / 1024, sb = b % 1024, swz = sb ^ (((sb >> 9) & 1) << 5); R = (st >> 1) * 16 + swz / 64; C = (st & 1) * 32 + (swz % 64) / 2; }
__host__ __device__ __forceinline__ int perm32(int rho) { const int n = rho >> 4, i = rho & 15; return 8 * (i >> 2) + 4 * n + (i & 3); }
struct Unit { int pm, pn; const char* a; const char* b; int e, r0, cnt, row0; };
typedef __bf16 bfv2_t __attribute__((ext_vector_type(2))); typedef float fv2_t __attribute__((ext_vector_type(2)));
__device__ __forceinline__ unsigned cvt_pk_bf16(float lo, float hi) { fv2_t v; v.x = lo; v.y = hi; return __builtin_bit_cast(unsigned, __builtin_convertvector(v, bfv2_t)); }

struct StaticOrder {
    int nM, nN, nwg, G, c; const char* A; const char* Bt; size_t tstepA, tstepB;
    __device__ __forceinline__ void init(const bf16* A_, const bf16* Bt_, int M, int N, int lda, int ldb, int G_, int c_) { nM = M / BM; nN = N / BM; nwg = nM * nN; G = G_; c = c_; A = (const char*)A_; Bt = (const char*)Bt_; tstepA = (size_t)BM * lda * 2; tstepB = (size_t)BM * ldb * 2; pace = nullptr; }
    __device__ __forceinline__ bool next(int i, Unit& u) const {
        const long L = (long)i * G + c; if (L >= nwg) return false;
        int wgid = (int)L; { const int q = nwg / NXCD, r = nwg % NXCD, xcd = wgid % NXCD, off = wgid / NXCD; wgid = (xcd < r ? xcd * (q + 1) : r * (q + 1) + (xcd - r) * q) + off; }
        const int nig = WGM * nN, gid = wgid / nig, fm = gid * WGM, gsz = (nM - fm) < WGM ? (nM - fm) : WGM;
        u.pm = fm + ((wgid % nig) % gsz); u.pn = (wgid % nig) / gsz; u.a = A + (size_t)u.pm * tstepA; u.b = Bt + (size_t)u.pn * tstepB; u.e = 0; u.r0 = 0; u.cnt = 0; u.row0 = 0; return true;
    }
    __device__ __forceinline__ unsigned row_off(const Unit&, int) const { return 0u; }
    unsigned* pace;
    __device__ __forceinline__ void pace_arrive_wait(int ui, int wid, int lane) const {
        if (pace == nullptr || wid != 0) return;
        unsigned* p = pace + 64 * (c & 7);
        if (lane == 0) __hip_atomic_fetch_add(p, 1u, __ATOMIC_RELAXED, __HIP_MEMORY_SCOPE_AGENT);
        const unsigned want = (unsigned)(G >> 3) * (unsigned)(ui + 1);
        for (int sp = 0; sp < 4096; ++sp) { if (__hip_atomic_load(p, __ATOMIC_RELAXED, __HIP_MEMORY_SCOPE_AGENT) >= want) break; __builtin_amdgcn_s_sleep(2); }
    }
    __device__ __forceinline__ void pace_finish(int units_done, int wid, int lane) const {
        if (pace == nullptr || wid != 0 || lane != 0) return;
        const int rmax = (nwg + G - 1) / G;
        if (units_done < rmax) __hip_atomic_fetch_add(pace + 64 * (c & 7), (unsigned)(rmax - units_done), __ATOMIC_RELAXED, __HIP_MEMORY_SCOPE_AGENT);
    }
};

struct PairOrder {
    StaticOrder s0; const char* A1; const char* B1;
    __device__ __forceinline__ bool next(int i, Unit& u) const {
        if (!s0.next(i >> 1, u)) return false;
        if (i & 1) { u.a = A1 + (size_t)u.pm * s0.tstepA; u.b = B1 + (size_t)u.pn * s0.tstepB; u.e = 1; }
        return true;
    }
    __device__ __forceinline__ unsigned row_off(const Unit&, int) const { return 0u; }
    __device__ __forceinline__ void pace_arrive_wait(int, int, int) const {}
    __device__ __forceinline__ void pace_finish(int, int, int) const {}
};

template <class Epi, class Sched, bool ALIGN_EPI, bool GATHER>
__device__ __forceinline__ void gemm_phase(LAS unsigned char* lds, const int K, const int lda, const int ldb, const Sched& S, const Epi& E, const int tid) {
    const int wid = __builtin_amdgcn_readfirstlane(tid >> 6), lane = tid & 63, wr = wid >> 2, wc = wid & 3, fr = lane & 15, fq = lane >> 4;
    const int nt = K / BK;
    int Rr[2], Cc[2];
    unsigned voffA[2][2], voffB[2][2], voffAn[2][2];
#pragma unroll
    for (int i = 0; i < 2; ++i) { stage_rc(tid * 16 + i * 8192, Rr[i], Cc[i]);
#pragma unroll
        for (int h = 0; h < 2; ++h) { const int Rb = Epi::PERM ? (64 * (Rr[i] >> 5) + 32 * h + perm32(Rr[i] & 31)) : h * HALF + Rr[i];
            voffB[h][i] = (unsigned)(Rb * ldb + Cc[i]) * 2u; voffA[h][i] = (unsigned)((h * HALF + Rr[i]) * lda + Cc[i]) * 2u; voffAn[h][i] = voffA[h][i]; } }
    const size_t kstep = (size_t)(BK * 2);
    const unsigned ldsw = (unsigned)wid * 1024u;
    const int aoff = lds_byte(wr * 64 + fr, fq * 8), boff = lds_byte(wc * 32 + fr, fq * 8);
#define PG8_SA(b, h) (((b) * 2 + (h)) * HTB)
#define PG8_SB(b, h) ((4 + (b) * 2 + (h)) * HTB)
#define PG8_STAGE(bufoff, gbase, voff) do { const char* _gb = (const char*)(gbase); asm volatile("" : "+s"(_gb));     \
        _Pragma("unroll") for (int _i = 0; _i < 2; ++_i) \
        __builtin_amdgcn_global_load_lds((const unsigned*)(_gb + (voff)[_i]), (LAS unsigned*)(lds + (bufoff) + ldsw + _i * 8192), 16, 0, 0); } while (0)
#define PG8_LDA(dst, b, h) do { _Pragma("unroll") for (int m = 0; m < 4; ++m) _Pragma("unroll") for (int k = 0; k < 2; ++k) dst[m][k] = *(const LAS bf16x8*)(lds + PG8_SA(b, h) + aoff + m * 2048 + k * 1024); } while (0)
#define PG8_LDB(dst, b, h) do { _Pragma("unroll") for (int n = 0; n < 2; ++n) _Pragma("unroll") for (int k = 0; k < 2; ++k) dst[n][k] = *(const LAS bf16x8*)(lds + PG8_SB(b, h) + boff + n * 2048 + k * 1024); } while (0)
#define PG8_MMA(ai, bj, At, Bt) do { __builtin_amdgcn_s_setprio(1); _Pragma("unroll") for (int m = 0; m < 4; ++m) _Pragma("unroll") for (int n = 0; n < 2; ++n) _Pragma("unroll") for (int k = 0; k < 2; ++k) \
        acc[ai][bj][m][n] = __builtin_amdgcn_mfma_f32_16x16x32_bf16(Bt[n][k], At[m][k], acc[ai][bj][m][n], 0, 0, 0); __builtin_amdgcn_s_setprio(0); } while (0)
#define PG8_WAIT_V(n) asm volatile("s_waitcnt vmcnt(" #n ")" ::: "memory")
#define PG8_WAIT_L(n) asm volatile("s_waitcnt lgkmcnt(" #n ")" ::: "memory")
#define PG8_BAR __builtin_amdgcn_s_barrier()
#define PG8_SCHED __builtin_amdgcn_sched_barrier(0)
    Unit cur, nxt; int ui = 0;
    if (!S.next(0, cur)) return;
    if constexpr (GATHER) {
#pragma unroll
        for (int h = 0; h < 2; ++h)
#pragma unroll
            for (int i = 0; i < 2; ++i) voffA[h][i] = S.row_off(cur, h * HALF + Rr[i]) + (unsigned)Cc[i] * 2u;
    }
    f32x4 acc[2][2][4][2];
#pragma unroll
    for (int a = 0; a < 2; ++a)
#pragma unroll
        for (int b = 0; b < 2; ++b)
#pragma unroll
            for (int m = 0; m < 4; ++m)
#pragma unroll
                for (int n = 0; n < 2; ++n) acc[a][b][m][n] = (f32x4){0.f, 0.f, 0.f, 0.f};
    bf16x8 At[4][2], B0[2][2], B1[2][2];
    const char* cA = cur.a; const char* cB = cur.b;
    PG8_STAGE(PG8_SB(0, 0), cB, voffB[0]); PG8_STAGE(PG8_SB(0, 1), cB, voffB[1]); PG8_STAGE(PG8_SA(0, 0), cA, voffA[0]); PG8_STAGE(PG8_SA(0, 1), cA, voffA[1]);
    if (wr == 1) PG8_BAR;
    PG8_WAIT_V(2); PG8_BAR;
    PG8_STAGE(PG8_SB(1, 0), cB + kstep, voffB[0]); PG8_STAGE(PG8_SA(1, 0), cA + kstep, voffA[0]); PG8_STAGE(PG8_SB(1, 1), cB + kstep, voffB[1]);
    PG8_WAIT_V(6); PG8_BAR;
    for (;;) {
        const bool has_next = S.next(ui + 1, nxt);
        const char* nA = has_next ? nxt.a : cA; const char* nB = has_next ? nxt.b : cB;
        if constexpr (GATHER) {
#pragma unroll
            for (int h = 0; h < 2; ++h)
#pragma unroll
                for (int i = 0; i < 2; ++i) voffAn[h][i] = has_next ? S.row_off(nxt, h * HALF + Rr[i]) + (unsigned)Cc[i] * 2u : voffA[h][i];
        }
        for (int t = 0; t < nt; t += 2) {
            const bool last = (t == nt - 2);
            if (last) S.pace_arrive_wait(ui, wid, lane);
            const char* a1 = cA + (size_t)(t + 1) * kstep;
            const char* a2 = last ? nA : cA + (size_t)(t + 2) * kstep; const char* b2 = last ? nB : cB + (size_t)(t + 2) * kstep;
            const char* a3 = a2 + kstep; const char* b3 = b2 + kstep;
            PG8_LDB(B0, 0, 0); PG8_LDB(B1, 0, 1); PG8_SCHED; PG8_LDA(At, 0, 0); PG8_STAGE(PG8_SA(1, 1), a1, voffA[1]);
            if constexpr (GATHER) { if (last) {
#pragma unroll
                for (int h = 0; h < 2; ++h)
#pragma unroll
                    for (int i = 0; i < 2; ++i) voffA[h][i] = voffAn[h][i]; } }
            PG8_WAIT_V(8); PG8_WAIT_L(0); PG8_BAR; PG8_MMA(0, 0, At, B0); PG8_MMA(0, 1, At, B1); PG8_BAR; PG8_SCHED;
            PG8_LDA(At, 0, 1); PG8_STAGE(PG8_SB(0, 0), b2, voffB[0]); PG8_STAGE(PG8_SB(0, 1), b2, voffB[1]); PG8_STAGE(PG8_SA(0, 0), a2, voffA[0]);
            PG8_WAIT_V(8); PG8_WAIT_L(0); PG8_BAR; PG8_MMA(1, 0, At, B0); PG8_MMA(1, 1, At, B1); PG8_BAR; PG8_SCHED;
            PG8_LDB(B0, 1, 0); PG8_LDB(B1, 1, 1); PG8_SCHED; PG8_LDA(At, 1, 0); PG8_STAGE(PG8_SA(0, 1), a2, voffA[1]);
            PG8_WAIT_V(8); PG8_WAIT_L(0); PG8_BAR; PG8_MMA(0, 0, At, B0); PG8_MMA(0, 1, At, B1); PG8_BAR; PG8_SCHED;
            PG8_LDA(At, 1, 1); PG8_STAGE(PG8_SB(1, 0), b3, voffB[0]); PG8_STAGE(PG8_SB(1, 1), b3, voffB[1]); PG8_STAGE(PG8_SA(1, 0), a3, voffA[0]);
            PG8_WAIT_V(8); PG8_WAIT_L(0); PG8_BAR; PG8_MMA(1, 0, At, B0); PG8_MMA(1, 1, At, B1); PG8_BAR; PG8_SCHED;
        }
        if constexpr (ALIGN_EPI) { if (wr == 0) PG8_BAR; }
        E(acc, cur, wr, wc, fr, fq);
        if (!has_next) { S.pace_finish(ui + 1, wid, lane); break; }
#pragma unroll
        for (int a = 0; a < 2; ++a)
#pragma unroll
            for (int b = 0; b < 2; ++b)
#pragma unroll
                for (int m = 0; m < 4; ++m)
#pragma unroll
                    for (int n = 0; n < 2; ++n) acc[a][b][m][n] = (f32x4){0.f, 0.f, 0.f, 0.f};
        cur = nxt; cA = nA; cB = nB; ++ui;
        if constexpr (ALIGN_EPI) { if (wr == 1) PG8_BAR; }
    }
    PG8_WAIT_V(0);
    if constexpr (!ALIGN_EPI) { if (wr == 0) PG8_BAR; }
    PG8_BAR;
#undef PG8_SA
#undef PG8_SB
#undef PG8_STAGE
#undef PG8_LDA
#undef PG8_LDB
#undef PG8_MMA
#undef PG8_WAIT_V
#undef PG8_WAIT_L
#undef PG8_BAR
#undef PG8_SCHED
}

__device__ __forceinline__ void line_pair(const u32x4 v0, const u32x4 v1, const bool odd, u32x4& a, u32x4& b) {
#pragma unroll
    for (int j = 0; j < 4; ++j) { const unsigned x = odd ? v0[j] : v1[j]; const unsigned y = (unsigned)__builtin_amdgcn_update_dpp(0, (int)x, 0xB1, 0xf, 0xf, false);
        a[j] = odd ? y : v0[j]; b[j] = odd ? v1[j] : y; }
}
__device__ __forceinline__ float fsig(float x) { return __builtin_amdgcn_rcpf(1.f + fexp2(x * -LOG2E)); }
__device__ __forceinline__ u32x4 pack8(const f32x4 a, const f32x4 b) { u32x4 w; w.x = cvt_pk_bf16(a[0], a[1]); w.y = cvt_pk_bf16(a[2], a[3]); w.z = cvt_pk_bf16(b[0], b[1]); w.w = cvt_pk_bf16(b[2], b[3]); return w; }
__device__ __forceinline__ void unpack8(const u32x4 w, f32x4& a, f32x4& b) {
    a[0] = __uint_as_float(w.x << 16); a[1] = __uint_as_float(w.x & 0xffff0000u); a[2] = __uint_as_float(w.y << 16); a[3] = __uint_as_float(w.y & 0xffff0000u);
    b[0] = __uint_as_float(w.z << 16); b[1] = __uint_as_float(w.z & 0xffff0000u); b[2] = __uint_as_float(w.w << 16); b[3] = __uint_as_float(w.w & 0xffff0000u); }

template <int MODE>
__device__ __forceinline__ void epiz_body(const f32x4 (&acc)[2][2][4][2], bf16* base, const int ldc, const int row0, const int oc, const float* vec, const int img_off = 0, const bool odd = false) {
    f32x4 bv[2][2];
#pragma unroll
    for (int bj = 0; bj < 2; ++bj)
#pragma unroll
        for (int n = 0; n < 2; ++n) bv[bj][n] = (MODE == 0 || MODE == 1 || MODE == 3) ? *(const f32x4*)(vec + bj * 32 + 4 * n) : (f32x4){0.f, 0.f, 0.f, 0.f};
#pragma unroll
    for (int ai = 0; ai < 2; ++ai)
#pragma unroll
        for (int m = 0; m < 4; ++m) { bf16* rowp = base + (size_t)(row0 + ai * HALF + m * 16) * ldc + oc; u32x4 pk[2];
#pragma unroll
            for (int bj = 0; bj < 2; ++bj) { f32x4 v[2];
#pragma unroll
                for (int n = 0; n < 2; ++n) { f32x4 x = acc[ai][bj][m][n];
                    if (MODE == 0) x = (x + bv[bj][n]) * (0.125f * LOG2E);
                    else if (MODE == 1) x = x + bv[bj][n];
                    else if (MODE == 2) {
#pragma unroll
                        for (int j = 0; j < 4; ++j) x[j] = x[j] * fsig(x[j]); }
                    else if (MODE == 3) {
#pragma unroll
                        for (int j = 0; j < 4; ++j) { const float l = bv[bj][n][j]; x[j] = flog2(l + (1.f - l) * fsig(x[j])); } }
                    else if (MODE == 6) {
#pragma unroll
                        for (int j = 0; j < 4; ++j) x[j] = fsig(x[j]); }
                    v[n] = x; }
                if (MODE == 6) *(u32x4*)((unsigned char*)base + ((ai * 4 + m) * 2 + bj) * 8192 + img_off) = pack8(v[0], v[1]);
                else pk[bj] = pack8(v[0], v[1]); }
            if (MODE != 6) { u32x4 a, b; line_pair(pk[0], pk[1], odd, a, b); *(u32x4*)rowp = a; *(u32x4*)(rowp + ldc) = b; } }
}
struct EpiZ {
    static constexpr bool PERM = true;
    const float* bqkv; const float* lb; bf16* Q; bf16* KV; bf16* HG; bf16* GT;
    __device__ __forceinline__ void operator()(const f32x4 (&acc)[2][2][4][2], const Unit& u, int wr, int wc, int fr, int fq) const {
        const bool odd = fr & 1; const int row0 = u.pm * BM + wr * 64 + (fr & ~1), cb = u.pn * BM + wc * 64 + 8 * fq, cl = cb + (odd ? 32 : 0);
        if (u.pn < 4) epiz_body<0>(acc, Q, QW, row0, cl, bqkv + cb, 0, odd);
        else if (u.pn == 4) epiz_body<1>(acc, KV, 256, row0, cl - QW, bqkv + cb, 0, odd);
        else if (u.pn < 21) { const int ct = (u.pn - 5) * 256 + (wc >> 1) * 128; bf16* hb = HG + (size_t)((ct >> 10) * 8 + ((ct >> 7) & 7)) * HGPS; const int oc = (wc & 1) * 64 + 8 * fq + (odd ? 32 : 0);
            if (u.pn < 9) epiz_body<2>(acc, hb, 128, row0, oc, nullptr, 0, odd);
            else if (u.pn < 13) epiz_body<3>(acc, hb, 128, row0, oc, lb + ((cb - QKVW) & 1023), 0, odd);
            else if (u.pn < 17) epiz_body<4>(acc, hb, 128, row0, oc, nullptr, 0, odd);
            else epiz_body<2>(acc, hb, 128, row0, oc, nullptr, 0, odd); }
        else epiz_body<6>(acc, GT + (size_t)(u.pm * 16 + (u.pn - 21)) * 65536, 0, 0, 0, nullptr, (wr * 4 + wc) * 1024 + (fq * 16 + fr) * 16);
    }
};
struct EpiMix {
    static constexpr bool PERM = true;
    const bf16* GT; bf16* MIX; unsigned char* PART;
    template <bool SECOND>
    __device__ __forceinline__ void body(const f32x4 (&acc)[2][2][4][2], const int row0, const int cl, const bool odd, const unsigned char* gimg, unsigned char* pimg) const {
#pragma unroll
        for (int ai = 0; ai < 2; ++ai)
#pragma unroll
        for (int mh = 0; mh < 2; ++mh) {
            u32x4 g[2][2], o[2][2];
#pragma unroll
            for (int m2 = 0; m2 < 2; ++m2)
#pragma unroll
                for (int bj = 0; bj < 2; ++bj) {
                    g[m2][bj] = __builtin_nontemporal_load((const u32x4*)(gimg + ((ai * 4 + 2 * mh + m2) * 2 + bj) * 8192));
                    if (SECOND) o[m2][bj] = *(const u32x4*)(pimg + ((ai * 4 + 2 * mh + m2) * 2 + bj) * 8192); }
#pragma unroll
            for (int m2 = 0; m2 < 2; ++m2) { const int m = 2 * mh + m2; u32x4 pk[2];
#pragma unroll
                for (int bj = 0; bj < 2; ++bj) {
                    f32x4 g0, g1; unpack8(g[m2][bj], g0, g1);
                    f32x4 v0 = acc[ai][bj][m][0] * g0, v1 = acc[ai][bj][m][1] * g1;
                    if (SECOND) { f32x4 o0, o1; unpack8(o[m2][bj], o0, o1); v0 += o0; v1 += o1; }
                    if (SECOND) pk[bj] = pack8(v0, v1); else *(u32x4*)(pimg + ((ai * 4 + m) * 2 + bj) * 8192) = pack8(v0, v1); }
                if (SECOND) { u32x4 a, b; line_pair(pk[0], pk[1], odd, a, b); bf16* rp = MIX + (size_t)(row0 + ai * HALF + m * 16) * D + cl; *(u32x4*)rp = a; *(u32x4*)(rp + D) = b; } }
        }
    }
    __device__ __forceinline__ void operator()(const f32x4 (&acc)[2][2][4][2], const Unit& u, int wr, int wc, int fr, int fq) const {
        const bool odd = fr & 1; const int row0 = u.pm * BM + wr * 64 + (fr & ~1), cl = u.pn * BM + wc * 64 + 8 * fq + (odd ? 32 : 0);
        const unsigned char* gimg = (const unsigned char*)GT + (size_t)(u.pm * 16 + (u.e ? 8 : 0) + u.pn) * 131072 + (wr * 4 + wc) * 1024 + (fq * 16 + fr) * 16;
        unsigned char* pimg = PART + (wr * 4 + wc) * 1024 + (fq * 16 + fr) * 16;
        if (u.e) body<true>(acc, row0, cl, odd, gimg, pimg); else body<false>(acc, row0, cl, odd, gimg, pimg);
    }
};
__device__ __forceinline__ void ss_slot(float s, float* SS, int row, int slot, int fq) {
    s += __shfl_xor(s, 16); s += __shfl_xor(s, 32);
    if (fq == 0) SS[(size_t)row * 32 + slot] = s;
}
struct EpiDelta {
    static constexpr bool PERM = true;
    bf16* DL;
    __device__ __forceinline__ void operator()(const f32x4 (&acc)[2][2][4][2], const Unit& u, int wr, int wc, int fr, int fq) const {
        unsigned char* dimg = (unsigned char*)DL + (size_t)(u.pm * 8 + u.pn) * 131072 + (wr * 4 + wc) * 1024 + (fq * 16 + fr) * 16;
#pragma unroll
        for (int ai = 0; ai < 2; ++ai)
#pragma unroll
            for (int m = 0; m < 4; ++m)
#pragma unroll
                for (int bj = 0; bj < 2; ++bj) *(u32x4*)(dimg + ((ai * 4 + m) * 2 + bj) * 8192) = pack8(acc[ai][bj][m][0], acc[ai][bj][m][1]);
    }
};
struct EpiPleRaw {
    static constexpr bool PERM = true;
    bf16* PL; float* SS;
    __device__ __forceinline__ void operator()(const f32x4 (&acc)[2][2][4][2], const Unit& u, int wr, int wc, int fr, int fq) const {
        const int row0 = u.pm * BM + wr * 64 + fr;
        unsigned char* pimg = (unsigned char*)PL + (size_t)(u.pm * 8 + u.pn) * 131072 + (wr * 4 + wc) * 1024 + (fq * 16 + fr) * 16;
#pragma unroll
        for (int ai = 0; ai < 2; ++ai)
#pragma unroll
            for (int m = 0; m < 4; ++m) { const int row = row0 + ai * HALF + m * 16; float s = 0.f;
#pragma unroll
                for (int bj = 0; bj < 2; ++bj) { const f32x4 a = acc[ai][bj][m][0], b = acc[ai][bj][m][1];
                    s += ((a[0] * a[0] + a[1] * a[1]) + (a[2] * a[2] + a[3] * a[3])) + ((b[0] * b[0] + b[1] * b[1]) + (b[2] * b[2] + b[3] * b[3]));
                    *(u32x4*)(pimg + ((ai * 4 + m) * 2 + bj) * 8192) = pack8(a, b); }
                ss_slot(s, SS, row, u.pn * 4 + wc, fq); }
    }
};
struct EpiPleGate {
    static constexpr bool PERM = true;
    bf16* UPD; const bf16* PL; const float* rstd3; const float* rstdp; const float* gple;
    __device__ __forceinline__ void operator()(const f32x4 (&acc)[2][2][4][2], const Unit& u, int wr, int wc, int fr, int fq) const {
        const bool odd = fr & 1; const int row0 = u.pm * BM + wr * 64 + fr, cb = u.pn * BM + wc * 64 + 8 * fq, cl = cb + (odd ? 32 : 0);
        const unsigned char* pimg = (const unsigned char*)PL + (size_t)(u.pm * 8 + u.pn) * 131072 + (wr * 4 + wc) * 1024 + (fq * 16 + fr) * 16;
        f32x4 gp[2][2];
#pragma unroll
        for (int bj = 0; bj < 2; ++bj)
#pragma unroll
            for (int n = 0; n < 2; ++n) gp[bj][n] = *(const f32x4*)(gple + cb + bj * 32 + 4 * n);
#pragma unroll
        for (int ai = 0; ai < 2; ++ai) {
            u32x4 pp[4][2]; float r3[4], rp[4];
#pragma unroll
            for (int m = 0; m < 4; ++m) { const int row = row0 + ai * HALF + m * 16; r3[m] = rstd3[row]; rp[m] = rstdp[row];
#pragma unroll
                for (int bj = 0; bj < 2; ++bj) pp[m][bj] = __builtin_nontemporal_load((const u32x4*)(pimg + ((ai * 4 + m) * 2 + bj) * 8192)); }
#pragma unroll
            for (int m = 0; m < 4; ++m) { const int row = (row0 & ~1) + ai * HALF + m * 16; u32x4 pk[2];
#pragma unroll
                for (int bj = 0; bj < 2; ++bj) {
                    f32x4 p0, p1; unpack8(pp[m][bj], p0, p1);
                    f32x4 g0 = acc[ai][bj][m][0] * r3[m], g1 = acc[ai][bj][m][1] * r3[m];
#pragma unroll
                    for (int j = 0; j < 4; ++j) { g0[j] = fsig(g0[j]); g1[j] = fsig(g1[j]); }
                    pk[bj] = pack8(p0 * rp[m] * gp[bj][0] * g0, p1 * rp[m] * gp[bj][1] * g1); }
                u32x4 a, b; line_pair(pk[0], pk[1], odd, a, b); bf16* up = UPD + (size_t)row * D + cl; *(u32x4*)up = a; *(u32x4*)(up + D) = b; }
        }
    }
};

struct MoeOrder {
    const LAS int* eoff; const LAS int* ecnt; int NT, G, c, total_rb; const char* A; const char* W; size_t wexp, tstepB, arow_bytes; const unsigned short* LIST; int gather;
    __device__ __forceinline__ bool next(int i, Unit& u) const {
        const int it = i * G + c; if (it >= total_rb * NT) return false;
        const int rb = it / NT, pn = it % NT, row0 = rb * BM;
        int e = 0; { int hi = NEXP;
#pragma unroll
            for (int st = 0; st < 6; ++st) { const int mid = (e + hi) >> 1; if (eoff[mid] <= row0) e = mid; else hi = mid; } }
        e = __builtin_amdgcn_readfirstlane(e);
        u.pm = rb; u.pn = pn; u.e = e; u.r0 = __builtin_amdgcn_readfirstlane(row0 - eoff[e]); u.cnt = __builtin_amdgcn_readfirstlane(ecnt[e]); u.row0 = row0;
        u.a = gather ? A : A + (size_t)row0 * arow_bytes; u.b = W + (size_t)e * wexp + (size_t)pn * tstepB; return true;
    }
    __device__ __forceinline__ void pace_arrive_wait(int, int, int) const {}
    __device__ __forceinline__ void pace_finish(int, int, int) const {}
    __device__ __forceinline__ unsigned row_off(const Unit& u, int row) const {
        const unsigned short* lp = LIST + (size_t)u.e * NTOK + u.r0;
        const unsigned tok = (row < u.cnt - u.r0) ? (unsigned)(lp[row] & 0x7fffu) : 0u; return tok * (unsigned)arow_bytes;
    }
};
struct EpiGateUp {
    static constexpr bool PERM = true;
    bf16* HID; const unsigned short* LIST; const float* RSTD2;
    __device__ __forceinline__ void operator()(const f32x4 (&acc)[2][2][4][2], const Unit& u, int wr, int wc, int fr, int fq) const {
        const int row0 = u.row0 + wr * 64 + fr, cb = u.pn * HALF + wc * 32 + 8 * fq;
        const unsigned short* lp = LIST + (size_t)u.e * NTOK + u.r0;
        unsigned tk[2][4]; float rs[2][4];
#pragma unroll
        for (int ai = 0; ai < 2; ++ai)
#pragma unroll
            for (int m = 0; m < 4; ++m) { const int lr = ai * HALF + wr * 64 + m * 16 + fr; tk[ai][m] = (lr < u.cnt - u.r0) ? (unsigned)(lp[lr] & 0x7fffu) : 0u; }
#pragma unroll
        for (int ai = 0; ai < 2; ++ai)
#pragma unroll
            for (int m = 0; m < 4; ++m) rs[ai][m] = RSTD2[tk[ai][m]];
#pragma unroll
        for (int ai = 0; ai < 2; ++ai)
#pragma unroll
            for (int m = 0; m < 4; ++m) { f32x4 v[2];
#pragma unroll
                for (int n = 0; n < 2; ++n) { const f32x4 g = acc[ai][0][m][n] * rs[ai][m], up = acc[ai][1][m][n] * rs[ai][m];
#pragma unroll
                    for (int j = 0; j < 4; ++j) v[n][j] = g[j] * fsig(g[j]) * up[j]; }
                *(u32x4*)(HID + (size_t)(row0 + ai * HALF + m * 16) * MH + cb) = pack8(v[0], v[1]); }
    }
};
struct EpiDown {
    static constexpr bool PERM = true;
    const unsigned short* LIST; const float* TW; bf16* Y;
    __device__ __forceinline__ void operator()(const f32x4 (&acc)[2][2][4][2], const Unit& u, int wr, int wc, int fr, int fq) const {
        const bool odd = fr & 1; const int cl = u.pn * BM + wc * 64 + 8 * fq + (odd ? 32 : 0);
        const unsigned short* lp = LIST + (size_t)u.e * NTOK + u.r0;
        unsigned entE[2][4], entO[2][4]; float w[2][4];
#pragma unroll
        for (int ai = 0; ai < 2; ++ai)
#pragma unroll
            for (int m = 0; m < 4; ++m) { const int lr = ai * HALF + wr * 64 + m * 16 + (fr & ~1), nv = u.cnt - u.r0;
                entE[ai][m] = (lr < nv) ? (unsigned)lp[lr] : 0x10000u; entO[ai][m] = (lr + 1 < nv) ? (unsigned)lp[lr + 1] : 0x10000u; }
#pragma unroll
        for (int ai = 0; ai < 2; ++ai)
#pragma unroll
            for (int m = 0; m < 4; ++m) { const unsigned a = entE[ai][m], b = entO[ai][m], eo = odd ? b : a; w[ai][m] = TW[(eo & 0x7fffu) * 2 + ((eo >> 15) & 1u)]; }
#pragma unroll
        for (int ai = 0; ai < 2; ++ai)
#pragma unroll
            for (int m = 0; m < 4; ++m) { u32x4 a, b;
                line_pair(pack8(acc[ai][0][m][0] * w[ai][m], acc[ai][0][m][1] * w[ai][m]), pack8(acc[ai][1][m][0] * w[ai][m], acc[ai][1][m][1] * w[ai][m]), odd, a, b);
#pragma unroll
                for (int o = 0; o < 2; ++o) { const unsigned e = o ? entO[ai][m] : entE[ai][m]; if (!(e & 0x10000u)) { const unsigned tok = e & 0x7fffu, k = (e >> 15) & 1u;
                    *(u32x4*)(Y + (size_t)k * NTOK * D + (size_t)tok * D + cl) = o ? b : a; } } }
    }
};
}

namespace hg {
typedef short s16x4 __attribute__((ext_vector_type(4)));
typedef short bf16x8 __attribute__((ext_vector_type(8)));
typedef __bf16 bfv2 __attribute__((ext_vector_type(2)));
typedef float fv2 __attribute__((ext_vector_type(2)));
constexpr int RS = 272, IMG = 64 * RS;
constexpr int L_QI = 0, L_QR = IMG, L_KR = 2 * IMG, L_KL = 3 * IMG, L_V = 4 * IMG;
constexpr int L_SEG = 5 * IMG, L_D = L_SEG + 4096, L_RED = L_D + 512, L_RSTD = L_RED + 2048, L_END = L_RSTD + 256;
__device__ __forceinline__ unsigned cvtpk(float lo, float hi) { fv2 v; v.x = lo; v.y = hi; return __builtin_bit_cast(unsigned, __builtin_convertvector(v, bfv2)); }
__device__ __forceinline__ float blo(unsigned u) { return __uint_as_float(u << 16); }
__device__ __forceinline__ float bhi(unsigned u) { return __uint_as_float(u & 0xffff0000u); }
__device__ __forceinline__ bf16x8 frag_from2(const f32x4 a, const f32x4 b) { v4u w; w.x = cvtpk(a[0], a[1]); w.y = cvtpk(a[2], a[3]); w.z = cvtpk(b[0], b[1]); w.w = cvtpk(b[2], b[3]); return __builtin_bit_cast(bf16x8, w); }
__device__ __forceinline__ bf16x8 frag_tr2(LAS unsigned char* p0, LAS unsigned char* p1) {
    const s16x4 lo = __builtin_amdgcn_ds_read_tr16_b64_v4i16((LAS s16x4*)p0), hi = __builtin_amdgcn_ds_read_tr16_b64_v4i16((LAS s16x4*)p1);
    return __builtin_shufflevector(lo, hi, 0, 1, 2, 3, 4, 5, 6, 7); }
__device__ __forceinline__ bf16x8 frag_2x8(LAS unsigned char* p0, LAS unsigned char* p1) { v4u w; const v2u a = *(const LAS v2u*)p0, b = *(const LAS v2u*)p1; w.x = a.x; w.y = a.y; w.z = b.x; w.w = b.y; return __builtin_bit_cast(bf16x8, w); }
__device__ __forceinline__ float row_sum16(float s) {
    s += __int_as_float(__builtin_amdgcn_update_dpp(0, __float_as_int(s), 0x128, 0xf, 0xf, false));
    s += __int_as_float(__builtin_amdgcn_update_dpp(0, __float_as_int(s), 0x124, 0xf, 0xf, false));
    s += __int_as_float(__builtin_amdgcn_update_dpp(0, __float_as_int(s), 0x122, 0xf, 0xf, false));
    s += __int_as_float(__builtin_amdgcn_update_dpp(0, __float_as_int(s), 0x121, 0xf, 0xf, false));
    return s; }
#define HG_MFMA(a, b, c) __builtin_amdgcn_mfma_f32_16x16x32_bf16((a), (b), (c), 0, 0, 0)

template <bool P1>
__device__ __forceinline__ void unit(LAS unsigned char* lds, const bf16* HG, bf16* OREC, float* UST, float* DST, const float* ghg, const int u, const int tid) {
    const int lane = tid & 63, w = __builtin_amdgcn_readfirstlane(tid >> 6), r = lane & 15, q = lane >> 4;
    const int bh = u >> 5, j = u & 31, b = bh >> 3, h = bh & 7;
    const size_t row0 = (size_t)b * SEQ + (size_t)j * 512;
    f32x4 Sacc[8];
    float* ust = UST + (size_t)u * 16384 + (size_t)w * 2048 + lane;
#pragma unroll
    for (int kt = 0; kt < 8; ++kt)
#pragma unroll
        for (int rg = 0; rg < 4; ++rg) Sacc[kt][rg] = P1 ? 0.f : ust[(kt * 4 + rg) * 64];
    fv2 btot; btot.x = 0.f; btot.y = 0.f;
    unsigned gq[8], gg[8]; v4u rv[2], rgr[2];
#define HG_LOAD_RAW(c) do { const bf16* gp_ = HG + (size_t)h * HGPS + (row0 + (size_t)(c) * 64 + 8 * w) * 128 + 2 * lane; \
        _Pragma("unroll") for (int i = 0; i < 8; ++i) { if (!P1) { gq[i] = __builtin_nontemporal_load((const unsigned*)(gp_ + (size_t)i * 128)); gg[i] = __builtin_nontemporal_load((const unsigned*)(gp_ + (size_t)i * 128 + 8 * HGPS)); } else gg[i] = *(const unsigned*)(gp_ + (size_t)i * 128 + 8 * HGPS); } \
        _Pragma("unroll") for (int i = 0; i < 2; ++i) { const int ci_ = tid + 512 * i; const bf16* vp_ = HG + (size_t)h * HGPS + (row0 + (size_t)(c) * 64 + (ci_ >> 4)) * 128 + (ci_ & 15) * 8; \
            if (!P1) { rv[i] = __builtin_nontemporal_load((const v4u*)(vp_ + 16 * HGPS)); rgr[i] = __builtin_nontemporal_load((const v4u*)(vp_ + 24 * HGPS)); } else rv[i] = *(const v4u*)(vp_ + 16 * HGPS); } } while (0)
    HG_LOAD_RAW(0);
#pragma unroll 1
    for (int c = 0; c < 8; ++c) {
        const size_t rowc = row0 + (size_t)c * 64;
#pragma unroll
        for (int i = 0; i < 2; ++i) { const int ci = tid + 512 * i; *(LAS v4u*)(lds + L_V + (ci >> 4) * RS + (ci & 15) * 16) = rv[i]; }
        float c0[8], c1[8]; { float r0 = 0.f, r1 = 0.f;
#pragma unroll
            for (int i = 0; i < 8; ++i) { r0 += blo(gg[i]); r1 += bhi(gg[i]); c0[i] = r0; c1[i] = r1; }
            fv2 sv; sv.x = r0; sv.y = r1; *(LAS fv2*)(lds + L_SEG + (w * 128 + 2 * lane) * 4) = sv; }
        v4u grk[2];
        if (!P1) { grk[0] = rgr[0]; grk[1] = rgr[1]; }
        __syncthreads();
        float off0 = 0.f, off1 = 0.f, ref0 = 0.f, ref1 = 0.f, tot0 = 0.f, tot1 = 0.f;
#pragma unroll
        for (int s = 0; s < 8; ++s) { const fv2 sv = *(const LAS fv2*)(lds + L_SEG + (s * 128 + 2 * lane) * 4);
            if (s < w) { off0 += sv.x; off1 += sv.y; } if (s < 4) { ref0 += sv.x; ref1 += sv.y; } tot0 += sv.x; tot1 += sv.y; }
        if (w == 0) { fv2 dv; dv.x = fexp2(tot0); dv.y = fexp2(tot1); *(LAS fv2*)(lds + L_D + 2 * lane * 4) = dv; btot.x += tot0; btot.y += tot1; }
#pragma unroll
        for (int i = 0; i < 8; ++i) {
            const int t = 8 * w + i; const float b0 = off0 + c0[i], b1 = off1 + c1[i];
            const float k0 = 1.f - fexp2(blo(gg[i])), k1 = 1.f - fexp2(bhi(gg[i]));
            *(LAS unsigned*)(lds + L_KL + t * RS + 4 * lane) = cvtpk(k0 * fexp2(tot0 - b0), k1 * fexp2(tot1 - b1));
            if (!P1) { const float q0 = blo(gq[i]), q1 = bhi(gq[i]);
                *(LAS unsigned*)(lds + L_QI + t * RS + 4 * lane) = cvtpk(q0 * fexp2(b0), q1 * fexp2(b1));
                *(LAS unsigned*)(lds + L_QR + t * RS + 4 * lane) = cvtpk(q0 * fexp2(b0 - ref0), q1 * fexp2(b1 - ref1));
                *(LAS unsigned*)(lds + L_KR + t * RS + 4 * lane) = cvtpk(k0 * fexp2(ref0 - b0), k1 * fexp2(ref1 - b1)); }
        }
        __syncthreads();
        if (c + 1 < 8) HG_LOAD_RAW(c + 1);
        bf16x8 Vf[2];
#pragma unroll
        for (int cp = 0; cp < 2; ++cp) { LAS unsigned char* p0 = lds + L_V + (32 * cp + 4 * q + (r >> 2)) * RS + (16 * w + 4 * (r & 3)) * 2; Vf[cp] = frag_tr2(p0, p0 + 16 * RS); }
        f32x4 Oacc[4];
        if (!P1) {
#pragma unroll
            for (int ti = 0; ti < 4; ++ti) Oacc[ti] = (f32x4){0.f, 0.f, 0.f, 0.f};
#pragma unroll
            for (int cc = 0; cc < 4; ++cc) { const bf16x8 Sf = frag_from2(Sacc[2 * cc], Sacc[2 * cc + 1]);
#pragma unroll
                for (int ti = 0; ti < 4; ++ti) { LAS unsigned char* p = lds + L_QI + (16 * ti + r) * RS + 64 * cc + 8 * q; Oacc[ti] = HG_MFMA(frag_2x8(p, p + 32), Sf, Oacc[ti]); } }
#pragma unroll
            for (int ti = 0; ti < 4; ++ti) {
                f32x4 AT[4];
#pragma unroll
                for (int si = 0; si < 4; ++si) { AT[si] = (f32x4){0.f, 0.f, 0.f, 0.f};
                    if (si <= ti) {
#pragma unroll
                        for (int cc = 0; cc < 4; ++cc) { const bf16x8 A = *(const LAS bf16x8*)(lds + L_KR + (16 * si + r) * RS + 64 * cc + 16 * q); const bf16x8 B = *(const LAS bf16x8*)(lds + L_QR + (16 * ti + r) * RS + 64 * cc + 16 * q);
                            AT[si] = HG_MFMA(A, B, AT[si]); }
                        if (si == ti) {
#pragma unroll
                            for (int rg = 0; rg < 4; ++rg) if (4 * q + rg > r) AT[si][rg] = 0.f; }
                    } }
#pragma unroll
                for (int cp = 0; cp < 2; ++cp) if (cp <= (ti >> 1)) Oacc[ti] = HG_MFMA(frag_from2(AT[2 * cp], AT[2 * cp + 1]), Vf[cp], Oacc[ti]);
            }
        }
#pragma unroll
        for (int kt = 0; kt < 8; ++kt) { const f32x4 dv = *(const LAS f32x4*)(lds + L_D + (16 * kt + 4 * q) * 4); Sacc[kt] = Sacc[kt] * dv;
#pragma unroll
            for (int cp = 0; cp < 2; ++cp) { LAS unsigned char* p0 = lds + L_KL + (32 * cp + 4 * q + (r >> 2)) * RS + (16 * kt + 4 * (r & 3)) * 2; Sacc[kt] = HG_MFMA(frag_tr2(p0, p0 + 16 * RS), Vf[cp], Sacc[kt]); } }
        if (P1) { __syncthreads(); }
        else {
#pragma unroll
            for (int ti = 0; ti < 4; ++ti)
#pragma unroll
                for (int rg = 0; rg < 4; ++rg) { float s = Oacc[ti][rg] * Oacc[ti][rg];
                    s = row_sum16(s);
                    if (r == 0) *(LAS float*)(lds + L_RED + ((16 * ti + 4 * q + rg) * 8 + w) * 4) = s; }
            __syncthreads();
            if (tid < 64) { const f32x4 a = *(const LAS f32x4*)(lds + L_RED + tid * 32), bq = *(const LAS f32x4*)(lds + L_RED + tid * 32 + 16);
                *(LAS float*)(lds + L_RSTD + tid * 4) = rsqrtf((((a[0] + a[1]) + (a[2] + a[3])) + ((bq[0] + bq[1]) + (bq[2] + bq[3]))) * (1.f / 128.f) + EPS); }
            __syncthreads();
            { const float gv = ghg[16 * w + r];
#pragma unroll
                for (int ti = 0; ti < 4; ++ti) { const f32x4 rs = *(const LAS f32x4*)(lds + L_RSTD + (16 * ti + 4 * q) * 4);
#pragma unroll
                    for (int rg = 0; rg < 4; ++rg) *(LAS bf16*)(lds + L_QI + (16 * ti + 4 * q + rg) * RS + (16 * w + r) * 2) = (bf16)(cvtpk(Oacc[ti][rg] * rs[rg] * gv, 0.f) & 0xffffu); } }
            __syncthreads();
#pragma unroll
            for (int i = 0; i < 2; ++i) { const int ci = tid + 512 * i, row = ci >> 4, c16 = ci & 15;
                const v4u ov = *(const LAS v4u*)(lds + L_QI + row * RS + c16 * 16); const v4u gv = grk[i]; v4u o;
                o.x = cvtpk(blo(ov.x) * blo(gv.x), bhi(ov.x) * bhi(gv.x)); o.y = cvtpk(blo(ov.y) * blo(gv.y), bhi(ov.y) * bhi(gv.y));
                o.z = cvtpk(blo(ov.z) * blo(gv.z), bhi(ov.z) * bhi(gv.z)); o.w = cvtpk(blo(ov.w) * blo(gv.w), bhi(ov.w) * bhi(gv.w));
                *(v4u*)(OREC + (rowc + row) * HW + h * 128 + c16 * 8) = o; }
        }
    }
    if (P1) {
#pragma unroll
        for (int kt = 0; kt < 8; ++kt)
#pragma unroll
            for (int rg = 0; rg < 4; ++rg) ust[(kt * 4 + rg) * 64] = Sacc[kt][rg];
        if (w == 0) { fv2 dv; dv.x = fexp2(btot.x); dv.y = fexp2(btot.y); *(fv2*)(DST + (size_t)u * 128 + 2 * lane) = dv; }
    }
    __syncthreads();
#undef HG_LOAD_RAW
}
__device__ __forceinline__ void scan(float* UST, const float* DST, int gtid, int nthr) {
    for (int e = gtid; e < 16 * 16384; e += nthr) {
        const int bh = e >> 14, el = e & 16383, ln = el & 63, rg = (el >> 6) & 3, kt = (el >> 8) & 7, k = 16 * kt + 4 * (ln >> 4) + rg;
        float uu[32], dd[32];
        float* p0 = UST + (size_t)bh * 32 * 16384 + el; const float* d0 = DST + (size_t)bh * 32 * 128 + k;
#pragma unroll
        for (int j = 0; j < 32; ++j) { uu[j] = p0[(size_t)j * 16384]; dd[j] = d0[j * 128]; }
        float T = 0.f;
#pragma unroll
        for (int j = 0; j < 32; ++j) { p0[(size_t)j * 16384] = T; T = dd[j] * T + uu[j]; }
    }
}
}

namespace at {
typedef short bf16x8 __attribute__((ext_vector_type(8)));
constexpr int RSK = 144;
constexpr int L_K = 0, L_V = 272 * RSK, L_B = 2 * 272 * RSK, L_O = L_B + 4096, OW = 16 * RSK, L_END = L_O + 8 * OW;
__device__ __forceinline__ void item(LAS unsigned char* lds, bf16* QB, const bf16* KVB, const float* sinks, const float* rel, const int it, const int tid) {
    const int lane = tid & 63, w = __builtin_amdgcn_readfirstlane(tid >> 6), r = lane & 15, q = lane >> 4;
    const int kvh = it & 1, blk = (it >> 1) & 127, b = it >> 8, head = kvh * 8 + w;
    const size_t tok0 = (size_t)b * SEQ + (size_t)blk * 128;
    __syncthreads();
#pragma unroll
    for (int i = 0; i < 4; ++i) { const int ci = tid + 512 * i, row = ci >> 3, c8 = ci & 7; v4u kk = (v4u){0u, 0u, 0u, 0u}, vv = (v4u){0u, 0u, 0u, 0u};
        if (blk > 0 || row >= 128) { const bf16* p = KVB + (tok0 - 128 + row) * 256 + kvh * 64 + c8 * 8; kk = *(const v4u*)p; vv = *(const v4u*)(p + 128); }
        *(LAS v4u*)(lds + L_K + row * RSK + c8 * 16) = kk; *(LAS v4u*)(lds + L_V + row * RSK + c8 * 16) = vv; }
    if (tid < 128) *(LAS v4u*)(lds + L_V + (256 + (tid >> 3)) * RSK + (tid & 7) * 16) = (v4u){0u, 0u, 0u, 0u};
#pragma unroll
    for (int i = 0; i < 2; ++i) { const int e = tid + 512 * i, g = e >> 7, d = e & 127; int bk;
        if (d < 16) bk = d; else { bk = 16 + (int)(__logf((float)d * (1.f / 16.f)) / 2.0794415416798357f * 16.f); if (bk > 31) bk = 31; }
        *(LAS float*)(lds + L_B + e * 4) = rel[bk * 16 + kvh * 8 + g] * LOG2E; }
    __syncthreads();
    float bv[9][4];
#pragma unroll
    for (int kt = 0; kt < 9; ++kt)
#pragma unroll
        for (int rg = 0; rg < 4; ++rg) { const int dist = 128 - 16 * kt + r - 4 * q - rg; const bool ok = dist >= 0 && dist < 128;
            const float bb = *(const LAS float*)(lds + L_B + (w * 128 + (ok ? dist : 0)) * 4); bv[kt][rg] = ok ? bb : -1e30f; }
    const float sink = sinks[head] * LOG2E;
    bf16x8 Qn0, Qn1; { const bf16* qrow = QB + (tok0 + r) * QW + head * 64 + 8 * q; Qn0 = *(const bf16x8*)qrow; Qn1 = *(const bf16x8*)(qrow + 32); }
#pragma unroll 1
    for (int qt = 0; qt < 8; ++qt) {
        const bf16x8 Qf0 = Qn0, Qf1 = Qn1;
        if (qt + 1 < 8) { const bf16* qrow = QB + (tok0 + 16 * (qt + 1) + r) * QW + head * 64 + 8 * q; Qn0 = *(const bf16x8*)qrow; Qn1 = *(const bf16x8*)(qrow + 32); }
        f32x4 ST[9];
#pragma unroll
        for (int kt = 0; kt < 9; ++kt) {
            if (blk == 0 && qt + kt < 8) { ST[kt] = (f32x4){-1e30f, -1e30f, -1e30f, -1e30f}; }
            else { LAS unsigned char* kp = lds + L_K + (16 * (qt + kt) + r) * RSK + 16 * q; f32x4 a = (f32x4){0.f, 0.f, 0.f, 0.f};
                a = __builtin_amdgcn_mfma_f32_16x16x32_bf16(*(const LAS bf16x8*)kp, Qf0, a, 0, 0, 0); a = __builtin_amdgcn_mfma_f32_16x16x32_bf16(*(const LAS bf16x8*)(kp + 64), Qf1, a, 0, 0, 0);
#pragma unroll
                for (int rg = 0; rg < 4; ++rg) ST[kt][rg] = a[rg] + bv[kt][rg]; } }
        float m = sink;
#pragma unroll
        for (int kt = 0; kt < 9; ++kt)
#pragma unroll
            for (int rg = 0; rg < 4; ++rg) m = fmaxf(m, ST[kt][rg]);
        m = fmaxf(m, __shfl_xor(m, 16)); m = fmaxf(m, __shfl_xor(m, 32));
        float l = 0.f;
#pragma unroll
        for (int kt = 0; kt < 9; ++kt)
#pragma unroll
            for (int rg = 0; rg < 4; ++rg) { const float p = fexp2(ST[kt][rg] - m); ST[kt][rg] = p; l += p; }
        l += __shfl_xor(l, 16); l += __shfl_xor(l, 32);
        const float inv = 1.f / (l + fexp2(sink - m));
        f32x4 O[4];
#pragma unroll
        for (int dt = 0; dt < 4; ++dt) O[dt] = (f32x4){0.f, 0.f, 0.f, 0.f};
#pragma unroll
        for (int cp = 0; cp < 5; ++cp) {
            const f32x4 pa = ST[2 * cp] * inv, pb = (2 * cp + 1 < 9) ? ST[(2 * cp + 1 < 9) ? 2 * cp + 1 : 8] * inv : (f32x4){0.f, 0.f, 0.f, 0.f};
            const bf16x8 P = hg::frag_from2(pa, pb);
#pragma unroll
            for (int dt = 0; dt < 4; ++dt) { LAS unsigned char* p0 = lds + L_V + (16 * (qt + 2 * cp) + 4 * q + (r >> 2)) * RSK + (16 * dt + 4 * (r & 3)) * 2;
                O[dt] = __builtin_amdgcn_mfma_f32_16x16x32_bf16(P, hg::frag_tr2(p0, p0 + 16 * RSK), O[dt], 0, 0, 0); } }
        LAS unsigned char* ow = lds + L_O + w * OW;
#pragma unroll
        for (int dt = 0; dt < 4; ++dt)
#pragma unroll
            for (int rg = 0; rg < 4; ++rg) *(LAS bf16*)(ow + (4 * q + rg) * RSK + (16 * dt + r) * 2) = (bf16)(hg::cvtpk(O[dt][rg], 0.f) & 0xffffu);
#pragma unroll
        for (int i = 0; i < 2; ++i) { const int ci = lane + 64 * i, row = ci >> 3, c8 = ci & 7;
            const v4u v = *(const LAS v4u*)(ow + row * RSK + c8 * 16); *(v4u*)(QB + (tok0 + 16 * qt + row) * QW + head * 64 + c8 * 8) = v; }
    }
}
}

namespace rt {
typedef short bf16x8 __attribute__((ext_vector_type(8)));
__device__ __forceinline__ void prep_w(const float* wco, const float* wfi, const float* gf, bf16* WRH, bf16* WRL, int gtid, int nthr) {
    for (int e = gtid; e < 80 * D; e += nthr) { const int n = e >> 11, k = e & 2047;
        const float w = (n < 8) ? wco[k * 8 + n] : (n < 72 ? wfi[k * 64 + (n - 8)] : 0.f); const float v = w * gf[k];
        const unsigned h = hg::cvtpk(v, 0.f) & 0xffffu; const float l = v - __uint_as_float(h << 16);
        WRH[e] = (bf16)h; WRL[e] = (bf16)(hg::cvtpk(l, 0.f) & 0xffffu); }
}
constexpr int RSB = 272, BUFB = 2 * 80 * RSB, L_G = 2 * BUFB, L_LW = L_G + 8192, L_HIST = L_LW + 8 * 5120;
__device__ __forceinline__ void pass(LAS unsigned char* lds, const float* x, const bf16* DL, float* RSTD2, const float* gf, const bf16* WRH, const bf16* WRL, const float* bco, const float* bfi,
                                     bf16* XN, float* TW, const int tl, const bool live, const int tid, int& ea_out, int& eb_out) {
    const int lane = tid & 63, w = __builtin_amdgcn_readfirstlane(tid >> 6), r = lane & 15, q = lane >> 4;
    const int tok = live ? tl * 16 + r : r;
    LAS float* lw = (LAS float*)(lds + L_LW + w * 5120);
    v4u st[5];
#define RT_BLOAD(ck_) do { _Pragma("unroll") for (int i = 0; i < 5; ++i) { const int p_ = tid + 512 * i, mat_ = p_ >= 1280, rem_ = p_ - 1280 * mat_, n_ = rem_ >> 4, j_ = rem_ & 15; \
        st[i] = *(const v4u*)((mat_ ? WRL : WRH) + (size_t)n_ * D + (ck_) * 128 + j_ * 8); } } while (0)
#define RT_BSTORE(buf_) do { _Pragma("unroll") for (int i = 0; i < 5; ++i) { const int p_ = tid + 512 * i, mat_ = p_ >= 1280, rem_ = p_ - 1280 * mat_, n_ = rem_ >> 4, j_ = rem_ & 15; \
        *(LAS v4u*)(lds + (buf_) * BUFB + mat_ * 80 * RSB + n_ * RSB + j_ * 16) = st[i]; } } while (0)
    RT_BLOAD(0);
    const float* xr = x + (size_t)tok * D + 8 * q; bf16* xo = XN + (size_t)tok * D + 8 * q;
    const int tl0 = live ? tl : 0, t0 = (tl0 & 15) * 16;
    const unsigned char* dbase = (const unsigned char*)DL + (size_t)(tl0 >> 4) * 8 * 131072 + (((t0 >> 7) * 4 + ((t0 >> 4) & 3)) * 2) * 8192 + (((t0 >> 6) & 1) * 4) * 1024 + (q * 16 + r) * 16;
    f32x4 X[4][2]; v4u Dl[4];
#define RT_XLOAD(ck_) do { _Pragma("unroll") for (int s_ = 0; s_ < 4; ++s_) { const int c_ = 4 * (ck_) + s_; X[s_][0] = __builtin_nontemporal_load((const f32x4*)(xr + 32 * c_)); \
        X[s_][1] = __builtin_nontemporal_load((const f32x4*)(xr + 32 * c_ + 4)); Dl[s_] = __builtin_nontemporal_load((const v4u*)(dbase + (size_t)(c_ >> 3) * 131072 + (c_ & 1) * 8192 + ((c_ >> 1) & 3) * 1024)); } } while (0)
    RT_XLOAD(0);
    RT_BSTORE(0);
    __syncthreads();
    f32x4 acc[5];
#pragma unroll
    for (int nt = 0; nt < 5; ++nt) acc[nt] = (f32x4){0.f, 0.f, 0.f, 0.f};
    float ssq = 0.f;
#pragma unroll 1
    for (int ck = 0; ck < 16; ++ck) {
        f32x4 Xc[4][2]; v4u Dc[4];
#pragma unroll
        for (int s_ = 0; s_ < 4; ++s_) { Xc[s_][0] = X[s_][0]; Xc[s_][1] = X[s_][1]; Dc[s_] = Dl[s_]; }
        if (ck + 1 < 16) { RT_BLOAD(ck + 1); RT_XLOAD(ck + 1); }
        LAS unsigned char* bb = lds + (ck & 1) * BUFB + r * RSB + 16 * q;
#pragma unroll
        for (int s_ = 0; s_ < 4; ++s_) {
            const int c = 4 * ck + s_;
            f32x4 x0 = Xc[s_][0], x1 = Xc[s_][1]; { f32x4 d0, d1; pg8::unpack8(Dc[s_], d0, d1); x0 += d0; x1 += d1; }
            ssq += ((x0[0] * x0[0] + x0[1] * x0[1]) + (x0[2] * x0[2] + x0[3] * x0[3])) + ((x1[0] * x1[0] + x1[1] * x1[1]) + (x1[2] * x1[2] + x1[3] * x1[3]));
            v4u hi; hi.x = hg::cvtpk(x0[0], x0[1]); hi.y = hg::cvtpk(x0[2], x0[3]); hi.z = hg::cvtpk(x1[0], x1[1]); hi.w = hg::cvtpk(x1[2], x1[3]);
            if (live) *(v4u*)(xo + 32 * c) = hi;
            v4u lo; lo.x = hg::cvtpk(x0[0] - hg::blo(hi.x), x0[1] - hg::bhi(hi.x)); lo.y = hg::cvtpk(x0[2] - hg::blo(hi.y), x0[3] - hg::bhi(hi.y));
            lo.z = hg::cvtpk(x1[0] - hg::blo(hi.z), x1[1] - hg::bhi(hi.z)); lo.w = hg::cvtpk(x1[2] - hg::blo(hi.w), x1[3] - hg::bhi(hi.w));
            const bf16x8 Ah = __builtin_bit_cast(bf16x8, hi), Al = __builtin_bit_cast(bf16x8, lo);
#pragma unroll
            for (int nt = 0; nt < 5; ++nt) { const bf16x8 Bh = *(const LAS bf16x8*)(bb + nt * 16 * RSB + 64 * s_), Bl = *(const LAS bf16x8*)(bb + 80 * RSB + nt * 16 * RSB + 64 * s_);
                acc[nt] = __builtin_amdgcn_mfma_f32_16x16x32_bf16(Ah, Bh, acc[nt], 0, 0, 0); acc[nt] = __builtin_amdgcn_mfma_f32_16x16x32_bf16(Ah, Bl, acc[nt], 0, 0, 0);
                acc[nt] = __builtin_amdgcn_mfma_f32_16x16x32_bf16(Al, Bh, acc[nt], 0, 0, 0); }
        }
        if (ck + 1 < 16) RT_BSTORE((ck + 1) & 1);
        __syncthreads();
    }
#undef RT_BLOAD
#undef RT_BSTORE
#undef RT_XLOAD
    ssq += __shfl_xor(ssq, 16); ssq += __shfl_xor(ssq, 32);
    const float rstd = rsqrtf(ssq * (1.f / D) + EPS);
    if (live && q == 0) RSTD2[tok] = rstd;
#pragma unroll
    for (int nt = 0; nt < 5; ++nt)
#pragma unroll
        for (int rg = 0; rg < 4; ++rg) lw[(4 * q + rg) * 80 + 16 * nt + r] = acc[nt][rg];
    asm volatile("s_waitcnt lgkmcnt(0)" ::: "memory");
    if (live && lane < 16) {
        const LAS float* L = lw + lane * 80;
        float cm = L[0] * rstd + bco[0]; int grp = 0; float cv[8]; cv[0] = cm;
#pragma unroll
        for (int j = 1; j < 8; ++j) { cv[j] = L[j] * rstd + bco[j]; if (cv[j] > cm) { cm = cv[j]; grp = j; } }
        float den = 0.f;
#pragma unroll
        for (int j = 0; j < 8; ++j) den += fexp(cv[j] - cm);
        const float psel = 1.f / den;
        float f[8];
#pragma unroll
        for (int j = 0; j < 8; ++j) f[j] = L[8 + grp * 8 + j] * rstd + bfi[grp * 8 + j];
        int i0 = 0; float f0 = f[0];
#pragma unroll
        for (int j = 1; j < 8; ++j) if (f[j] > f0) { f0 = f[j]; i0 = j; }
        int i1 = -1; float f1 = 0.f;
#pragma unroll
        for (int j = 0; j < 8; ++j) if (j != i0 && (i1 < 0 || f[j] > f1)) { f1 = f[j]; i1 = j; }
        const float e1 = fexp(f1 - f0), w0 = psel / (1.f + e1), w1 = psel * e1 / (1.f + e1);
        ea_out = grp * 8 + i0; eb_out = grp * 8 + i1;
        TW[tok * 2] = w0; TW[tok * 2 + 1] = w1;
    }
}
}

constexpr int LDS_BYTES = 155648;
constexpr int LDS_MISC = 152576;

__global__ void __launch_bounds__(NTHR, 2) fwd_kernel(Args args) {
    extern __shared__ __attribute__((aligned(16))) unsigned char lds_raw[];
    LAS unsigned char* lds = (LAS unsigned char*)lds_raw;
    LAS float* ldsf = (LAS float*)lds;
    volatile LAS unsigned* MISC = (volatile LAS unsigned*)(lds + LDS_MISC);
    int tid = threadIdx.x; asm volatile("" : "+v"(tid));
    int lane = tid & 63, wave = __builtin_amdgcn_readfirstlane(tid >> 6);
#define GRID_SYNC() do { xcd_barrier(bar, tid); asm volatile("" : "+v"(tid)); lane = tid & 63; wave = __builtin_amdgcn_readfirstlane(tid >> 6); gw = bx * NWAVES + wave; } while (0)
    const int G = gridDim.x, bx = blockIdx.x;
    int gw = bx * NWAVES + wave; const int NGW = G * NWAVES;
    unsigned char* ws = args.ws;
    unsigned* ctl = (unsigned*)(ws + WS_CTL);
    if (tid < 64) MISC[tid] = 0u;
    __syncthreads();
    XcdBarrier bar = xcd_barrier_post(ctl + CW_BAR, MISC + 8, tid);

    const float* x = args.in[I_X];
    float* hbuf = args.out;
    float* LB = (float*)(ws + WS_SMALL);
    float* TW = (float*)(ws + WS_SMALL + 65536);
    unsigned short* LIST = (unsigned short*)(ws + WS_LIST);
    bf16* W_IN_T = (bf16*)(ws + WS_WIN); bf16* W_UA_T = (bf16*)(ws + WS_WUA); bf16* W_UR_T = (bf16*)(ws + WS_WUR);
    bf16* W_OUT_T = (bf16*)(ws + WS_WOUT); bf16* W_PG_T = (bf16*)(ws + WS_WPG); bf16* W_PI_T = (bf16*)(ws + WS_WPI);
    bf16* U = (bf16*)(ws + WS_RA); bf16* OREC = (bf16*)(ws + WS_RA); bf16* XN = (bf16*)(ws + WS_RA);
    bf16* QB = (bf16*)(ws + WS_RB); bf16* KVB = (bf16*)(ws + WS_RB + 64 * MiB); bf16* HID = (bf16*)(ws + WS_RB); bf16* PB = (bf16*)(ws + WS_PB);
    bf16* HG = (bf16*)(ws + WS_RC); bf16* MIX = (bf16*)(ws + WS_RC); bf16* Y = (bf16*)(ws + WS_RE);
    bf16* GT = (bf16*)(ws + WS_RD); bf16* W_DN_T = (bf16*)(ws + WS_RD); bf16* PL = (bf16*)(ws + WS_RD + 128 * MiB);
    bf16* W_GU_T = (bf16*)(ws + WS_RE);
    float* RSTDP = (float*)(ws + WS_SMALL + 393216); float* RSTD3 = (float*)(ws + WS_SMALL + 524288); float* RSTD2 = (float*)(ws + WS_SMALL + 655360);
    bf16* DELTA = (bf16*)(ws + WS_RC + 128 * MiB);
    bf16* H3B = (bf16*)(ws + WS_RC);
    bf16* WRH = (bf16*)(ws + 6 * MiB); bf16* WRL = (bf16*)(ws + 6 * MiB + 512 * 1024);
    float* UST = (float*)(ws + WS_RA + 64 * MiB); float* DST = (float*)(ws + WS_RA + 96 * MiB);
    float* SS_H1 = (float*)(ws + WS_SS); float* SS_PL = (float*)(ws + WS_SS + 4 * MiB); float* SS_FIN = (float*)(ws + WS_SS + 8 * MiB);
    unsigned* CNT = ctl + CW_CNT;
    LAS unsigned char* ring = lds;

#ifndef REP_P0
#define REP_P0 1
#endif
#ifndef REP_P1
#define REP_P1 1
#endif
#pragma unroll 1
    for (int rep = 0; rep < REP_P0; ++rep) {
        LAS float* scr = ldsf + wave * 4096;
        transpose_all(args.in[I_WIN], D, INC, W_IN_T, scr, gw, NGW, lane, D);
        transpose_all(args.in[I_WUA], QW, D, W_UA_T, scr, gw, NGW, lane, QW);
        transpose_all(args.in[I_WUR], HW, D, W_UR_T, scr, gw, NGW, lane, HW);
        transpose_all(args.in[I_WOUT], D, D, W_OUT_T, scr, gw, NGW, lane, D);
        transpose_all(args.in[I_WPG], D, D, W_PG_T, scr, gw, NGW, lane, D);
        transpose_all(args.in[I_WPI], PLE, D, W_PI_T, scr, gw, NGW, lane, PLE);
        for (int it = gw; it < (NEXP - 16) * 1024; it += NGW) { const int e = it >> 10, r = it & 1023, mat = r >> 9, item = r & 511;
            transpose_item(args.in[mat ? I_WU : I_WG] + (size_t)e * D * MH, D, MH, W_GU_T + (size_t)e * 1024 * D, scr, item, lane, 1 + mat, D, args.in[I_GFFN]); }
        for (int m = gw; m < NTOK; m += NGW) { const f32x4 pv = __builtin_nontemporal_load((const f32x4*)(args.in[I_P] + (size_t)m * PLE) + lane);
            v2u w; w.x = pk2(pv.x, pv.y); w.y = pk2(pv.z, pv.w); *((v2u*)(PB + (size_t)m * PLE) + lane) = w; }
        const float* gm = args.in[I_GMIX];
        for (int m = gw; m < NTOK; m += NGW) {
            const f32x4* xr = (const f32x4*)(x + (size_t)m * D) + lane;
            f32x4 v[8]; float s = 0.f;
#pragma unroll
            for (int j = 0; j < 8; ++j) { v[j] = __builtin_nontemporal_load(xr + 64 * j); s += (v[j].x * v[j].x + v[j].y * v[j].y) + (v[j].z * v[j].z + v[j].w * v[j].w); }
            const float rstd = rsqrtf(wave_sum(s) * (1.f / D) + EPS);
            v2u* o = (v2u*)(U + (size_t)m * D) + lane;
#pragma unroll
            for (int j = 0; j < 8; ++j) { const f32x4 g = *((const f32x4*)gm + 64 * j + lane); v2u w; w.x = pk2(v[j].x * rstd * g.x, v[j].y * rstd * g.y); w.y = pk2(v[j].z * rstd * g.z, v[j].w * rstd * g.w); o[64 * j] = w; }
        }
        rt::prep_w(args.in[I_WCO], args.in[I_WFI], args.in[I_GFFN], WRH, WRL, bx * NTHR + tid, G * NTHR);
        const float* lbl = args.in[I_LBL];
        for (int j = bx * NTHR + tid; j < HW; j += G * NTHR) LB[j] = 1.f / (1.f + __expf(lbl[HW + j] - lbl[j]));
    }
    GRID_SYNC();

#pragma unroll 1
    for (int rep = 0; rep < REP_P1; ++rep) {
        pg8::StaticOrder S; S.init(U, W_IN_T, NTOK, INC, D, D, G, bx);
        pg8::EpiZ E{args.in[I_BQKV], LB, QB, KVB, HG, GT};
        pg8::gemm_phase<pg8::EpiZ, pg8::StaticOrder, true, false>(ring, D, D, D, S, E, tid);
        const int nshort = G - (S.nwg % G);
        if (S.nwg % G != 0 && bx >= S.nwg % G) { LAS float* scr = ldsf + wave * 4096; const int sw = (bx - S.nwg % G) * NWAVES + wave, nsw = nshort * NWAVES;
            for (int it = sw; it < 16 * 1024; it += nsw) { const int e = (NEXP - 16) + (it >> 10), r = it & 1023, mat = r >> 9, item = r & 511;
                transpose_item(args.in[mat ? I_WU : I_WG] + (size_t)e * D * MH, D, MH, W_GU_T + (size_t)e * 1024 * D, scr, item, lane, 1 + mat, D, args.in[I_GFFN]); } }
        else if (S.nwg % G == 0) { LAS float* scr = ldsf + wave * 4096;
            for (int it = gw; it < 16 * 1024; it += NGW) { const int e = (NEXP - 16) + (it >> 10), r = it & 1023, mat = r >> 9, item = r & 511;
                transpose_item(args.in[mat ? I_WU : I_WG] + (size_t)e * D * MH, D, MH, W_GU_T + (size_t)e * 1024 * D, scr, item, lane, 1 + mat, D, args.in[I_GFFN]); } }
    }
    GRID_SYNC();

    for (int u = bx; u < 512; u += G) hg::unit<true>(lds, HG, OREC, UST, DST, args.in[I_GHGRN], u, tid);
    for (int it = bx; it < 2 * 128 * 2; it += G) at::item(lds, QB, KVB, args.in[I_SINKS], args.in[I_REL], it, tid);
    GRID_SYNC();

    hg::scan(UST, DST, bx * NTHR + tid, G * NTHR);
    GRID_SYNC();
    for (int u = bx; u < 512; u += G) hg::unit<false>(lds, HG, OREC, UST, DST, args.in[I_GHGRN], u, tid);
    GRID_SYNC();

    {
        pg8::PairOrder S; S.s0.init(QB, W_UA_T, NTOK, D, QW, QW, G, bx); S.A1 = (const char*)OREC; S.B1 = (const char*)W_UR_T;
        pg8::EpiMix E{GT, MIX, (unsigned char*)UST + (size_t)bx * 131072};
        pg8::gemm_phase<pg8::EpiMix, pg8::PairOrder, true, false>(ring, QW, QW, QW, S, E, tid);
    }
    GRID_SYNC();

    {
        pg8::StaticOrder S; S.init(MIX, W_OUT_T, NTOK, D, D, D, G, bx);
        pg8::EpiDelta E{DELTA};
        pg8::gemm_phase<pg8::EpiDelta, pg8::StaticOrder, true, false>(ring, D, D, D, S, E, tid);
    }
    GRID_SYNC();

    {
        {
            LAS float* scr = ldsf + wave * 4096;
            for (int it = gw; it < NEXP * 512; it += NGW) { const int e = it >> 9, item = it & 511;
                transpose_item(args.in[I_WD] + (size_t)e * MH * D, MH, D, W_DN_T + (size_t)e * D * MH, scr, item, lane, 0, MH); }
        }
        __syncthreads();
        LAS unsigned* hist = (LAS unsigned*)(lds + rt::L_HIST);
        for (int i = 0; i * NGW < NTOK / 16; ++i) {
            const int tl = gw + i * NGW; const bool live = tl < NTOK / 16;
            __syncthreads();
            if (tid < 64) hist[tid] = 0u;
            int ea = 0, eb = 0; unsigned ra = 0u, rb = 0u;
            rt::pass(lds, x, DELTA, RSTD2, args.in[I_GFFN], WRH, WRL, args.in[I_BCO], args.in[I_BFI], XN, TW, tl, live, tid, ea, eb);
            if (live && lane < 16) { ra = atomicAdd((unsigned*)(hist + ea), 1u); rb = atomicAdd((unsigned*)(hist + eb), 1u); }
            __syncthreads();
            if (tid < 64) { const unsigned c = hist[tid]; hist[64 + tid] = c ? atomicAdd(CNT + 64 * tid, c) : 0u; }
            __syncthreads();
            if (live && lane < 16) { const int m = tl * 16 + lane;
                LIST[(size_t)ea * NTOK + hist[64 + ea] + ra] = (unsigned short)m; LIST[(size_t)eb * NTOK + hist[64 + eb] + rb] = (unsigned short)(m | 0x8000); }
        }
    }
    GRID_SYNC();

    LAS int* eoff = (LAS int*)(lds + 150528);
    LAS int* ecnt = (LAS int*)(lds + 150528 + 512);
    if (tid < 64) {
        const int c = (int)__hip_atomic_load(CNT + 64 * tid, __ATOMIC_RELAXED, __HIP_MEMORY_SCOPE_AGENT); int v = (c + 255) & ~255;
#pragma unroll
        for (int d = 1; d < 64; d <<= 1) { const int t = __shfl_up(v, d); if (lane >= d) v += t; }
        ecnt[tid] = c; eoff[tid] = v - ((c + 255) & ~255); if (tid == 63) eoff[NEXP] = v;
    }
    __syncthreads();
    const int vcu = (G % 8 == 0) ? (bx % 8) * (G / 8) + bx / 8 : bx;
    const int nrb = eoff[NEXP] / 256;
    {
        pg8::MoeOrder S{eoff, ecnt, 4, G, vcu, nrb, (const char*)XN, (const char*)W_GU_T, (size_t)1024 * D * 2, (size_t)256 * D * 2, (size_t)D * 2, LIST, 1};
        pg8::EpiGateUp E{HID, LIST, RSTD2};
        pg8::gemm_phase<pg8::EpiGateUp, pg8::MoeOrder, true, true>(ring, D, D, D, S, E, tid);
    }
    GRID_SYNC();
    {
        pg8::MoeOrder S{eoff, ecnt, 8, G, vcu, nrb, (const char*)HID, (const char*)W_DN_T, (size_t)D * MH * 2, (size_t)256 * MH * 2, (size_t)MH * 2, LIST, 0};
        pg8::EpiDown E{LIST, TW, Y};
        pg8::gemm_phase<pg8::EpiDown, pg8::MoeOrder, true, false>(ring, MH, MH, MH, S, E, tid);
    }
    {
        pg8::StaticOrder S; S.init(PB, W_PI_T, NTOK, D, PLE, PLE, G, bx);
        pg8::EpiPleRaw E{PL, SS_PL};
        pg8::gemm_phase<pg8::EpiPleRaw, pg8::StaticOrder, true, false>(ring, PLE, PLE, PLE, S, E, tid);
    }
    GRID_SYNC();

    {
        for (int m = gw; m < NTOK; m += NGW) {
            const v2u* hb = (const v2u*)(XN + (size_t)m * D) + lane;
            const v2u* y0 = (const v2u*)(Y + (size_t)m * D) + lane; const v2u* y1 = (const v2u*)(Y + (size_t)NTOK * D + (size_t)m * D) + lane;
            v2u* o = (v2u*)(XN + (size_t)m * D) + lane;
            float s = 0.f;
#pragma unroll
            for (int j = 0; j < 8; ++j) { const v2u a = __builtin_nontemporal_load(y0 + 64 * j), c = __builtin_nontemporal_load(y1 + 64 * j), dd = __builtin_nontemporal_load(hb + 64 * j);
                f32x4 v; v.x = __uint_as_float(dd.x << 16); v.y = __uint_as_float(dd.x & 0xffff0000u); v.z = __uint_as_float(dd.y << 16); v.w = __uint_as_float(dd.y & 0xffff0000u);
                v.x += __uint_as_float(a.x << 16) + __uint_as_float(c.x << 16); v.y += __uint_as_float(a.x & 0xffff0000u) + __uint_as_float(c.x & 0xffff0000u);
                v.z += __uint_as_float(a.y << 16) + __uint_as_float(c.y << 16); v.w += __uint_as_float(a.y & 0xffff0000u) + __uint_as_float(c.y & 0xffff0000u);
                s += (v.x * v.x + v.y * v.y) + (v.z * v.z + v.w * v.w);
                v2u w; w.x = hg::cvtpk(v.x, v.y); w.y = hg::cvtpk(v.z, v.w); o[64 * j] = w; }
            const float ssum = wave_sum(s);
            const float sp = wave_sum(lane < 32 ? SS_PL[(size_t)m * 32 + lane] : 0.f);
            if (lane == 0) { RSTD3[m] = rsqrtf(ssum * (1.f / D) + EPS); RSTDP[m] = rsqrtf(sp * (1.f / D) + EPS); }
        }
    }
    GRID_SYNC();

    {
        pg8::StaticOrder S; S.init(XN, W_PG_T, NTOK, D, D, D, G, bx);
        pg8::EpiPleGate E{H3B, PL, RSTD3, RSTDP, args.in[I_GPLE]};
        pg8::gemm_phase<pg8::EpiPleGate, pg8::StaticOrder, true, false>(ring, D, D, D, S, E, tid);
    }
    GRID_SYNC();

    {
        const float* gfin = args.in[I_GFIN];
        f32x4 gv[8];
#pragma unroll
        for (int j = 0; j < 8; ++j) gv[j] = *((const f32x4*)gfin + 64 * j + lane);
        for (int m = gw; m < NTOK; m += 2 * NGW) {
            const int m1 = (m + NGW < NTOK) ? m + NGW : m;
            f32x4* o0 = (f32x4*)(hbuf + (size_t)m * D) + lane; f32x4* o1 = (f32x4*)(hbuf + (size_t)m1 * D) + lane;
            const v2u* u0 = (const v2u*)(H3B + (size_t)m * D) + lane; const v2u* u1 = (const v2u*)(H3B + (size_t)m1 * D) + lane;
            const v2u* h0 = (const v2u*)(XN + (size_t)m * D) + lane; const v2u* h1 = (const v2u*)(XN + (size_t)m1 * D) + lane;
            v2u a0[8], a1[8], b0[8], b1[8];
#pragma unroll
            for (int j = 0; j < 8; ++j) { a0[j] = __builtin_nontemporal_load(u0 + 64 * j); a1[j] = __builtin_nontemporal_load(u1 + 64 * j); b0[j] = __builtin_nontemporal_load(h0 + 64 * j); b1[j] = __builtin_nontemporal_load(h1 + 64 * j); }
            f32x4 y0[8], y1[8]; float s0 = 0.f, s1 = 0.f;
#pragma unroll
            for (int j = 0; j < 8; ++j) {
                y0[j].x = __uint_as_float(a0[j].x << 16) + __uint_as_float(b0[j].x << 16); y0[j].y = __uint_as_float(a0[j].x & 0xffff0000u) + __uint_as_float(b0[j].x & 0xffff0000u);
                y0[j].z = __uint_as_float(a0[j].y << 16) + __uint_as_float(b0[j].y << 16); y0[j].w = __uint_as_float(a0[j].y & 0xffff0000u) + __uint_as_float(b0[j].y & 0xffff0000u);
                y1[j].x = __uint_as_float(a1[j].x << 16) + __uint_as_float(b1[j].x << 16); y1[j].y = __uint_as_float(a1[j].x & 0xffff0000u) + __uint_as_float(b1[j].x & 0xffff0000u);
                y1[j].z = __uint_as_float(a1[j].y << 16) + __uint_as_float(b1[j].y << 16); y1[j].w = __uint_as_float(a1[j].y & 0xffff0000u) + __uint_as_float(b1[j].y & 0xffff0000u);
                s0 += (y0[j].x * y0[j].x + y0[j].y * y0[j].y) + (y0[j].z * y0[j].z + y0[j].w * y0[j].w); s1 += (y1[j].x * y1[j].x + y1[j].y * y1[j].y) + (y1[j].z * y1[j].z + y1[j].w * y1[j].w); }
            const float r0 = rsqrtf(wave_sum(s0) * (1.f / D) + EPS), r1 = rsqrtf(wave_sum(s1) * (1.f / D) + EPS);
#pragma unroll
            for (int j = 0; j < 8; ++j) { __builtin_nontemporal_store(y0[j] * r0 * gv[j], o0 + 64 * j); __builtin_nontemporal_store(y1[j] * r1 * gv[j], o1 + 64 * j); }
        }
    }
}

extern "C" void kernel_launch(void* const* d_in, const int* in_sizes, int n_in, void* d_out, int out_size, void* d_ws, size_t ws_size, hipStream_t stream) {
    static int grid = 0;
    if (grid == 0) {
        if (n_in != 24 || out_size != NTOK * D || ws_size < WS_END) { fprintf(stderr, "kernel_launch: unexpected shapes (n_in %d, out %d, ws %zu)\n", n_in, out_size, ws_size); grid = -1; return; }
        int dev = 0, cus = 0;
        if (hipGetDevice(&dev) != hipSuccess || hipDeviceGetAttribute(&cus, hipDeviceAttributeMultiprocessorCount, dev) != hipSuccess) { grid = -1; return; }
        if (hipFuncSetAttribute((const void*)fwd_kernel, hipFuncAttributeMaxDynamicSharedMemorySize, LDS_BYTES) != hipSuccess) { fprintf(stderr, "kernel_launch: hipFuncSetAttribute failed\n"); grid = -1; return; }
        int per_cu = 0;
        if (hipOccupancyMaxActiveBlocksPerMultiprocessor(&per_cu, (const void*)fwd_kernel, NTHR, LDS_BYTES) != hipSuccess || per_cu < 1) { fprintf(stderr, "kernel_launch: occupancy query says %d\n", per_cu); }
        (void)hipGetLastError();
        grid = cus;
    }
    if (grid < 0) return;
    if (hipMemsetAsync((char*)d_ws + WS_CTL, 0, CTL_ZERO_BYTES, stream) != hipSuccess) return;
    Args a{};
    for (int i = 0; i < 24; ++i) a.in[i] = (const float*)d_in[i];
    a.out = (float*)d_out; a.ws = (unsigned char*)d_ws;
    hipLaunchKernelGGL(fwd_kernel, dim3(grid), dim3(NTHR), LDS_BYTES, stream, a);
}
```

```cpp
#include <hip/hip_runtime.h>
#include <cstdio>
#include <cstdint>

#define GAS __attribute__((address_space(1)))
#define LAS __attribute__((address_space(3)))
typedef unsigned short bf16;
typedef float f32x4 __attribute__((ext_vector_type(4)));
typedef unsigned v4u __attribute__((ext_vector_type(4)));
typedef unsigned v2u __attribute__((ext_vector_type(2)));

constexpr int NTOK = 32768, SEQ = 16384, D = 2048;
constexpr int QW = 1024, KVW = 128, QKVW = 1280, HW = 1024, INC = 9472;
constexpr int NEXP = 64, MH = 512, PLE = 256;
constexpr float EPS = 1e-6f;
constexpr int NWAVES = 8, NTHR = 512;
constexpr size_t HGPS = (size_t)NTOK * 128;
constexpr int HIDCAP = 81920;

constexpr size_t MiB = 1u << 20;
constexpr size_t WS_CTL = 0, CTL_ZERO_BYTES = 1 * MiB;
constexpr size_t WS_SMALL = 1 * MiB;
constexpr size_t WS_LIST = 2 * MiB;
constexpr size_t WS_WIN = 8 * MiB, WS_WUA = 45 * MiB, WS_WUR = 49 * MiB, WS_WOUT = 53 * MiB, WS_WPG = 61 * MiB, WS_WPI = 69 * MiB;
constexpr size_t WS_RA = 70 * MiB;
constexpr size_t WS_RB = 198 * MiB;
constexpr size_t WS_RC = 278 * MiB;
constexpr size_t WS_RD = 534 * MiB;
constexpr size_t WS_RE = 790 * MiB;
constexpr size_t WS_PB = 1046 * MiB;
constexpr size_t WS_SS = 1062 * MiB;
constexpr size_t WS_END = 1074 * MiB;
constexpr int CW_BAR = 4096;
constexpr int CW_CNT = 16384;
constexpr int CW_PACE = 32768;

__device__ __forceinline__ float bf2f(bf16 h) { return __uint_as_float(((unsigned)h) << 16); }
__device__ __forceinline__ unsigned f2bf(float f) { unsigned u = __float_as_uint(f); return (u + 0x7fffu + ((u >> 16) & 1u)) >> 16; }
__device__ __forceinline__ unsigned pk2(float lo, float hi) { return f2bf(lo) | (f2bf(hi) << 16); }
constexpr float LOG2E = 1.4426950408889634f;
__device__ __forceinline__ float fexp2(float x) { return __builtin_amdgcn_exp2f(x); }
__device__ __forceinline__ float fexp(float x) { return __builtin_amdgcn_exp2f(x * LOG2E); }
__device__ __forceinline__ float flog2(float x) { return __builtin_amdgcn_logf(x); }
__device__ __forceinline__ float wave_sum(float v) {
#pragma unroll
    for (int o = 1; o < 64; o <<= 1) v += __shfl_xor(v, o);
    return v;
}

#define XB_TMO      128
#define XB_XCNT(j)  (256  + 64 * (j))
#define XB_XSUB(j)  (1280 + 64 * (j))
#define XB_XGEN(j)  (2304 + 64 * (j))
#define XB_TOP      3328
#define XB_TOPGEN   3392
#define XCD_BAR_WORDS 3456
#define XB_SPIN_CAP (1u << 23)
__device__ __forceinline__ unsigned xb_ld(unsigned* p)              { return __hip_atomic_load(p, __ATOMIC_RELAXED, __HIP_MEMORY_SCOPE_AGENT); }
__device__ __forceinline__ unsigned xb_add(unsigned* p, unsigned v) { return __hip_atomic_fetch_add(p, v, __ATOMIC_RELAXED, __HIP_MEMORY_SCOPE_AGENT); }
__device__ __forceinline__ unsigned xb_xcc_id() { return (unsigned)__builtin_amdgcn_s_getreg((3 << 11) | 20) & 0xFu; }
#define XB_SPIN(cond, bar) do { unsigned _sp = 0; while (cond) { __builtin_amdgcn_s_sleep(1); \
    if ((++_sp & 255u) == 0u) { if (xb_ld(&(bar)[XB_TMO])) break; if (_sp > XB_SPIN_CAP) { atomicAdd(&(bar)[XB_TMO], 1u); break; } } } } while (0)
struct XcdBarrier { unsigned* bar; unsigned x; volatile LAS unsigned* st; };
__device__ __forceinline__ XcdBarrier xcd_barrier_post(unsigned* bar, volatile LAS unsigned* st, const int tid) {
    XcdBarrier b; b.bar = bar; b.x = xb_xcc_id(); b.st = st;
    if (tid == 0) (void)xb_add(&bar[XB_XCNT(b.x)], 1u);
    return b;
}
__device__ __forceinline__ void xcd_barrier_complete(unsigned* bar, unsigned x, unsigned& nloc, unsigned& nx) {
    const unsigned G = gridDim.x * gridDim.y * gridDim.z;
    unsigned sum, cnt, mine, sp = 0u;
    for (;;) {
        sum = 0u; cnt = 0u; mine = 0u;
#pragma unroll
        for (unsigned j = 0; j < 16; ++j) { const unsigned c = xb_ld(&bar[XB_XCNT(j)]); sum += c; cnt += (c > 0u) ? 1u : 0u; mine = (j == x) ? c : mine; }
        if (sum == G) break;
        __builtin_amdgcn_s_sleep(1);
        if ((++sp & 255u) == 0u) { if (xb_ld(&bar[XB_TMO])) break; if (sp > XB_SPIN_CAP) { atomicAdd(&bar[XB_TMO], 1u); break; } }
    }
    nloc = mine > 0u ? mine : 1u; nx = cnt > 0u ? cnt : 1u;
}
__device__ __forceinline__ void xcd_barrier(const XcdBarrier& b, const int tid) {
    asm volatile("s_waitcnt vmcnt(0)" ::: "memory");
    __syncthreads();
    if (tid == 0) {
        unsigned* bar = b.bar;
        __builtin_amdgcn_s_waitcnt(0);
        unsigned nloc = b.st[0], nx = b.st[1];
        if (nloc == 0u) { xcd_barrier_complete(bar, b.x, nloc, nx); b.st[0] = nloc; b.st[1] = nx; }
        const unsigned old = xb_add(&bar[XB_XSUB(b.x)], 1u);
        const unsigned gen = old / nloc;
        if (old + 1u == (gen + 1u) * nloc) {
            __builtin_amdgcn_fence(__ATOMIC_RELEASE, "agent");
            asm volatile("s_waitcnt vmcnt(0)" ::: "memory");
            const unsigned og = xb_add(&bar[XB_TOP], 1u);
            const unsigned tg = og / nx;
            if (og + 1u == (tg + 1u) * nx) xb_add(&bar[XB_TOPGEN], 1u);
            else XB_SPIN(xb_ld(&bar[XB_TOPGEN]) == tg, bar);
            __builtin_amdgcn_fence(__ATOMIC_ACQUIRE, "agent");
            xb_add(&bar[XB_XGEN(b.x)], 1u);
            asm volatile("s_waitcnt vmcnt(0)" ::: "memory");
        } else {
            XB_SPIN(xb_ld(&bar[XB_XGEN(b.x)]) == gen, bar);
            __builtin_amdgcn_fence(__ATOMIC_ACQUIRE, "agent");
            asm volatile("s_waitcnt vmcnt(0)" ::: "memory");
        }
    }
    __syncthreads();
}

struct Args {
    const float* in[24];
    float* out;
    unsigned char* ws;
};
enum { I_X = 0, I_P, I_GMIX, I_WIN, I_BQKV, I_SINKS, I_REL, I_LBL, I_GHGRN, I_WUA, I_WUR, I_WOUT, I_GFFN, I_WCO, I_BCO, I_WFI, I_BFI,
       I_WG, I_WU, I_WD, I_WPI, I_GPLE, I_WPG, I_GFIN };

__device__ __forceinline__ void transpose_item(const float* W, int K, int N, bf16* WT, LAS float* scr, int item, int lane, int gu, int ldw, const float* ks = nullptr) {
    const int nblk = N / 32, kb = item / nblk, nb = item % nblk, k0 = 64 * kb, n0 = 32 * nb;
    const int d0 = gu ? (256 * (n0 >> 7) + 64 * ((n0 & 127) >> 5) + 32 * (gu - 1)) : n0;
#pragma unroll 8
    for (int i = 0; i < 32; ++i) { const int kk = 2 * i + (lane >> 5); scr[kk * 33 + (lane & 31)] = __builtin_nontemporal_load(W + (size_t)(k0 + kk) * N + n0 + (lane & 31)); }
    asm volatile("s_waitcnt lgkmcnt(0)" ::: "memory");
    const int c = lane & 7;
    f32x4 k0s = (f32x4){1.f, 1.f, 1.f, 1.f}, k1s = k0s; if (ks) { k0s = *(const f32x4*)(ks + k0 + 8 * c); k1s = *(const f32x4*)(ks + k0 + 8 * c + 4); }
#pragma unroll
    for (int j = 0; j < 4; ++j) { const int n = (lane >> 3) + 8 * j; const LAS float* s = scr + (8 * c) * 33 + n;
        v4u o; o.x = pk2(s[0 * 33] * k0s[0], s[1 * 33] * k0s[1]); o.y = pk2(s[2 * 33] * k0s[2], s[3 * 33] * k0s[3]); o.z = pk2(s[4 * 33] * k1s[0], s[5 * 33] * k1s[1]); o.w = pk2(s[6 * 33] * k1s[2], s[7 * 33] * k1s[3]);
        *(v4u*)(WT + (size_t)(d0 + n) * ldw + k0 + 8 * c) = o; }
    asm volatile("s_waitcnt lgkmcnt(0)" ::: "memory");
}
__device__ __forceinline__ void transpose_all(const float* W, int K, int N, bf16* WT, LAS float* scr, int gw, int ngw, int lane, int ldw) {
    const int nitems = (K / 64) * (N / 32);
    for (int it = gw; it < nitems; it += ngw) transpose_item(W, K, N, WT, scr, it, lane, 0, ldw);
}

namespace pg8 {
typedef short bf16x8 __attribute__((ext_vector_type(8)));
typedef unsigned u32x4 __attribute__((ext_vector_type(4)));
constexpr int BM = 256, BK = 64, HALF = 128, HTB = HALF * BK * 2, STAGE_BYTES = 8 * HTB, NXCD = 8, WGM = 8;
__host__ __device__ __forceinline__ int lds_byte(int r, int c) { const int st = (r >> 4) * 2 + (c >> 5), rr = r & 15, cc = c & 31, ob = rr * 64 + cc * 2; return st * 1024 + (ob ^ (((ob >> 9) & 1) << 5)); }
__host__ __device__ __forceinline__ void stage_rc(int b, int& R, int& C) { const int st = b / 1024, sb = b % 1024, swz = sb ^ (((sb >> 9) & 1) << 5); R = (st >> 1) * 16 + swz / 64; C = (st & 1) * 32 + (swz % 64) / 2; }
__host__ __device__ __forceinline__ int perm32(int rho) { const int n = rho >> 4, i = rho & 15; return 8 * (i >> 2) + 4 * n + (i & 3); }
struct Unit { int pm, pn; const char* a; const char* b; int e, r0, cnt, row0; };
typedef __bf16 bfv2_t __attribute__((ext_vector_type(2))); typedef float fv2_t __attribute__((ext_vector_type(2)));
__device__ __forceinline__ unsigned cvt_pk_bf16(float lo, float hi) { fv2_t v; v.x = lo; v.y = hi; return __builtin_bit_cast(unsigned, __builtin_convertvector(v, bfv2_t)); }

struct StaticOrder {
    int nM, nN, nwg, G, c, lo, hi; const char* A; const char* Bt; size_t tstepA, tstepB;
    __device__ __forceinline__ void init(const bf16* A_, const bf16* Bt_, int M, int N, int lda, int ldb, int G_, int c_) { nM = M / BM; nN = N / BM; nwg = nM * nN; G = G_; c = c_; lo = 0; hi = nwg; A = (const char*)A_; Bt = (const char*)Bt_; tstepA = (size_t)BM * lda * 2; tstepB = (size_t)BM * ldb * 2; pace = nullptr; }
    __device__ __forceinline__ bool next(int i, Unit& u) const {
        const long L = (long)lo + (long)i * G + c; if (L >= hi) return false;
        int wgid = (int)L; { const int q = nwg / NXCD, r = nwg % NXCD, xcd = wgid % NXCD, off = wgid / NXCD; wgid = (xcd < r ? xcd * (q + 1) : r * (q + 1) + (xcd - r) * q) + off; }
        const int nig = WGM * nN, gid = wgid / nig, fm = gid * WGM, gsz = (nM - fm) < WGM ? (nM - fm) : WGM;
        u.pm = fm + ((wgid % nig) % gsz); u.pn = (wgid % nig) / gsz; u.a = A + (size_t)u.pm * tstepA; u.b = Bt + (size_t)u.pn * tstepB; u.e = 0; u.r0 = 0; u.cnt = 0; u.row0 = 0; return true;
    }
    __device__ __forceinline__ unsigned row_off(const Unit&, int) const { return 0u; }
    unsigned* pace;
    __device__ __forceinline__ void pace_arrive_wait(int ui, int wid, int lane) const {
        if (pace == nullptr || wid != 0) return;
        unsigned* p = pace + 64 * (c & 7);
        if (lane == 0) __hip_atomic_fetch_add(p, 1u, __ATOMIC_RELAXED, __HIP_MEMORY_SCOPE_AGENT);
        const unsigned want = (unsigned)(G >> 3) * (unsigned)(ui + 1);
        for (int sp = 0; sp < 4096; ++sp) { if (__hip_atomic_load(p, __ATOMIC_RELAXED, __HIP_MEMORY_SCOPE_AGENT) >= want) break; __builtin_amdgcn_s_sleep(2); }
    }
    __device__ __forceinline__ void pace_finish(int units_done, int wid, int lane) const {
        if (pace == nullptr || wid != 0 || lane != 0) return;
        const int rmax = (nwg + G - 1) / G;
        if (units_done < rmax) __hip_atomic_fetch_add(pace + 64 * (c & 7), (unsigned)(rmax - units_done), __ATOMIC_RELAXED, __HIP_MEMORY_SCOPE_AGENT);
    }
};

struct PairOrder {
    StaticOrder s0; const char* A1; const char* B1;
    __device__ __forceinline__ bool next(int i, Unit& u) const {
        if (!s0.next(i >> 1, u)) return false;
        if (i & 1) { u.a = A1 + (size_t)u.pm * s0.tstepA; u.b = B1 + (size_t)u.pn * s0.tstepB; u.e = 1; }
        return true;
    }
    __device__ __forceinline__ unsigned row_off(const Unit&, int) const { return 0u; }
    __device__ __forceinline__ void pace_arrive_wait(int, int, int) const {}
    __device__ __forceinline__ void pace_finish(int, int, int) const {}
};

template <class Epi, class Sched, bool ALIGN_EPI, bool GATHER>
__device__ __forceinline__ void gemm_phase(LAS unsigned char* lds, const int K, const int lda, const int ldb, const Sched& S, const Epi& E, const int tid) {
    const int wid = __builtin_amdgcn_readfirstlane(tid >> 6), lane = tid & 63, wr = wid >> 2, wc = wid & 3, fr = lane & 15, fq = lane >> 4;
    const int nt = K / BK;
    int Rr[2], Cc[2];
    unsigned voffA[2][2], voffB[2][2], voffAn[2][2];
#pragma unroll
    for (int i = 0; i < 2; ++i) { stage_rc(tid * 16 + i * 8192, Rr[i], Cc[i]);
#pragma unroll
        for (int h = 0; h < 2; ++h) { const int Rb = Epi::PERM ? (64 * (Rr[i] >> 5) + 32 * h + perm32(Rr[i] & 31)) : h * HALF + Rr[i];
            voffB[h][i] = (unsigned)(Rb * ldb + Cc[i]) * 2u; voffA[h][i] = (unsigned)((h * HALF + Rr[i]) * lda + Cc[i]) * 2u; voffAn[h][i] = voffA[h][i]; } }
    const size_t kstep = (size_t)(BK * 2);
    const unsigned ldsw = (unsigned)wid * 1024u;
    const int aoff = lds_byte(wr * 64 + fr, fq * 8), boff = lds_byte(wc * 32 + fr, fq * 8);
#define PG8_SA(b, h) (((b) * 2 + (h)) * HTB)
#define PG8_SB(b, h) ((4 + (b) * 2 + (h)) * HTB)
#define PG8_STAGE(bufoff, gbase, voff) do { const char* _gb = (const char*)(gbase); asm volatile("" : "+s"(_gb));     \
        _Pragma("unroll") for (int _i = 0; _i < 2; ++_i) \
        __builtin_amdgcn_global_load_lds((const unsigned*)(_gb + (voff)[_i]), (LAS unsigned*)(lds + (bufoff) + ldsw + _i * 8192), 16, 0, 0); } while (0)
#define PG8_LDA(dst, b, h) do { _Pragma("unroll") for (int m = 0; m < 4; ++m) _Pragma("unroll") for (int k = 0; k < 2; ++k) dst[m][k] = *(const LAS bf16x8*)(lds + PG8_SA(b, h) + aoff + m * 2048 + k * 1024); } while (0)
#define PG8_LDB(dst, b, h) do { _Pragma("unroll") for (int n = 0; n < 2; ++n) _Pragma("unroll") for (int k = 0; k < 2; ++k) dst[n][k] = *(const LAS bf16x8*)(lds + PG8_SB(b, h) + boff + n * 2048 + k * 1024); } while (0)
#define PG8_MMA(ai, bj, At, Bt) do { __builtin_amdgcn_s_setprio(1); _Pragma("unroll") for (int m = 0; m < 4; ++m) _Pragma("unroll") for (int n = 0; n < 2; ++n) _Pragma("unroll") for (int k = 0; k < 2; ++k) \
        acc[ai][bj][m][n] = __builtin_amdgcn_mfma_f32_16x16x32_bf16(Bt[n][k], At[m][k], acc[ai][bj][m][n], 0, 0, 0); __builtin_amdgcn_s_setprio(0); } while (0)
#define PG8_WAIT_V(n) asm volatile("s_waitcnt vmcnt(" #n ")" ::: "memory")
#define PG8_WAIT_L(n) asm volatile("s_waitcnt lgkmcnt(" #n ")" ::: "memory")
#define PG8_BAR __builtin_amdgcn_s_barrier()
#define PG8_SCHED __builtin_amdgcn_sched_barrier(0)
    Unit cur, nxt; int ui = 0;
    if (!S.next(0, cur)) return;
    if constexpr (GATHER) {
#pragma unroll
        for (int h = 0; h < 2; ++h)
#pragma unroll
            for (int i = 0; i < 2; ++i) voffA[h][i] = S.row_off(cur, h * HALF + Rr[i]) + (unsigned)Cc[i] * 2u;
    }
    f32x4 acc[2][2][4][2];
#pragma unroll
    for (int a = 0; a < 2; ++a)
#pragma unroll
        for (int b = 0; b < 2; ++b)
#pragma unroll
            for (int m = 0; m < 4; ++m)
#pragma unroll
                for (int n = 0; n < 2; ++n) acc[a][b][m][n] = (f32x4){0.f, 0.f, 0.f, 0.f};
    bf16x8 At[4][2], B0[2][2], B1[2][2];
    const char* cA = cur.a; const char* cB = cur.b;
    PG8_STAGE(PG8_SB(0, 0), cB, voffB[0]); PG8_STAGE(PG8_SB(0, 1), cB, voffB[1]); PG8_STAGE(PG8_SA(0, 0), cA, voffA[0]); PG8_STAGE(PG8_SA(0, 1), cA, voffA[1]);
    if (wr == 1) PG8_BAR;
    PG8_WAIT_V(2); PG8_BAR;
    PG8_STAGE(PG8_SB(1, 0), cB + kstep, voffB[0]); PG8_STAGE(PG8_SA(1, 0), cA + kstep, voffA[0]); PG8_STAGE(PG8_SB(1, 1), cB + kstep, voffB[1]);
    PG8_WAIT_V(6); PG8_BAR;
    for (;;) {
        const bool has_next = S.next(ui + 1, nxt);
        const char* nA = has_next ? nxt.a : cA; const char* nB = has_next ? nxt.b : cB;
        if constexpr (GATHER) {
#pragma unroll
            for (int h = 0; h < 2; ++h)
#pragma unroll
                for (int i = 0; i < 2; ++i) voffAn[h][i] = has_next ? S.row_off(nxt, h * HALF + Rr[i]) + (unsigned)Cc[i] * 2u : voffA[h][i];
        }
        for (int t = 0; t < nt; t += 2) {
            const bool last = (t == nt - 2);
            if (last) S.pace_arrive_wait(ui, wid, lane);
            const char* a1 = cA + (size_t)(t + 1) * kstep;
            const char* a2 = last ? nA : cA + (size_t)(t + 2) * kstep; const char* b2 = last ? nB : cB + (size_t)(t + 2) * kstep;
            const char* a3 = a2 + kstep; const char* b3 = b2 + kstep;
            PG8_LDB(B0, 0, 0); PG8_LDB(B1, 0, 1); PG8_SCHED; PG8_LDA(At, 0, 0); PG8_STAGE(PG8_SA(1, 1), a1, voffA[1]);
            if constexpr (GATHER) { if (last) {
#pragma unroll
                for (int h = 0; h < 2; ++h)
#pragma unroll
                    for (int i = 0; i < 2; ++i) voffA[h][i] = voffAn[h][i]; } }
            PG8_WAIT_V(8); PG8_WAIT_L(0); PG8_BAR; PG8_MMA(0, 0, At, B0); PG8_MMA(0, 1, At, B1); PG8_BAR; PG8_SCHED;
            PG8_LDA(At, 0, 1); PG8_STAGE(PG8_SB(0, 0), b2, voffB[0]); PG8_STAGE(PG8_SB(0, 1), b2, voffB[1]); PG8_STAGE(PG8_SA(0, 0), a2, voffA[0]);
            PG8_WAIT_V(8); PG8_WAIT_L(0); PG8_BAR; PG8_MMA(1, 0, At, B0); PG8_MMA(1, 1, At, B1); PG8_BAR; PG8_SCHED;
            PG8_LDB(B0, 1, 0); PG8_LDB(B1, 1, 1); PG8_SCHED; PG8_LDA(At, 1, 0); PG8_STAGE(PG8_SA(0, 1), a2, voffA[1]);
            PG8_WAIT_V(8); PG8_WAIT_L(0); PG8_BAR; PG8_MMA(0, 0, At, B0); PG8_MMA(0, 1, At, B1); PG8_BAR; PG8_SCHED;
            PG8_LDA(At, 1, 1); PG8_STAGE(PG8_SB(1, 0), b3, voffB[0]); PG8_STAGE(PG8_SB(1, 1), b3, voffB[1]); PG8_STAGE(PG8_SA(1, 0), a3, voffA[0]);
            PG8_WAIT_V(8); PG8_WAIT_L(0); PG8_BAR; PG8_MMA(1, 0, At, B0); PG8_MMA(1, 1, At, B1); PG8_BAR; PG8_SCHED;
        }
        if constexpr (ALIGN_EPI) { if (wr == 0) PG8_BAR; }
        E(acc, cur, wr, wc, fr, fq);
        if (!has_next) { S.pace_finish(ui + 1, wid, lane); break; }
#pragma unroll
        for (int a = 0; a < 2; ++a)
#pragma unroll
            for (int b = 0; b < 2; ++b)
#pragma unroll
                for (int m = 0; m < 4; ++m)
#pragma unroll
                    for (int n = 0; n < 2; ++n) acc[a][b][m][n] = (f32x4){0.f, 0.f, 0.f, 0.f};
        cur = nxt; cA = nA; cB = nB; ++ui;
        if constexpr (ALIGN_EPI) { if (wr == 1) PG8_BAR; }
    }
    PG8_WAIT_V(0);
    if constexpr (!ALIGN_EPI) { if (wr == 0) PG8_BAR; }
    PG8_BAR;
#undef PG8_SA
#undef PG8_SB
#undef PG8_STAGE
#undef PG8_LDA
#undef PG8_LDB
#undef PG8_MMA
#undef PG8_WAIT_V
#undef PG8_WAIT_L
#undef PG8_BAR
#undef PG8_SCHED
}

__device__ __forceinline__ void line_pair(const u32x4 v0, const u32x4 v1, const bool odd, u32x4& a, u32x4& b) {
#pragma unroll
    for (int j = 0; j < 4; ++j) { const unsigned x = odd ? v0[j] : v1[j]; const unsigned y = (unsigned)__builtin_amdgcn_update_dpp(0, (int)x, 0xB1, 0xf, 0xf, false);
        a[j] = odd ? y : v0[j]; b[j] = odd ? v1[j] : y; }
}
__device__ __forceinline__ float fsig(float x) { return __builtin_amdgcn_rcpf(1.f + fexp2(x * -LOG2E)); }
__device__ __forceinline__ u32x4 pack8(const f32x4 a, const f32x4 b) { u32x4 w; w.x = cvt_pk_bf16(a[0], a[1]); w.y = cvt_pk_bf16(a[2], a[3]); w.z = cvt_pk_bf16(b[0], b[1]); w.w = cvt_pk_bf16(b[2], b[3]); return w; }
__device__ __forceinline__ void unpack8(const u32x4 w, f32x4& a, f32x4& b) {
    a[0] = __uint_as_float(w.x << 16); a[1] = __uint_as_float(w.x & 0xffff0000u); a[2] = __uint_as_float(w.y << 16); a[3] = __uint_as_float(w.y & 0xffff0000u);
    b[0] = __uint_as_float(w.z << 16); b[1] = __uint_as_float(w.z & 0xffff0000u); b[2] = __uint_as_float(w.w << 16); b[3] = __uint_as_float(w.w & 0xffff0000u); }

template <int MODE>
__device__ __forceinline__ void epiz_body(const f32x4 (&acc)[2][2][4][2], bf16* base, const int ldc, const int row0, const int oc, const float* vec, const int img_off = 0, const bool odd = false) {
    f32x4 bv[2][2];
#pragma unroll
    for (int bj = 0; bj < 2; ++bj)
#pragma unroll
        for (int n = 0; n < 2; ++n) bv[bj][n] = (MODE == 0 || MODE == 1 || MODE == 3) ? *(const f32x4*)(vec + bj * 32 + 4 * n) : (f32x4){0.f, 0.f, 0.f, 0.f};
#pragma unroll
    for (int ai = 0; ai < 2; ++ai)
#pragma unroll
        for (int m = 0; m < 4; ++m) { bf16* rowp = base + (size_t)(row0 + ai * HALF + m * 16) * ldc + oc; u32x4 pk[2];
#pragma unroll
            for (int bj = 0; bj < 2; ++bj) { f32x4 v[2];
#pragma unroll
                for (int n = 0; n < 2; ++n) { f32x4 x = acc[ai][bj][m][n];
                    if (MODE == 0) x = (x + bv[bj][n]) * (0.125f * LOG2E);
                    else if (MODE == 1) x = x + bv[bj][n];
                    else if (MODE == 2) {
#pragma unroll
                        for (int j = 0; j < 4; ++j) x[j] = x[j] * fsig(x[j]); }
                    else if (MODE == 3) {
#pragma unroll
                        for (int j = 0; j < 4; ++j) { const float l = bv[bj][n][j]; x[j] = flog2(l + (1.f - l) * fsig(x[j])); } }
                    else if (MODE == 6) {
#pragma unroll
                        for (int j = 0; j < 4; ++j) x[j] = fsig(x[j]); }
                    v[n] = x; }
                if (MODE == 6) *(u32x4*)((unsigned char*)base + ((ai * 4 + m) * 2 + bj) * 8192 + img_off) = pack8(v[0], v[1]);
                else pk[bj] = pack8(v[0], v[1]); }
            if (MODE != 6) { u32x4 a, b; line_pair(pk[0], pk[1], odd, a, b); *(u32x4*)rowp = a; *(u32x4*)(rowp + ldc) = b; } }
}
struct EpiZ {
    static constexpr bool PERM = true;
    const float* bqkv; const float* lb; bf16* Q; bf16* KV; bf16* HG; bf16* GT;
    __device__ __forceinline__ void operator()(const f32x4 (&acc)[2][2][4][2], const Unit& u, int wr, int wc, int fr, int fq) const {
        const bool odd = fr & 1; const int row0 = u.pm * BM + wr * 64 + (fr & ~1), cb = u.pn * BM + wc * 64 + 8 * fq, cl = cb + (odd ? 32 : 0);
        if (u.pn < 4) epiz_body<0>(acc, Q, QW, row0, cl, bqkv + cb, 0, odd);
        else if (u.pn == 4) epiz_body<1>(acc, KV, 256, row0, cl - QW, bqkv + cb, 0, odd);
        else if (u.pn < 21) { const int ct = (u.pn - 5) * 256 + (wc >> 1) * 128; bf16* hb = HG + (size_t)((ct >> 10) * 8 + ((ct >> 7) & 7)) * HGPS; const int oc = (wc & 1) * 64 + 8 * fq + (odd ? 32 : 0);
            if (u.pn < 9) epiz_body<2>(acc, hb, 128, row0, oc, nullptr, 0, odd);
            else if (u.pn < 13) epiz_body<3>(acc, hb, 128, row0, oc, lb + ((cb - QKVW) & 1023), 0, odd);
            else if (u.pn < 17) epiz_body<4>(acc, hb, 128, row0, oc, nullptr, 0, odd);
            else epiz_body<2>(acc, hb, 128, row0, oc, nullptr, 0, odd); }
        else epiz_body<6>(acc, GT + (size_t)(u.pm * 16 + (u.pn - 21)) * 65536, 0, 0, 0, nullptr, (wr * 4 + wc) * 1024 + (fq * 16 + fr) * 16);
    }
};
struct EpiMix {
    static constexpr bool PERM = true;
    const bf16* GT; bf16* MIX; unsigned char* PART;
    template <bool SECOND>
    __device__ __forceinline__ void body(const f32x4 (&acc)[2][2][4][2], const int row0, const int cl, const bool odd, const unsigned char* gimg, unsigned char* pimg) const {
#pragma unroll
        for (int ai = 0; ai < 2; ++ai)
#pragma unroll
        for (int mh = 0; mh < 2; ++mh) {
            u32x4 g[2][2], o[2][2];
#pragma unroll
            for (int m2 = 0; m2 < 2; ++m2)
#pragma unroll
                for (int bj = 0; bj < 2; ++bj) {
                    g[m2][bj] = __builtin_nontemporal_load((const u32x4*)(gimg + ((ai * 4 + 2 * mh + m2) * 2 + bj) * 8192));
                    if (SECOND) o[m2][bj] = *(const u32x4*)(pimg + ((ai * 4 + 2 * mh + m2) * 2 + bj) * 8192); }
#pragma unroll
            for (int m2 = 0; m2 < 2; ++m2) { const int m = 2 * mh + m2; u32x4 pk[2];
#pragma unroll
                for (int bj = 0; bj < 2; ++bj) {
                    f32x4 g0, g1; unpack8(g[m2][bj], g0, g1);
                    f32x4 v0 = acc[ai][bj][m][0] * g0, v1 = acc[ai][bj][m][1] * g1;
                    if (SECOND) { f32x4 o0, o1; unpack8(o[m2][bj], o0, o1); v0 += o0; v1 += o1; }
                    if (SECOND) pk[bj] = pack8(v0, v1); else *(u32x4*)(pimg + ((ai * 4 + m) * 2 + bj) * 8192) = pack8(v0, v1); }
                if (SECOND) { u32x4 a, b; line_pair(pk[0], pk[1], odd, a, b); bf16* rp = MIX + (size_t)(row0 + ai * HALF + m * 16) * D + cl; *(u32x4*)rp = a; *(u32x4*)(rp + D) = b; } }
        }
    }
    __device__ __forceinline__ void operator()(const f32x4 (&acc)[2][2][4][2], const Unit& u, int wr, int wc, int fr, int fq) const {
        const bool odd = fr & 1; const int row0 = u.pm * BM + wr * 64 + (fr & ~1), cl = u.pn * BM + wc * 64 + 8 * fq + (odd ? 32 : 0);
        const unsigned char* gimg = (const unsigned char*)GT + (size_t)(u.pm * 16 + (u.e ? 8 : 0) + u.pn) * 131072 + (wr * 4 + wc) * 1024 + (fq * 16 + fr) * 16;
        unsigned char* pimg = PART + (wr * 4 + wc) * 1024 + (fq * 16 + fr) * 16;
        if (u.e) body<true>(acc, row0, cl, odd, gimg, pimg); else body<false>(acc, row0, cl, odd, gimg, pimg);
    }
};
__device__ __forceinline__ void ss_slot(float s, float* SS, int row, int slot, int fq) {
    s += __shfl_xor(s, 16); s += __shfl_xor(s, 32);
    if (fq == 0) SS[(size_t)row * 32 + slot] = s;
}
struct EpiDelta {
    static constexpr bool PERM = true;
    bf16* DL;
    __device__ __forceinline__ void operator()(const f32x4 (&acc)[2][2][4][2], const Unit& u, int wr, int wc, int fr, int fq) const {
        unsigned char* dimg = (unsigned char*)DL + (size_t)(u.pm * 8 + u.pn) * 131072 + (wr * 4 + wc) * 1024 + (fq * 16 + fr) * 16;
#pragma unroll
        for (int ai = 0; ai < 2; ++ai)
#pragma unroll
            for (int m = 0; m < 4; ++m)
#pragma unroll
                for (int bj = 0; bj < 2; ++bj) *(u32x4*)(dimg + ((ai * 4 + m) * 2 + bj) * 8192) = pack8(acc[ai][bj][m][0], acc[ai][bj][m][1]);
    }
};
struct EpiPleRaw {
    static constexpr bool PERM = true;
    bf16* PL; float* SS;
    __device__ __forceinline__ void operator()(const f32x4 (&acc)[2][2][4][2], const Unit& u, int wr, int wc, int fr, int fq) const {
        const int row0 = u.pm * BM + wr * 64 + fr;
        unsigned char* pimg = (unsigned char*)PL + (size_t)(u.pm * 8 + u.pn) * 131072 + (wr * 4 + wc) * 1024 + (fq * 16 + fr) * 16;
#pragma unroll
        for (int ai = 0; ai < 2; ++ai)
#pragma unroll
            for (int m = 0; m < 4; ++m) { const int row = row0 + ai * HALF + m * 16; float s = 0.f;
#pragma unroll
                for (int bj = 0; bj < 2; ++bj) { const f32x4 a = acc[ai][bj][m][0], b = acc[ai][bj][m][1];
                    s += ((a[0] * a[0] + a[1] * a[1]) + (a[2] * a[2] + a[3] * a[3])) + ((b[0] * b[0] + b[1] * b[1]) + (b[2] * b[2] + b[3] * b[3]));
                    *(u32x4*)(pimg + ((ai * 4 + m) * 2 + bj) * 8192) = pack8(a, b); }
                ss_slot(s, SS, row, u.pn * 4 + wc, fq); }
    }
};
struct EpiPleGate {
    static constexpr bool PERM = true;
    bf16* UPD; const bf16* PL; const float* rstd3; const float* rstdp; const float* gple;
    __device__ __forceinline__ void operator()(const f32x4 (&acc)[2][2][4][2], const Unit& u, int wr, int wc, int fr, int fq) const {
        const bool odd = fr & 1; const int row0 = u.pm * BM + wr * 64 + fr, cb = u.pn * BM + wc * 64 + 8 * fq, cl = cb + (odd ? 32 : 0);
        const unsigned char* pimg = (const unsigned char*)PL + (size_t)(u.pm * 8 + u.pn) * 131072 + (wr * 4 + wc) * 1024 + (fq * 16 + fr) * 16;
        f32x4 gp[2][2];
#pragma unroll
        for (int bj = 0; bj < 2; ++bj)
#pragma unroll
            for (int n = 0; n < 2; ++n) gp[bj][n] = *(const f32x4*)(gple + cb + bj * 32 + 4 * n);
#pragma unroll
        for (int ai = 0; ai < 2; ++ai) {
            u32x4 pp[4][2]; float r3[4], rp[4];
#pragma unroll
            for (int m = 0; m < 4; ++m) { const int row = row0 + ai * HALF + m * 16; r3[m] = rstd3[row]; rp[m] = rstdp[row];
#pragma unroll
                for (int bj = 0; bj < 2; ++bj) pp[m][bj] = __builtin_nontemporal_load((const u32x4*)(pimg + ((ai * 4 + m) * 2 + bj) * 8192)); }
#pragma unroll
            for (int m = 0; m < 4; ++m) { const int row = (row0 & ~1) + ai * HALF + m * 16; u32x4 pk[2];
#pragma unroll
                for (int bj = 0; bj < 2; ++bj) {
                    f32x4 p0, p1; unpack8(pp[m][bj], p0, p1);
                    f32x4 g0 = acc[ai][bj][m][0] * r3[m], g1 = acc[ai][bj][m][1] * r3[m];
#pragma unroll
                    for (int j = 0; j < 4; ++j) { g0[j] = fsig(g0[j]); g1[j] = fsig(g1[j]); }
                    pk[bj] = pack8(p0 * rp[m] * gp[bj][0] * g0, p1 * rp[m] * gp[bj][1] * g1); }
                u32x4 a, b; line_pair(pk[0], pk[1], odd, a, b); bf16* up = UPD + (size_t)row * D + cl; *(u32x4*)up = a; *(u32x4*)(up + D) = b; }
        }
    }
};

struct MoeOrder {
    const LAS int* eoff; const LAS int* ecnt; int NT, G, c, total_rb; const char* A; const char* W; size_t wexp, tstepB, arow_bytes; const unsigned short* LIST; int gather;
    __device__ __forceinline__ bool next(int i, Unit& u) const {
        const int it = i * G + c; if (it >= total_rb * NT) return false;
        const int rb = it / NT, pn = it % NT, row0 = rb * BM;
        int e = 0; { int hi = NEXP;
#pragma unroll
            for (int st = 0; st < 6; ++st) { const int mid = (e + hi) >> 1; if (eoff[mid] <= row0) e = mid; else hi = mid; } }
        e = __builtin_amdgcn_readfirstlane(e);
        u.pm = rb; u.pn = pn; u.e = e; u.r0 = __builtin_amdgcn_readfirstlane(row0 - eoff[e]); u.cnt = __builtin_amdgcn_readfirstlane(ecnt[e]); u.row0 = row0;
        u.a = gather ? A : A + (size_t)row0 * arow_bytes; u.b = W + (size_t)e * wexp + (size_t)pn * tstepB; return true;
    }
    __device__ __forceinline__ void pace_arrive_wait(int, int, int) const {}
    __device__ __forceinline__ void pace_finish(int, int, int) const {}
    __device__ __forceinline__ unsigned row_off(const Unit& u, int row) const {
        const unsigned short* lp = LIST + (size_t)u.e * NTOK + u.r0;
        const unsigned tok = (row < u.cnt - u.r0) ? (unsigned)(lp[row] & 0x7fffu) : 0u; return tok * (unsigned)arow_bytes;
    }
};
struct EpiGateUp {
    static constexpr bool PERM = true;
    bf16* HID; const unsigned short* LIST; const float* RSTD2;
    __device__ __forceinline__ void operator()(const f32x4 (&acc)[2][2][4][2], const Unit& u, int wr, int wc, int fr, int fq) const {
        const int row0 = u.row0 + wr * 64 + fr, cb = u.pn * HALF + wc * 32 + 8 * fq;
        const unsigned short* lp = LIST + (size_t)u.e * NTOK + u.r0;
        unsigned tk[2][4]; float rs[2][4];
#pragma unroll
        for (int ai = 0; ai < 2; ++ai)
#pragma unroll
            for (int m = 0; m < 4; ++m) { const int lr = ai * HALF + wr * 64 + m * 16 + fr; tk[ai][m] = (lr < u.cnt - u.r0) ? (unsigned)(lp[lr] & 0x7fffu) : 0u; }
#pragma unroll
        for (int ai = 0; ai < 2; ++ai)
#pragma unroll
            for (int m = 0; m < 4; ++m) rs[ai][m] = RSTD2[tk[ai][m]];
#pragma unroll
        for (int ai = 0; ai < 2; ++ai)
#pragma unroll
            for (int m = 0; m < 4; ++m) { f32x4 v[2];
#pragma unroll
                for (int n = 0; n < 2; ++n) { const f32x4 g = acc[ai][0][m][n] * rs[ai][m], up = acc[ai][1][m][n] * rs[ai][m];
#pragma unroll
                    for (int j = 0; j < 4; ++j) v[n][j] = g[j] * fsig(g[j]) * up[j]; }
                *(u32x4*)(HID + (size_t)(row0 + ai * HALF + m * 16) * MH + cb) = pack8(v[0], v[1]); }
    }
};
struct EpiDown {
    static constexpr bool PERM = true;
    const unsigned short* LIST; const float* TW; bf16* Y;
    __device__ __forceinline__ void operator()(const f32x4 (&acc)[2][2][4][2], const Unit& u, int wr, int wc, int fr, int fq) const {
        const bool odd = fr & 1; const int cl = u.pn * BM + wc * 64 + 8 * fq + (odd ? 32 : 0);
        const unsigned short* lp = LIST + (size_t)u.e * NTOK + u.r0;
        unsigned entE[2][4], entO[2][4]; float w[2][4];
#pragma unroll
        for (int ai = 0; ai < 2; ++ai)
#pragma unroll
            for (int m = 0; m < 4; ++m) { const int lr = ai * HALF + wr * 64 + m * 16 + (fr & ~1), nv = u.cnt - u.r0;
                entE[ai][m] = (lr < nv) ? (unsigned)lp[lr] : 0x10000u; entO[ai][m] = (lr + 1 < nv) ? (unsigned)lp[lr + 1] : 0x10000u; }
#pragma unroll
        for (int ai = 0; ai < 2; ++ai)
#pragma unroll
            for (int m = 0; m < 4; ++m) { const unsigned a = entE[ai][m], b = entO[ai][m], eo = odd ? b : a; w[ai][m] = TW[(eo & 0x7fffu) * 2 + ((eo >> 15) & 1u)]; }
#pragma unroll
        for (int ai = 0; ai < 2; ++ai)
#pragma unroll
            for (int m = 0; m < 4; ++m) { u32x4 a, b;
                line_pair(pack8(acc[ai][0][m][0] * w[ai][m], acc[ai][0][m][1] * w[ai][m]), pack8(acc[ai][1][m][0] * w[ai][m], acc[ai][1][m][1] * w[ai][m]), odd, a, b);
#pragma unroll
                for (int o = 0; o < 2; ++o) { const unsigned e = o ? entO[ai][m] : entE[ai][m]; if (!(e & 0x10000u)) { const unsigned tok = e & 0x7fffu, k = (e >> 15) & 1u;
                    *(u32x4*)(Y + (size_t)k * NTOK * D + (size_t)tok * D + cl) = o ? b : a; } } }
    }
};
}

namespace hg {
typedef short s16x4 __attribute__((ext_vector_type(4)));
typedef short bf16x8 __attribute__((ext_vector_type(8)));
typedef __bf16 bfv2 __attribute__((ext_vector_type(2)));
typedef float fv2 __attribute__((ext_vector_type(2)));
constexpr int RS = 272, IMG = 64 * RS;
constexpr int L_QI = 0, L_QR = IMG, L_KR = 2 * IMG, L_KL = 3 * IMG, L_V = 4 * IMG;
constexpr int L_SEG = 5 * IMG, L_D = L_SEG + 4096, L_RED = L_D + 512, L_RSTD = L_RED + 2048, L_END = L_RSTD + 256;
__device__ __forceinline__ unsigned cvtpk(float lo, float hi) { fv2 v; v.x = lo; v.y = hi; return __builtin_bit_cast(unsigned, __builtin_convertvector(v, bfv2)); }
__device__ __forceinline__ float blo(unsigned u) { return __uint_as_float(u << 16); }
__device__ __forceinline__ float bhi(unsigned u) { return __uint_as_float(u & 0xffff0000u); }
__device__ __forceinline__ bf16x8 frag_from2(const f32x4 a, const f32x4 b) { v4u w; w.x = cvtpk(a[0], a[1]); w.y = cvtpk(a[2], a[3]); w.z = cvtpk(b[0], b[1]); w.w = cvtpk(b[2], b[3]); return __builtin_bit_cast(bf16x8, w); }
__device__ __forceinline__ bf16x8 frag_tr2(LAS unsigned char* p0, LAS unsigned char* p1) {
    const s16x4 lo = __builtin_amdgcn_ds_read_tr16_b64_v4i16((LAS s16x4*)p0), hi = __builtin_amdgcn_ds_read_tr16_b64_v4i16((LAS s16x4*)p1);
    return __builtin_shufflevector(lo, hi, 0, 1, 2, 3, 4, 5, 6, 7); }
__device__ __forceinline__ bf16x8 frag_2x8(LAS unsigned char* p0, LAS unsigned char* p1) { v4u w; const v2u a = *(const LAS v2u*)p0, b = *(const LAS v2u*)p1; w.x = a.x; w.y = a.y; w.z = b.x; w.w = b.y; return __builtin_bit_cast(bf16x8, w); }
__device__ __forceinline__ float row_sum16(float s) {
    s += __int_as_float(__builtin_amdgcn_update_dpp(0, __float_as_int(s), 0x128, 0xf, 0xf, false));
    s += __int_as_float(__builtin_amdgcn_update_dpp(0, __float_as_int(s), 0x124, 0xf, 0xf, false));
    s += __int_as_float(__builtin_amdgcn_update_dpp(0, __float_as_int(s), 0x122, 0xf, 0xf, false));
    s += __int_as_float(__builtin_amdgcn_update_dpp(0, __float_as_int(s), 0x121, 0xf, 0xf, false));
    return s; }
#define HG_MFMA(a, b, c) __builtin_amdgcn_mfma_f32_16x16x32_bf16((a), (b), (c), 0, 0, 0)

template <bool P1>
__device__ __forceinline__ void unit(LAS unsigned char* lds, const bf16* HG, bf16* OREC, float* UST, float* DST, const float* ghg, const int u, const int tid) {
    const int lane = tid & 63, w = __builtin_amdgcn_readfirstlane(tid >> 6), r = lane & 15, q = lane >> 4;
    const int bh = u >> 5, j = u & 31, b = bh >> 3, h = bh & 7;
    const size_t row0 = (size_t)b * SEQ + (size_t)j * 512;
    f32x4 Sacc[8];
    float* ust = UST + (size_t)u * 16384 + (size_t)w * 2048 + lane;
#pragma unroll
    for (int kt = 0; kt < 8; ++kt)
#pragma unroll
        for (int rg = 0; rg < 4; ++rg) Sacc[kt][rg] = P1 ? 0.f : ust[(kt * 4 + rg) * 64];
    fv2 btot; btot.x = 0.f; btot.y = 0.f;
    unsigned gq[8], gg[8]; v4u rv[2], rgr[2];
#define HG_LOAD_RAW(c) do { const bf16* gp_ = HG + (size_t)h * HGPS + (row0 + (size_t)(c) * 64 + 8 * w) * 128 + 2 * lane; \
        _Pragma("unroll") for (int i = 0; i < 8; ++i) { if (!P1) { gq[i] = __builtin_nontemporal_load((const unsigned*)(gp_ + (size_t)i * 128)); gg[i] = __builtin_nontemporal_load((const unsigned*)(gp_ + (size_t)i * 128 + 8 * HGPS)); } else gg[i] = *(const unsigned*)(gp_ + (size_t)i * 128 + 8 * HGPS); } \
        _Pragma("unroll") for (int i = 0; i < 2; ++i) { const int ci_ = tid + 512 * i; const bf16* vp_ = HG + (size_t)h * HGPS + (row0 + (size_t)(c) * 64 + (ci_ >> 4)) * 128 + (ci_ & 15) * 8; \
            if (!P1) { rv[i] = __builtin_nontemporal_load((const v4u*)(vp_ + 16 * HGPS)); rgr[i] = __builtin_nontemporal_load((const v4u*)(vp_ + 24 * HGPS)); } else rv[i] = *(const v4u*)(vp_ + 16 * HGPS); } } while (0)
    HG_LOAD_RAW(0);
#pragma unroll 1
    for (int c = 0; c < 8; ++c) {
        const size_t rowc = row0 + (size_t)c * 64;
#pragma unroll
        for (int i = 0; i < 2; ++i) { const int ci = tid + 512 * i; *(LAS v4u*)(lds + L_V + (ci >> 4) * RS + (ci & 15) * 16) = rv[i]; }
        float c0[8], c1[8]; { float r0 = 0.f, r1 = 0.f;
#pragma unroll
            for (int i = 0; i < 8; ++i) { r0 += blo(gg[i]); r1 += bhi(gg[i]); c0[i] = r0; c1[i] = r1; }
            fv2 sv; sv.x = r0; sv.y = r1; *(LAS fv2*)(lds + L_SEG + (w * 128 + 2 * lane) * 4) = sv; }
        v4u grk[2];
        if (!P1) { grk[0] = rgr[0]; grk[1] = rgr[1]; }
        __syncthreads();
        float off0 = 0.f, off1 = 0.f, ref0 = 0.f, ref1 = 0.f, tot0 = 0.f, tot1 = 0.f;
#pragma unroll
        for (int s = 0; s < 8; ++s) { const fv2 sv = *(const LAS fv2*)(lds + L_SEG + (s * 128 + 2 * lane) * 4);
            if (s < w) { off0 += sv.x; off1 += sv.y; } if (s < 4) { ref0 += sv.x; ref1 += sv.y; } tot0 += sv.x; tot1 += sv.y; }
        if (w == 0) { fv2 dv; dv.x = fexp2(tot0); dv.y = fexp2(tot1); *(LAS fv2*)(lds + L_D + 2 * lane * 4) = dv; btot.x += tot0; btot.y += tot1; }
#pragma unroll
        for (int i = 0; i < 8; ++i) {
            const int t = 8 * w + i; const float b0 = off0 + c0[i], b1 = off1 + c1[i];
            const float k0 = 1.f - fexp2(blo(gg[i])), k1 = 1.f - fexp2(bhi(gg[i]));
            *(LAS unsigned*)(lds + L_KL + t * RS + 4 * lane) = cvtpk(k0 * fexp2(tot0 - b0), k1 * fexp2(tot1 - b1));
            if (!P1) { const float q0 = blo(gq[i]), q1 = bhi(gq[i]);
                *(LAS unsigned*)(lds + L_QI + t * RS + 4 * lane) = cvtpk(q0 * fexp2(b0), q1 * fexp2(b1));
                *(LAS unsigned*)(lds + L_QR + t * RS + 4 * lane) = cvtpk(q0 * fexp2(b0 - ref0), q1 * fexp2(b1 - ref1));
                *(LAS unsigned*)(lds + L_KR + t * RS + 4 * lane) = cvtpk(k0 * fexp2(ref0 - b0), k1 * fexp2(ref1 - b1)); }
        }
        __syncthreads();
        if (c + 1 < 8) HG_LOAD_RAW(c + 1);
        bf16x8 Vf[2];
#pragma unroll
        for (int cp = 0; cp < 2; ++cp) { LAS unsigned char* p0 = lds + L_V + (32 * cp + 4 * q + (r >> 2)) * RS + (16 * w + 4 * (r & 3)) * 2; Vf[cp] = frag_tr2(p0, p0 + 16 * RS); }
        f32x4 Oacc[4];
        if (!P1) {
#pragma unroll
            for (int ti = 0; ti < 4; ++ti) Oacc[ti] = (f32x4){0.f, 0.f, 0.f, 0.f};
#pragma unroll
            for (int cc = 0; cc < 4; ++cc) { const bf16x8 Sf = frag_from2(Sacc[2 * cc], Sacc[2 * cc + 1]);
#pragma unroll
                for (int ti = 0; ti < 4; ++ti) { LAS unsigned char* p = lds + L_QI + (16 * ti + r) * RS + 64 * cc + 8 * q; Oacc[ti] = HG_MFMA(frag_2x8(p, p + 32), Sf, Oacc[ti]); } }
#pragma unroll
            for (int ti = 0; ti < 4; ++ti) {
                f32x4 AT[4];
#pragma unroll
                for (int si = 0; si < 4; ++si) { AT[si] = (f32x4){0.f, 0.f, 0.f, 0.f};
                    if (si <= ti) {
#pragma unroll
                        for (int cc = 0; cc < 4; ++cc) { const bf16x8 A = *(const LAS bf16x8*)(lds + L_KR + (16 * si + r) * RS + 64 * cc + 16 * q); const bf16x8 B = *(const LAS bf16x8*)(lds + L_QR + (16 * ti + r) * RS + 64 * cc + 16 * q);
                            AT[si] = HG_MFMA(A, B, AT[si]); }
                        if (si == ti) {
#pragma unroll
                            for (int rg = 0; rg < 4; ++rg) if (4 * q + rg > r) AT[si][rg] = 0.f; }
                    } }
#pragma unroll
                for (int cp = 0; cp < 2; ++cp) if (cp <= (ti >> 1)) Oacc[ti] = HG_MFMA(frag_from2(AT[2 * cp], AT[2 * cp + 1]), Vf[cp], Oacc[ti]);
            }
        }
#pragma unroll
        for (int kt = 0; kt < 8; ++kt) { const f32x4 dv = *(const LAS f32x4*)(lds + L_D + (16 * kt + 4 * q) * 4); Sacc[kt] = Sacc[kt] * dv;
#pragma unroll
            for (int cp = 0; cp < 2; ++cp) { LAS unsigned char* p0 = lds + L_KL + (32 * cp + 4 * q + (r >> 2)) * RS + (16 * kt + 4 * (r & 3)) * 2; Sacc[kt] = HG_MFMA(frag_tr2(p0, p0 + 16 * RS), Vf[cp], Sacc[kt]); } }
        if (P1) { __syncthreads(); }
        else {
#pragma unroll
            for (int ti = 0; ti < 4; ++ti)
#pragma unroll
                for (int rg = 0; rg < 4; ++rg) { float s = Oacc[ti][rg] * Oacc[ti][rg];
                    s = row_sum16(s);
                    if (r == 0) *(LAS float*)(lds + L_RED + ((16 * ti + 4 * q + rg) * 8 + w) * 4) = s; }
            __syncthreads();
            if (tid < 64) { const f32x4 a = *(const LAS f32x4*)(lds + L_RED + tid * 32), bq = *(const LAS f32x4*)(lds + L_RED + tid * 32 + 16);
                *(LAS float*)(lds + L_RSTD + tid * 4) = rsqrtf((((a[0] + a[1]) + (a[2] + a[3])) + ((bq[0] + bq[1]) + (bq[2] + bq[3]))) * (1.f / 128.f) + EPS); }
            __syncthreads();
            { const float gv = ghg[16 * w + r];
#pragma unroll
                for (int ti = 0; ti < 4; ++ti) { const f32x4 rs = *(const LAS f32x4*)(lds + L_RSTD + (16 * ti + 4 * q) * 4);
#pragma unroll
                    for (int rg = 0; rg < 4; ++rg) *(LAS bf16*)(lds + L_QI + (16 * ti + 4 * q + rg) * RS + (16 * w + r) * 2) = (bf16)(cvtpk(Oacc[ti][rg] * rs[rg] * gv, 0.f) & 0xffffu); } }
            __syncthreads();
#pragma unroll
            for (int i = 0; i < 2; ++i) { const int ci = tid + 512 * i, row = ci >> 4, c16 = ci & 15;
                const v4u ov = *(const LAS v4u*)(lds + L_QI + row * RS + c16 * 16); const v4u gv = grk[i]; v4u o;
                o.x = cvtpk(blo(ov.x) * blo(gv.x), bhi(ov.x) * bhi(gv.x)); o.y = cvtpk(blo(ov.y) * blo(gv.y), bhi(ov.y) * bhi(gv.y));
                o.z = cvtpk(blo(ov.z) * blo(gv.z), bhi(ov.z) * bhi(gv.z)); o.w = cvtpk(blo(ov.w) * blo(gv.w), bhi(ov.w) * bhi(gv.w));
                *(v4u*)(OREC + (rowc + row) * HW + h * 128 + c16 * 8) = o; }
        }
    }
    if (P1) {
#pragma unroll
        for (int kt = 0; kt < 8; ++kt)
#pragma unroll
            for (int rg = 0; rg < 4; ++rg) ust[(kt * 4 + rg) * 64] = Sacc[kt][rg];
        if (w == 0) { fv2 dv; dv.x = fexp2(btot.x); dv.y = fexp2(btot.y); *(fv2*)(DST + (size_t)u * 128 + 2 * lane) = dv; }
    }
    __syncthreads();
#undef HG_LOAD_RAW
}
__device__ __forceinline__ void scan(float* UST, const float* DST, int gtid, int nthr) {
    for (int e = gtid; e < 16 * 16384; e += nthr) {
        const int bh = e >> 14, el = e & 16383, ln = el & 63, rg = (el >> 6) & 3, kt = (el >> 8) & 7, k = 16 * kt + 4 * (ln >> 4) + rg;
        float uu[32], dd[32];
        float* p0 = UST + (size_t)bh * 32 * 16384 + el; const float* d0 = DST + (size_t)bh * 32 * 128 + k;
#pragma unroll
        for (int j = 0; j < 32; ++j) { uu[j] = p0[(size_t)j * 16384]; dd[j] = d0[j * 128]; }
        float T = 0.f;
#pragma unroll
        for (int j = 0; j < 32; ++j) { p0[(size_t)j * 16384] = T; T = dd[j] * T + uu[j]; }
    }
}
}

namespace at {
typedef short bf16x8 __attribute__((ext_vector_type(8)));
constexpr int RSK = 144;
constexpr int L_K = 0, L_V = 272 * RSK, L_B = 2 * 272 * RSK, L_O = L_B + 4096, OW = 16 * RSK, L_END = L_O + 8 * OW;
__device__ __forceinline__ void item(LAS unsigned char* lds, bf16* QB, const bf16* KVB, const float* sinks, const float* rel, const int it, const int tid) {
    const int lane = tid & 63, w = __builtin_amdgcn_readfirstlane(tid >> 6), r = lane & 15, q = lane >> 4;
    const int kvh = it & 1, blk = (it >> 1) & 127, b = it >> 8, head = kvh * 8 + w;
    const size_t tok0 = (size_t)b * SEQ + (size_t)blk * 128;
    __syncthreads();
#pragma unroll
    for (int i = 0; i < 4; ++i) { const int ci = tid + 512 * i, row = ci >> 3, c8 = ci & 7; v4u kk = (v4u){0u, 0u, 0u, 0u}, vv = (v4u){0u, 0u, 0u, 0u};
        if (blk > 0 || row >= 128) { const bf16* p = KVB + (tok0 - 128 + row) * 256 + kvh * 64 + c8 * 8; kk = *(const v4u*)p; vv = *(const v4u*)(p + 128); }
        *(LAS v4u*)(lds + L_K + row * RSK + c8 * 16) = kk; *(LAS v4u*)(lds + L_V + row * RSK + c8 * 16) = vv; }
    if (tid < 128) *(LAS v4u*)(lds + L_V + (256 + (tid >> 3)) * RSK + (tid & 7) * 16) = (v4u){0u, 0u, 0u, 0u};
#pragma unroll
    for (int i = 0; i < 2; ++i) { const int e = tid + 512 * i, g = e >> 7, d = e & 127; int bk;
        if (d < 16) bk = d; else { bk = 16 + (int)(__logf((float)d * (1.f / 16.f)) / 2.0794415416798357f * 16.f); if (bk > 31) bk = 31; }
        *(LAS float*)(lds + L_B + e * 4) = rel[bk * 16 + kvh * 8 + g] * LOG2E; }
    __syncthreads();
    float bv[9][4];
#pragma unroll
    for (int kt = 0; kt < 9; ++kt)
#pragma unroll
        for (int rg = 0; rg < 4; ++rg) { const int dist = 128 - 16 * kt + r - 4 * q - rg; const bool ok = dist >= 0 && dist < 128;
            const float bb = *(const LAS float*)(lds + L_B + (w * 128 + (ok ? dist : 0)) * 4); bv[kt][rg] = ok ? bb : -1e30f; }
    const float sink = sinks[head] * LOG2E;
    bf16x8 Qn0, Qn1; { const bf16* qrow = QB + (tok0 + r) * QW + head * 64 + 8 * q; Qn0 = *(const bf16x8*)qrow; Qn1 = *(const bf16x8*)(qrow + 32); }
#pragma unroll 1
    for (int qt = 0; qt < 8; ++qt) {
        const bf16x8 Qf0 = Qn0, Qf1 = Qn1;
        if (qt + 1 < 8) { const bf16* qrow = QB + (tok0 + 16 * (qt + 1) + r) * QW + head * 64 + 8 * q; Qn0 = *(const bf16x8*)qrow; Qn1 = *(const bf16x8*)(qrow + 32); }
        f32x4 ST[9];
#pragma unroll
        for (int kt = 0; kt < 9; ++kt) {
            if (blk == 0 && qt + kt < 8) { ST[kt] = (f32x4){-1e30f, -1e30f, -1e30f, -1e30f}; }
            else { LAS unsigned char* kp = lds + L_K + (16 * (qt + kt) + r) * RSK + 16 * q; f32x4 a = (f32x4){0.f, 0.f, 0.f, 0.f};
                a = __builtin_amdgcn_mfma_f32_16x16x32_bf16(*(const LAS bf16x8*)kp, Qf0, a, 0, 0, 0); a = __builtin_amdgcn_mfma_f32_16x16x32_bf16(*(const LAS bf16x8*)(kp + 64), Qf1, a, 0, 0, 0);
#pragma unroll
                for (int rg = 0; rg < 4; ++rg) ST[kt][rg] = a[rg] + bv[kt][rg]; } }
        float m = sink;
#pragma unroll
        for (int kt = 0; kt < 9; ++kt)
#pragma unroll
            for (int rg = 0; rg < 4; ++rg) m = fmaxf(m, ST[kt][rg]);
        m = fmaxf(m, __shfl_xor(m, 16)); m = fmaxf(m, __shfl_xor(m, 32));
        float l = 0.f;
#pragma unroll
        for (int kt = 0; kt < 9; ++kt)
#pragma unroll
            for (int rg = 0; rg < 4; ++rg) { const float p = fexp2(ST[kt][rg] - m); ST[kt][rg] = p; l += p; }
        l += __shfl_xor(l, 16); l += __shfl_xor(l, 32);
        const float inv = 1.f / (l + fexp2(sink - m));
        f32x4 O[4];
#pragma unroll
        for (int dt = 0; dt < 4; ++dt) O[dt] = (f32x4){0.f, 0.f, 0.f, 0.f};
#pragma unroll
        for (int cp = 0; cp < 5; ++cp) {
            const f32x4 pa = ST[2 * cp] * inv, pb = (2 * cp + 1 < 9) ? ST[(2 * cp + 1 < 9) ? 2 * cp + 1 : 8] * inv : (f32x4){0.f, 0.f, 0.f, 0.f};
            const bf16x8 P = hg::frag_from2(pa, pb);
#pragma unroll
            for (int dt = 0; dt < 4; ++dt) { LAS unsigned char* p0 = lds + L_V + (16 * (qt + 2 * cp) + 4 * q + (r >> 2)) * RSK + (16 * dt + 4 * (r & 3)) * 2;
                O[dt] = __builtin_amdgcn_mfma_f32_16x16x32_bf16(P, hg::frag_tr2(p0, p0 + 16 * RSK), O[dt], 0, 0, 0); } }
        LAS unsigned char* ow = lds + L_O + w * OW;
#pragma unroll
        for (int dt = 0; dt < 4; ++dt)
#pragma unroll
            for (int rg = 0; rg < 4; ++rg) *(LAS bf16*)(ow + (4 * q + rg) * RSK + (16 * dt + r) * 2) = (bf16)(hg::cvtpk(O[dt][rg], 0.f) & 0xffffu);
#pragma unroll
        for (int i = 0; i < 2; ++i) { const int ci = lane + 64 * i, row = ci >> 3, c8 = ci & 7;
            const v4u v = *(const LAS v4u*)(ow + row * RSK + c8 * 16); *(v4u*)(QB + (tok0 + 16 * qt + row) * QW + head * 64 + c8 * 8) = v; }
    }
}
}

namespace rt {
typedef short bf16x8 __attribute__((ext_vector_type(8)));
__device__ __forceinline__ void prep_w(const float* wco, const float* wfi, const float* gf, bf16* WRH, bf16* WRL, int gtid, int nthr) {
    for (int e = gtid; e < 80 * D; e += nthr) { const int n = e >> 11, k = e & 2047;
        const float w = (n < 8) ? wco[k * 8 + n] : (n < 72 ? wfi[k * 64 + (n - 8)] : 0.f); const float v = w * gf[k];
        const unsigned h = hg::cvtpk(v, 0.f) & 0xffffu; const float l = v - __uint_as_float(h << 16);
        WRH[e] = (bf16)h; WRL[e] = (bf16)(hg::cvtpk(l, 0.f) & 0xffffu); }
}
constexpr int RSB = 272, BUFB = 2 * 80 * RSB, L_G = 2 * BUFB, L_LW = L_G + 8192, L_HIST = L_LW + 8 * 5120;
__device__ __forceinline__ void pass(LAS unsigned char* lds, const float* x, const bf16* DL, float* RSTD2, const float* gf, const bf16* WRH, const bf16* WRL, const float* bco, const float* bfi,
                                     bf16* XN, float* TW, const int tl, const bool live, const int tid, int& ea_out, int& eb_out) {
    const int lane = tid & 63, w = __builtin_amdgcn_readfirstlane(tid >> 6), r = lane & 15, q = lane >> 4;
    const int tok = live ? tl * 16 + r : r;
    LAS float* lw = (LAS float*)(lds + L_LW + w * 5120);
    v4u st[5];
#define RT_BLOAD(ck_) do { _Pragma("unroll") for (int i = 0; i < 5; ++i) { const int p_ = tid + 512 * i, mat_ = p_ >= 1280, rem_ = p_ - 1280 * mat_, n_ = rem_ >> 4, j_ = rem_ & 15; \
        st[i] = *(const v4u*)((mat_ ? WRL : WRH) + (size_t)n_ * D + (ck_) * 128 + j_ * 8); } } while (0)
#define RT_BSTORE(buf_) do { _Pragma("unroll") for (int i = 0; i < 5; ++i) { const int p_ = tid + 512 * i, mat_ = p_ >= 1280, rem_ = p_ - 1280 * mat_, n_ = rem_ >> 4, j_ = rem_ & 15; \
        *(LAS v4u*)(lds + (buf_) * BUFB + mat_ * 80 * RSB + n_ * RSB + j_ * 16) = st[i]; } } while (0)
    RT_BLOAD(0);
    const float* xr = x + (size_t)tok * D + 8 * q; bf16* xo = XN + (size_t)tok * D + 8 * q;
    const int tl0 = live ? tl : 0, t0 = (tl0 & 15) * 16;
    const unsigned char* dbase = (const unsigned char*)DL + (size_t)(tl0 >> 4) * 8 * 131072 + (((t0 >> 7) * 4 + ((t0 >> 4) & 3)) * 2) * 8192 + (((t0 >> 6) & 1) * 4) * 1024 + (q * 16 + r) * 16;
    f32x4 X[4][2]; v4u Dl[4];
#define RT_XLOAD(ck_) do { _Pragma("unroll") for (int s_ = 0; s_ < 4; ++s_) { const int c_ = 4 * (ck_) + s_; X[s_][0] = __builtin_nontemporal_load((const f32x4*)(xr + 32 * c_)); \
        X[s_][1] = __builtin_nontemporal_load((const f32x4*)(xr + 32 * c_ + 4)); Dl[s_] = __builtin_nontemporal_load((const v4u*)(dbase + (size_t)(c_ >> 3) * 131072 + (c_ & 1) * 8192 + ((c_ >> 1) & 3) * 1024)); } } while (0)
    RT_XLOAD(0);
    RT_BSTORE(0);
    __syncthreads();
    f32x4 acc[5];
#pragma unroll
    for (int nt = 0; nt < 5; ++nt) acc[nt] = (f32x4){0.f, 0.f, 0.f, 0.f};
    float ssq = 0.f;
#pragma unroll 1
    for (int ck = 0; ck < 16; ++ck) {
        f32x4 Xc[4][2]; v4u Dc[4];
#pragma unroll
        for (int s_ = 0; s_ < 4; ++s_) { Xc[s_][0] = X[s_][0]; Xc[s_][1] = X[s_][1]; Dc[s_] = Dl[s_]; }
        if (ck + 1 < 16) { RT_BLOAD(ck + 1); RT_XLOAD(ck + 1); }
        LAS unsigned char* bb = lds + (ck & 1) * BUFB + r * RSB + 16 * q;
#pragma unroll
        for (int s_ = 0; s_ < 4; ++s_) {
            const int c = 4 * ck + s_;
            f32x4 x0 = Xc[s_][0], x1 = Xc[s_][1]; { f32x4 d0, d1; pg8::unpack8(Dc[s_], d0, d1); x0 += d0; x1 += d1; }
            ssq += ((x0[0] * x0[0] + x0[1] * x0[1]) + (x0[2] * x0[2] + x0[3] * x0[3])) + ((x1[0] * x1[0] + x1[1] * x1[1]) + (x1[2] * x1[2] + x1[3] * x1[3]));
            v4u hi; hi.x = hg::cvtpk(x0[0], x0[1]); hi.y = hg::cvtpk(x0[2], x0[3]); hi.z = hg::cvtpk(x1[0], x1[1]); hi.w = hg::cvtpk(x1[2], x1[3]);
            if (live) *(v4u*)(xo + 32 * c) = hi;
            v4u lo; lo.x = hg::cvtpk(x0[0] - hg::blo(hi.x), x0[1] - hg::bhi(hi.x)); lo.y = hg::cvtpk(x0[2] - hg::blo(hi.y), x0[3] - hg::bhi(hi.y));
            lo.z = hg::cvtpk(x1[0] - hg::blo(hi.z), x1[1] - hg::bhi(hi.z)); lo.w = hg::cvtpk(x1[2] - hg::blo(hi.w), x1[3] - hg::bhi(hi.w));
            const bf16x8 Ah = __builtin_bit_cast(bf16x8, hi), Al = __builtin_bit_cast(bf16x8, lo);
#pragma unroll
            for (int nt = 0; nt < 5; ++nt) { const bf16x8 Bh = *(const LAS bf16x8*)(bb + nt * 16 * RSB + 64 * s_), Bl = *(const LAS bf16x8*)(bb + 80 * RSB + nt * 16 * RSB + 64 * s_);
                acc[nt] = __builtin_amdgcn_mfma_f32_16x16x32_bf16(Ah, Bh, acc[nt], 0, 0, 0); acc[nt] = __builtin_amdgcn_mfma_f32_16x16x32_bf16(Ah, Bl, acc[nt], 0, 0, 0);
                acc[nt] = __builtin_amdgcn_mfma_f32_16x16x32_bf16(Al, Bh, acc[nt], 0, 0, 0); }
        }
        if (ck + 1 < 16) RT_BSTORE((ck + 1) & 1);
        __syncthreads();
    }
#undef RT_BLOAD
#undef RT_BSTORE
#undef RT_XLOAD
    ssq += __shfl_xor(ssq, 16); ssq += __shfl_xor(ssq, 32);
    const float rstd = rsqrtf(ssq * (1.f / D) + EPS);
    if (live && q == 0) RSTD2[tok] = rstd;
#pragma unroll
    for (int nt = 0; nt < 5; ++nt)
#pragma unroll
        for (int rg = 0; rg < 4; ++rg) lw[(4 * q + rg) * 80 + 16 * nt + r] = acc[nt][rg];
    asm volatile("s_waitcnt lgkmcnt(0)" ::: "memory");
    if (live && lane < 16) {
        const LAS float* L = lw + lane * 80;
        float cm = L[0] * rstd + bco[0]; int grp = 0; float cv[8]; cv[0] = cm;
#pragma unroll
        for (int j = 1; j < 8; ++j) { cv[j] = L[j] * rstd + bco[j]; if (cv[j] > cm) { cm = cv[j]; grp = j; } }
        float den = 0.f;
#pragma unroll
        for (int j = 0; j < 8; ++j) den += fexp(cv[j] - cm);
        const float psel = 1.f / den;
        float f[8];
#pragma unroll
        for (int j = 0; j < 8; ++j) f[j] = L[8 + grp * 8 + j] * rstd + bfi[grp * 8 + j];
        int i0 = 0; float f0 = f[0];
#pragma unroll
        for (int j = 1; j < 8; ++j) if (f[j] > f0) { f0 = f[j]; i0 = j; }
        int i1 = -1; float f1 = 0.f;
#pragma unroll
        for (int j = 0; j < 8; ++j) if (j != i0 && (i1 < 0 || f[j] > f1)) { f1 = f[j]; i1 = j; }
        const float e1 = fexp(f1 - f0), w0 = psel / (1.f + e1), w1 = psel * e1 / (1.f + e1);
        ea_out = grp * 8 + i0; eb_out = grp * 8 + i1;
        TW[tok * 2] = w0; TW[tok * 2 + 1] = w1;
    }
}
}

constexpr int LDS_BYTES = 155648;
constexpr int LDS_MISC = 152576;

__global__ void __launch_bounds__(NTHR, 2) fwd_kernel(Args args) {
    extern __shared__ __attribute__((aligned(16))) unsigned char lds_raw[];
    LAS unsigned char* lds = (LAS unsigned char*)lds_raw;
    LAS float* ldsf = (LAS float*)lds;
    volatile LAS unsigned* MISC = (volatile LAS unsigned*)(lds + LDS_MISC);
    int tid = threadIdx.x; asm volatile("" : "+v"(tid));
    int lane = tid & 63, wave = __builtin_amdgcn_readfirstlane(tid >> 6);
#define GRID_SYNC() do { xcd_barrier(bar, tid); asm volatile("" : "+v"(tid)); lane = tid & 63; wave = __builtin_amdgcn_readfirstlane(tid >> 6); gw = bx * NWAVES + wave; } while (0)
    const int G = gridDim.x, bx = blockIdx.x;
    int gw = bx * NWAVES + wave; const int NGW = G * NWAVES;
    unsigned char* ws = args.ws;
    unsigned* ctl = (unsigned*)(ws + WS_CTL);
    if (tid < 64) MISC[tid] = 0u;
    __syncthreads();
    XcdBarrier bar = xcd_barrier_post(ctl + CW_BAR, MISC + 8, tid);

    const float* x = args.in[I_X];
    float* hbuf = args.out;
    float* LB = (float*)(ws + WS_SMALL);
    float* TW = (float*)(ws + WS_SMALL + 65536);
    unsigned short* LIST = (unsigned short*)(ws + WS_LIST);
    bf16* W_IN_T = (bf16*)(ws + WS_WIN); bf16* W_UA_T = (bf16*)(ws + WS_WUA); bf16* W_UR_T = (bf16*)(ws + WS_WUR);
    bf16* W_OUT_T = (bf16*)(ws + WS_WOUT); bf16* W_PG_T = (bf16*)(ws + WS_WPG); bf16* W_PI_T = (bf16*)(ws + WS_WPI);
    bf16* U = (bf16*)(ws + WS_RA); bf16* OREC = (bf16*)(ws + WS_RA); bf16* XN = (bf16*)(ws + WS_RA);
    bf16* QB = (bf16*)(ws + WS_RB); bf16* KVB = (bf16*)(ws + WS_RB + 64 * MiB); bf16* HID = (bf16*)(ws + WS_RB); bf16* PB = (bf16*)(ws + WS_PB);
    bf16* HG = (bf16*)(ws + WS_RC); bf16* MIX = (bf16*)(ws + WS_RC); bf16* Y = (bf16*)(ws + WS_RE);
    bf16* GT = (bf16*)(ws + WS_RD); bf16* W_DN_T = (bf16*)(ws + WS_RD); bf16* PL = (bf16*)(ws + WS_RD + 128 * MiB);
    bf16* W_GU_T = (bf16*)(ws + WS_RE);
    float* RSTDP = (float*)(ws + WS_SMALL + 393216); float* RSTD3 = (float*)(ws + WS_SMALL + 524288); float* RSTD2 = (float*)(ws + WS_SMALL + 655360);
    bf16* DELTA = (bf16*)(ws + WS_RC + 128 * MiB);
    bf16* H3B = (bf16*)(ws + WS_RC);
    bf16* WRH = (bf16*)(ws + 6 * MiB); bf16* WRL = (bf16*)(ws + 6 * MiB + 512 * 1024);
    float* UST = (float*)(ws + WS_RA + 64 * MiB); float* DST = (float*)(ws + WS_RA + 96 * MiB);
    float* SS_H1 = (float*)(ws + WS_SS); float* SS_PL = (float*)(ws + WS_SS + 4 * MiB); float* SS_FIN = (float*)(ws + WS_SS + 8 * MiB);
    unsigned* CNT = ctl + CW_CNT;
    LAS unsigned char* ring = lds;

#ifndef REP_P0
#define REP_P0 1
#endif
#ifndef REP_P1
#define REP_P1 1
#endif
#pragma unroll 1
    for (int rep = 0; rep < REP_P0; ++rep) {
        LAS float* scr = ldsf + wave * 4096;
        transpose_all(args.in[I_WIN], D, INC, W_IN_T, scr, gw, NGW, lane, D);
        transpose_all(args.in[I_WUA], QW, D, W_UA_T, scr, gw, NGW, lane, QW);
        transpose_all(args.in[I_WUR], HW, D, W_UR_T, scr, gw, NGW, lane, HW);
        transpose_all(args.in[I_WOUT], D, D, W_OUT_T, scr, gw, NGW, lane, D);
        transpose_all(args.in[I_WPG], D, D, W_PG_T, scr, gw, NGW, lane, D);
        transpose_all(args.in[I_WPI], PLE, D, W_PI_T, scr, gw, NGW, lane, PLE);
        for (int it = gw; it < (NEXP - 16) * 1024; it += NGW) { const int e = it >> 10, r = it & 1023, mat = r >> 9, item = r & 511;
            transpose_item(args.in[mat ? I_WU : I_WG] + (size_t)e * D * MH, D, MH, W_GU_T + (size_t)e * 1024 * D, scr, item, lane, 1 + mat, D, args.in[I_GFFN]); }
        for (int m = gw; m < NTOK; m += NGW) { const f32x4 pv = __builtin_nontemporal_load((const f32x4*)(args.in[I_P] + (size_t)m * PLE) + lane);
            v2u w; w.x = pk2(pv.x, pv.y); w.y = pk2(pv.z, pv.w); *((v2u*)(PB + (size_t)m * PLE) + lane) = w; }
        const float* gm = args.in[I_GMIX];
        for (int m = gw; m < NTOK; m += NGW) {
            const f32x4* xr = (const f32x4*)(x + (size_t)m * D) + lane;
            f32x4 v[8]; float s = 0.f;
#pragma unroll
            for (int j = 0; j < 8; ++j) { v[j] = __builtin_nontemporal_load(xr + 64 * j); s += (v[j].x * v[j].x + v[j].y * v[j].y) + (v[j].z * v[j].z + v[j].w * v[j].w); }
            const float rstd = rsqrtf(wave_sum(s) * (1.f / D) + EPS);
            v2u* o = (v2u*)(U + (size_t)m * D) + lane;
#pragma unroll
            for (int j = 0; j < 8; ++j) { const f32x4 g = *((const f32x4*)gm + 64 * j + lane); v2u w; w.x = pk2(v[j].x * rstd * g.x, v[j].y * rstd * g.y); w.y = pk2(v[j].z * rstd * g.z, v[j].w * rstd * g.w); o[64 * j] = w; }
        }
        rt::prep_w(args.in[I_WCO], args.in[I_WFI], args.in[I_GFFN], WRH, WRL, bx * NTHR + tid, G * NTHR);
        const float* lbl = args.in[I_LBL];
        for (int j = bx * NTHR + tid; j < HW; j += G * NTHR) LB[j] = 1.f / (1.f + __expf(lbl[HW + j] - lbl[j]));
    }
    GRID_SYNC();

#pragma unroll 1
    for (int rep = 0; rep < REP_P1; ++rep) {
        pg8::StaticOrder S; S.init(U, W_IN_T, NTOK, INC, D, D, G, bx);
        pg8::EpiZ E{args.in[I_BQKV], LB, QB, KVB, HG, GT};
        pg8::gemm_phase<pg8::EpiZ, pg8::StaticOrder, true, false>(ring, D, D, D, S, E, tid);
        const int nshort = G - (S.nwg % G);
        if (S.nwg % G != 0 && bx >= S.nwg % G) { LAS float* scr = ldsf + wave * 4096; const int sw = (bx - S.nwg % G) * NWAVES + wave, nsw = nshort * NWAVES;
            for (int it = sw; it < 16 * 1024; it += nsw) { const int e = (NEXP - 16) + (it >> 10), r = it & 1023, mat = r >> 9, item = r & 511;
                transpose_item(args.in[mat ? I_WU : I_WG] + (size_t)e * D * MH, D, MH, W_GU_T + (size_t)e * 1024 * D, scr, item, lane, 1 + mat, D, args.in[I_GFFN]); } }
        else if (S.nwg % G == 0) { LAS float* scr = ldsf + wave * 4096;
            for (int it = gw; it < 16 * 1024; it += NGW) { const int e = (NEXP - 16) + (it >> 10), r = it & 1023, mat = r >> 9, item = r & 511;
                transpose_item(args.in[mat ? I_WU : I_WG] + (size_t)e * D * MH, D, MH, W_GU_T + (size_t)e * 1024 * D, scr, item, lane, 1 + mat, D, args.in[I_GFFN]); } }
    }
    GRID_SYNC();

    for (int u = bx; u < 512; u += G) hg::unit<true>(lds, HG, OREC, UST, DST, args.in[I_GHGRN], u, tid);
    for (int it = bx; it < 2 * 128 * 2; it += G) at::item(lds, QB, KVB, args.in[I_SINKS], args.in[I_REL], it, tid);
    GRID_SYNC();

    hg::scan(UST, DST, bx * NTHR + tid, G * NTHR);
    GRID_SYNC();
    for (int u = bx; u < 512; u += G) hg::unit<false>(lds, HG, OREC, UST, DST, args.in[I_GHGRN], u, tid);
    GRID_SYNC();

    {
        pg8::PairOrder S; S.s0.init(QB, W_UA_T, NTOK, D, QW, QW, G, bx); S.A1 = (const char*)OREC; S.B1 = (const char*)W_UR_T;
        pg8::EpiMix E{GT, MIX, (unsigned char*)UST + (size_t)bx * 131072};
        pg8::gemm_phase<pg8::EpiMix, pg8::PairOrder, true, false>(ring, QW, QW, QW, S, E, tid);
    }
    GRID_SYNC();

    {
        pg8::StaticOrder S; S.init(MIX, W_OUT_T, NTOK, D, D, D, G, bx);
        pg8::EpiDelta E{DELTA};
        pg8::gemm_phase<pg8::EpiDelta, pg8::StaticOrder, true, false>(ring, D, D, D, S, E, tid);
    }
    GRID_SYNC();

    {
        {
            LAS float* scr = ldsf + wave * 4096;
            for (int it = gw; it < NEXP * 512; it += NGW) { const int e = it >> 9, item = it & 511;
                transpose_item(args.in[I_WD] + (size_t)e * MH * D, MH, D, W_DN_T + (size_t)e * D * MH, scr, item, lane, 0, MH); }
        }
        __syncthreads();
        LAS unsigned* hist = (LAS unsigned*)(lds + rt::L_HIST);
        for (int i = 0; i * NGW < NTOK / 16; ++i) {
            const int tl = gw + i * NGW; const bool live = tl < NTOK / 16;
            __syncthreads();
            if (tid < 64) hist[tid] = 0u;
            int ea = 0, eb = 0; unsigned ra = 0u, rb = 0u;
            rt::pass(lds, x, DELTA, RSTD2, args.in[I_GFFN], WRH, WRL, args.in[I_BCO], args.in[I_BFI], XN, TW, tl, live, tid, ea, eb);
            if (live && lane < 16) { ra = atomicAdd((unsigned*)(hist + ea), 1u); rb = atomicAdd((unsigned*)(hist + eb), 1u); }
            __syncthreads();
            if (tid < 64) { const unsigned c = hist[tid]; hist[64 + tid] = c ? atomicAdd(CNT + 64 * tid, c) : 0u; }
            __syncthreads();
            if (live && lane < 16) { const int m = tl * 16 + lane;
                LIST[(size_t)ea * NTOK + hist[64 + ea] + ra] = (unsigned short)m; LIST[(size_t)eb * NTOK + hist[64 + eb] + rb] = (unsigned short)(m | 0x8000); }
        }
    }
    GRID_SYNC();

    LAS int* eoff = (LAS int*)(lds + 150528);
    LAS int* ecnt = (LAS int*)(lds + 150528 + 512);
    if (tid < 64) {
        const int c = (int)__hip_atomic_load(CNT + 64 * tid, __ATOMIC_RELAXED, __HIP_MEMORY_SCOPE_AGENT); int v = (c + 255) & ~255;
#pragma unroll
        for (int d = 1; d < 64; d <<= 1) { const int t = __shfl_up(v, d); if (lane >= d) v += t; }
        ecnt[tid] = c; eoff[tid] = v - ((c + 255) & ~255); if (tid == 63) eoff[NEXP] = v;
    }
    __syncthreads();
    const int vcu = (G % 8 == 0) ? (bx % 8) * (G / 8) + bx / 8 : bx;
    const int nrb = eoff[NEXP] / 256;
    {
        pg8::MoeOrder S{eoff, ecnt, 4, G, vcu, nrb, (const char*)XN, (const char*)W_GU_T, (size_t)1024 * D * 2, (size_t)256 * D * 2, (size_t)D * 2, LIST, 1};
        pg8::EpiGateUp E{HID, LIST, RSTD2};
        pg8::gemm_phase<pg8::EpiGateUp, pg8::MoeOrder, true, true>(ring, D, D, D, S, E, tid);
    }
    const int r6 = (nrb * 4) % G, ple_early = r6 ? ((G - r6) * 8 < 1024 ? (G - r6) * 8 : 1024) : 0;
    if (r6 && vcu >= r6) {
        pg8::StaticOrder S; S.init(PB, W_PI_T, NTOK, D, PLE, PLE, 1, 0); S.lo = (vcu - r6) * 8; S.hi = S.lo + 8 < ple_early ? S.lo + 8 : ple_early;
        pg8::EpiPleRaw E{PL, SS_PL};
        pg8::gemm_phase<pg8::EpiPleRaw, pg8::StaticOrder, true, false>(ring, PLE, PLE, PLE, S, E, tid);
    }
    GRID_SYNC();
    {
        pg8::MoeOrder S{eoff, ecnt, 8, G, vcu, nrb, (const char*)HID, (const char*)W_DN_T, (size_t)D * MH * 2, (size_t)256 * MH * 2, (size_t)MH * 2, LIST, 0};
        pg8::EpiDown E{LIST, TW, Y};
        pg8::gemm_phase<pg8::EpiDown, pg8::MoeOrder, true, false>(ring, MH, MH, MH, S, E, tid);
    }
    {
        pg8::StaticOrder S; S.init(PB, W_PI_T, NTOK, D, PLE, PLE, G, bx); S.lo = ple_early;
        pg8::EpiPleRaw E{PL, SS_PL};
        pg8::gemm_phase<pg8::EpiPleRaw, pg8::StaticOrder, true, false>(ring, PLE, PLE, PLE, S, E, tid);
    }
    GRID_SYNC();

    {
        for (int m = gw; m < NTOK; m += NGW) {
            const v2u* hb = (const v2u*)(XN + (size_t)m * D) + lane;
            const v2u* y0 = (const v2u*)(Y + (size_t)m * D) + lane; const v2u* y1 = (const v2u*)(Y + (size_t)NTOK * D + (size_t)m * D) + lane;
            v2u* o = (v2u*)(XN + (size_t)m * D) + lane;
            float s = 0.f;
#pragma unroll
            for (int j = 0; j < 8; ++j) { const v2u a = __builtin_nontemporal_load(y0 + 64 * j), c = __builtin_nontemporal_load(y1 + 64 * j), dd = __builtin_nontemporal_load(hb + 64 * j);
                f32x4 v; v.x = __uint_as_float(dd.x << 16); v.y = __uint_as_float(dd.x & 0xffff0000u); v.z = __uint_as_float(dd.y << 16); v.w = __uint_as_float(dd.y & 0xffff0000u);
                v.x += __uint_as_float(a.x << 16) + __uint_as_float(c.x << 16); v.y += __uint_as_float(a.x & 0xffff0000u) + __uint_as_float(c.x & 0xffff0000u);
                v.z += __uint_as_float(a.y << 16) + __uint_as_float(c.y << 16); v.w += __uint_as_float(a.y & 0xffff0000u) + __uint_as_float(c.y & 0xffff0000u);
                s += (v.x * v.x + v.y * v.y) + (v.z * v.z + v.w * v.w);
                v2u w; w.x = hg::cvtpk(v.x, v.y); w.y = hg::cvtpk(v.z, v.w); o[64 * j] = w; }
            const float ssum = wave_sum(s);
            const float sp = wave_sum(lane < 32 ? SS_PL[(size_t)m * 32 + lane] : 0.f);
            if (lane == 0) { RSTD3[m] = rsqrtf(ssum * (1.f / D) + EPS); RSTDP[m] = rsqrtf(sp * (1.f / D) + EPS); }
        }
    }
    GRID_SYNC();

    {
        pg8::StaticOrder S; S.init(XN, W_PG_T, NTOK, D, D, D, G, bx);
        pg8::EpiPleGate E{H3B, PL, RSTD3, RSTDP, args.in[I_GPLE]};
        pg8::gemm_phase<pg8::EpiPleGate, pg8::StaticOrder, true, false>(ring, D, D, D, S, E, tid);
    }
    GRID_SYNC();

    {
        const float* gfin = args.in[I_GFIN];
        f32x4 gv[8];
#pragma unroll
        for (int j = 0; j < 8; ++j) gv[j] = *((const f32x4*)gfin + 64 * j + lane);
        for (int m = gw; m < NTOK; m += 2 * NGW) {
            const int m1 = (m + NGW < NTOK) ? m + NGW : m;
            f32x4* o0 = (f32x4*)(hbuf + (size_t)m * D) + lane; f32x4* o1 = (f32x4*)(hbuf + (size_t)m1 * D) + lane;
            const v2u* u0 = (const v2u*)(H3B + (size_t)m * D) + lane; const v2u* u1 = (const v2u*)(H3B + (size_t)m1 * D) + lane;
            const v2u* h0 = (const v2u*)(XN + (size_t)m * D) + lane; const v2u* h1 = (const v2u*)(XN + (size_t)m1 * D) + lane;
            v2u a0[8], a1[8], b0[8], b1[8];
#pragma unroll
            for (int j = 0; j < 8; ++j) { a0[j] = __builtin_nontemporal_load(u0 + 64 * j); a1[j] = __builtin_nontemporal_load(u1 + 64 * j); b0[j] = __builtin_nontemporal_load(h0 + 64 * j); b1[j] = __builtin_nontemporal_load(h1 + 64 * j); }
            f32x4 y0[8], y1[8]; float s0 = 0.f, s1 = 0.f;
#pragma unroll
            for (int j = 0; j < 8; ++j) {
                y0[j].x = __uint_as_float(a0[j].x << 16) + __uint_as_float(b0[j].x << 16); y0[j].y = __uint_as_float(a0[j].x & 0xffff0000u) + __uint_as_float(b0[j].x & 0xffff0000u);
                y0[j].z = __uint_as_float(a0[j].y << 16) + __uint_as_float(b0[j].y << 16); y0[j].w = __uint_as_float(a0[j].y & 0xffff0000u) + __uint_as_float(b0[j].y & 0xffff0000u);
                y1[j].x = __uint_as_float(a1[j].x << 16) + __uint_as_float(b1[j].x << 16); y1[j].y = __uint_as_float(a1[j].x & 0xffff0000u) + __uint_as_float(b1[j].x & 0xffff0000u);
                y1[j].z = __uint_as_float(a1[j].y << 16) + __uint_as_float(b1[j].y << 16); y1[j].w = __uint_as_float(a1[j].y & 0xffff0000u) + __uint_as_float(b1[j].y & 0xffff0000u);
                s0 += (y0[j].x * y0[j].x + y0[j].y * y0[j].y) + (y0[j].z * y0[j].z + y0[j].w * y0[j].w); s1 += (y1[j].x * y1[j].x + y1[j].y * y1[j].y) + (y1[j].z * y1[j].z + y1[j].w * y1[j].w); }
            const float r0 = rsqrtf(wave_sum(s0) * (1.f / D) + EPS), r1 = rsqrtf(wave_sum(s1) * (1.f / D) + EPS);
#pragma unroll
            for (int j = 0; j < 8; ++j) { __builtin_nontemporal_store(y0[j] * r0 * gv[j], o0 + 64 * j); __builtin_nontemporal_store(y1[j] * r1 * gv[j], o1 + 64 * j); }
        }
    }
}

extern "C" void kernel_launch(void* const* d_in, const int* in_sizes, int n_in, void* d_out, int out_size, void* d_ws, size_t ws_size, hipStream_t stream) {
    static int grid = 0;
    if (grid == 0) {
        if (n_in != 24 || out_size != NTOK * D || ws_size < WS_END) { fprintf(stderr, "kernel_launch: unexpected shapes (n_in %d, out %d, ws %zu)\n", n_in, out_size, ws_size); grid = -1; return; }
        int dev = 0, cus = 0;
        if (hipGetDevice(&dev) != hipSuccess || hipDeviceGetAttribute(&cus, hipDeviceAttributeMultiprocessorCount, dev) != hipSuccess) { grid = -1; return; }
        if (hipFuncSetAttribute((const void*)fwd_kernel, hipFuncAttributeMaxDynamicSharedMemorySize, LDS_BYTES) != hipSuccess) { fprintf(stderr, "kernel_launch: hipFuncSetAttribute failed\n"); grid = -1; return; }
        int per_cu = 0;
        if (hipOccupancyMaxActiveBlocksPerMultiprocessor(&per_cu, (const void*)fwd_kernel, NTHR, LDS_BYTES) != hipSuccess || per_cu < 1) { fprintf(stderr, "kernel_launch: occupancy query says %d\n", per_cu); }
        (void)hipGetLastError();
        grid = cus;
    }
    if (grid < 0) return;
    if (hipMemsetAsync((char*)d_ws + WS_CTL, 0, CTL_ZERO_BYTES, stream) != hipSuccess) return;
    Args a{};
    for (int i = 0; i < 24; ++i) a.in[i] = (const float*)d_in[i];
    a.out = (float*)d_out; a.ws = (unsigned char*)d_ws;
    hipLaunchKernelGGL(fwd_kernel, dim3(grid), dim3(NTHR), LDS_BYTES, stream, a);
}
```

```cpp
#include <hip/hip_runtime.h>
#include <cstdio>
#include <cstdint>

#define GAS __attribute__((address_space(1)))
#define LAS __attribute__((address_space(3)))
typedef unsigned short bf16;
typedef float f32x4 __attribute__((ext_vector_type(4)));
typedef unsigned v4u __attribute__((ext_vector_type(4)));
typedef unsigned v2u __attribute__((ext_vector_type(2)));

constexpr int NTOK = 32768, SEQ = 16384, D = 2048;
constexpr int QW = 1024, KVW = 128, QKVW = 1280, HW = 1024, INC = 9472;
constexpr int NEXP = 64, MH = 512, PLE = 256;
constexpr float EPS = 1e-6f;
constexpr int NWAVES = 8, NTHR = 512;
constexpr size_t HGPS = (size_t)NTOK * 128;
constexpr int HIDCAP = 81920;

constexpr size_t MiB = 1u << 20;
constexpr size_t WS_CTL = 0, CTL_ZERO_BYTES = 1 * MiB;
constexpr size_t WS_SMALL = 1 * MiB;
constexpr size_t WS_LIST = 2 * MiB;
constexpr size_t WS_WIN = 8 * MiB, WS_WUA = 45 * MiB, WS_WUR = 49 * MiB, WS_WOUT = 53 * MiB, WS_WPG = 61 * MiB, WS_WPI = 69 * MiB;
constexpr size_t WS_RA = 70 * MiB;
constexpr size_t WS_RB = 198 * MiB;
constexpr size_t WS_RC = 278 * MiB;
constexpr size_t WS_RD = 534 * MiB;
constexpr size_t WS_RE = 790 * MiB;
constexpr size_t WS_PB = 1046 * MiB;
constexpr size_t WS_SS = 1062 * MiB;
constexpr size_t WS_END = 1074 * MiB;
constexpr int CW_BAR = 4096;
constexpr int CW_CNT = 16384;
constexpr int CW_PACE = 32768;

__device__ __forceinline__ float bf2f(bf16 h) { return __uint_as_float(((unsigned)h) << 16); }
__device__ __forceinline__ unsigned f2bf(float f) { unsigned u = __float_as_uint(f); return (u + 0x7fffu + ((u >> 16) & 1u)) >> 16; }
__device__ __forceinline__ unsigned pk2(float lo, float hi) { return f2bf(lo) | (f2bf(hi) << 16); }
constexpr float LOG2E = 1.4426950408889634f;
__device__ __forceinline__ float fexp2(float x) { return __builtin_amdgcn_exp2f(x); }
__device__ __forceinline__ float fexp(float x) { return __builtin_amdgcn_exp2f(x * LOG2E); }
__device__ __forceinline__ float flog2(float x) { return __builtin_amdgcn_logf(x); }
__device__ __forceinline__ float wave_sum(float v) {
#pragma unroll
    for (int o = 1; o < 64; o <<= 1) v += __shfl_xor(v, o);
    return v;
}

#define XB_TMO      128
#define XB_XCNT(j)  (256  + 64 * (j))
#define XB_XSUB(j)  (1280 + 64 * (j))
#define XB_XGEN(j)  (2304 + 64 * (j))
#define XB_TOP      3328
#define XB_TOPGEN   3392
#define XCD_BAR_WORDS 3456
#define XB_SPIN_CAP (1u << 23)
__device__ __forceinline__ unsigned xb_ld(unsigned* p)              { return __hip_atomic_load(p, __ATOMIC_RELAXED, __HIP_MEMORY_SCOPE_AGENT); }
__device__ __forceinline__ unsigned xb_add(unsigned* p, unsigned v) { return __hip_atomic_fetch_add(p, v, __ATOMIC_RELAXED, __HIP_MEMORY_SCOPE_AGENT); }
__device__ __forceinline__ unsigned xb_xcc_id() { return (unsigned)__builtin_amdgcn_s_getreg((3 << 11) | 20) & 0xFu; }
#define XB_SPIN(cond, bar) do { unsigned _sp = 0; while (cond) { __builtin_amdgcn_s_sleep(1); \
    if ((++_sp & 255u) == 0u) { if (xb_ld(&(bar)[XB_TMO])) break; if (_sp > XB_SPIN_CAP) { atomicAdd(&(bar)[XB_TMO], 1u); break; } } } } while (0)
struct XcdBarrier { unsigned* bar; unsigned x; volatile LAS unsigned* st; };
__device__ __forceinline__ XcdBarrier xcd_barrier_post(unsigned* bar, volatile LAS unsigned* st, const int tid) {
    XcdBarrier b; b.bar = bar; b.x = xb_xcc_id(); b.st = st;
    if (tid == 0) (void)xb_add(&bar[XB_XCNT(b.x)], 1u);
    return b;
}
__device__ __forceinline__ void xcd_barrier_complete(unsigned* bar, unsigned x, unsigned& nloc, unsigned& nx) {
    const unsigned G = gridDim.x * gridDim.y * gridDim.z;
    unsigned sum, cnt, mine, sp = 0u;
    for (;;) {
        sum = 0u; cnt = 0u; mine = 0u;
#pragma unroll
        for (unsigned j = 0; j < 16; ++j) { const unsigned c = xb_ld(&bar[XB_XCNT(j)]); sum += c; cnt += (c > 0u) ? 1u : 0u; mine = (j == x) ? c : mine; }
        if (sum == G) break;
        __builtin_amdgcn_s_sleep(1);
        if ((++sp & 255u) == 0u) { if (xb_ld(&bar[XB_TMO])) break; if (sp > XB_SPIN_CAP) { atomicAdd(&bar[XB_TMO], 1u); break; } }
    }
    nloc = mine > 0u ? mine : 1u; nx = cnt > 0u ? cnt : 1u;
}
__device__ __forceinline__ void xcd_barrier(const XcdBarrier& b, const int tid) {
    asm volatile("s_waitcnt vmcnt(0)" ::: "memory");
    __syncthreads();
    if (tid == 0) {
        unsigned* bar = b.bar;
        __builtin_amdgcn_s_waitcnt(0);
        unsigned nloc = b.st[0], nx = b.st[1];
        if (nloc == 0u) { xcd_barrier_complete(bar, b.x, nloc, nx); b.st[0] = nloc; b.st[1] = nx; }
        const unsigned old = xb_add(&bar[XB_XSUB(b.x)], 1u);
        const unsigned gen = old / nloc;
        if (old + 1u == (gen + 1u) * nloc) {
            __builtin_amdgcn_fence(__ATOMIC_RELEASE, "agent");
            asm volatile("s_waitcnt vmcnt(0)" ::: "memory");
            const unsigned og = xb_add(&bar[XB_TOP], 1u);
            const unsigned tg = og / nx;
            if (og + 1u == (tg + 1u) * nx) xb_add(&bar[XB_TOPGEN], 1u);
            else XB_SPIN(xb_ld(&bar[XB_TOPGEN]) == tg, bar);
            __builtin_amdgcn_fence(__ATOMIC_ACQUIRE, "agent");
            xb_add(&bar[XB_XGEN(b.x)], 1u);
            asm volatile("s_waitcnt vmcnt(0)" ::: "memory");
        } else {
            XB_SPIN(xb_ld(&bar[XB_XGEN(b.x)]) == gen, bar);
            __builtin_amdgcn_fence(__ATOMIC_ACQUIRE, "agent");
            asm volatile("s_waitcnt vmcnt(0)" ::: "memory");
        }
    }
    __syncthreads();
}

struct Args {
    const float* in[24];
    float* out;
    unsigned char* ws;
};
enum { I_X = 0, I_P, I_GMIX, I_WIN, I_BQKV, I_SINKS, I_REL, I_LBL, I_GHGRN, I_WUA, I_WUR, I_WOUT, I_GFFN, I_WCO, I_BCO, I_WFI, I_BFI,
       I_WG, I_WU, I_WD, I_WPI, I_GPLE, I_WPG, I_GFIN };

__device__ __forceinline__ void transpose_item(const float* W, int K, int N, bf16* WT, LAS float* scr, int item, int lane, int gu, int ldw, const float* ks = nullptr) {
    const int nblk = N / 32, kb = item / nblk, nb = item % nblk, k0 = 64 * kb, n0 = 32 * nb;
    const int d0 = gu ? (256 * (n0 >> 7) + 64 * ((n0 & 127) >> 5) + 32 * (gu - 1)) : n0;
#pragma unroll 8
    for (int i = 0; i < 32; ++i) { const int kk = 2 * i + (lane >> 5); scr[kk * 33 + (lane & 31)] = __builtin_nontemporal_load(W + (size_t)(k0 + kk) * N + n0 + (lane & 31)); }
    asm volatile("s_waitcnt lgkmcnt(0)" ::: "memory");
    const int c = lane & 7;
    f32x4 k0s = (f32x4){1.f, 1.f, 1.f, 1.f}, k1s = k0s; if (ks) { k0s = *(const f32x4*)(ks + k0 + 8 * c); k1s = *(const f32x4*)(ks + k0 + 8 * c + 4); }
#pragma unroll
    for (int j = 0; j < 4; ++j) { const int n = (lane >> 3) + 8 * j; const LAS float* s = scr + (8 * c) * 33 + n;
        v4u o; o.x = pk2(s[0 * 33] * k0s[0], s[1 * 33] * k0s[1]); o.y = pk2(s[2 * 33] * k0s[2], s[3 * 33] * k0s[3]); o.z = pk2(s[4 * 33] * k1s[0], s[5 * 33] * k1s[1]); o.w = pk2(s[6 * 33] * k1s[2], s[7 * 33] * k1s[3]);
        *(v4u*)(WT + (size_t)(d0 + n) * ldw + k0 + 8 * c) = o; }
    asm volatile("s_waitcnt lgkmcnt(0)" ::: "memory");
}
__device__ __forceinline__ void transpose_all(const float* W, int K, int N, bf16* WT, LAS float* scr, int gw, int ngw, int lane, int ldw) {
    const int nitems = (K / 64) * (N / 32);
    for (int it = gw; it < nitems; it += ngw) transpose_item(W, K, N, WT, scr, it, lane, 0, ldw);
}

namespace pg8 {
typedef short bf16x8 __attribute__((ext_vector_type(8)));
typedef unsigned u32x4 __attribute__((ext_vector_type(4)));
constexpr int BM = 256, BK = 64, HALF = 128, HTB = HALF * BK * 2, STAGE_BYTES = 8 * HTB, NXCD = 8, WGM = 8;
__host__ __device__ __forceinline__ int lds_byte(int r, int c) { const int st = (r >> 4) * 2 + (c >> 5), rr = r & 15, cc = c & 31, ob = rr * 64 + cc * 2; return st * 1024 + (ob ^ (((ob >> 9) & 1) << 5)); }
__host__ __device__ __forceinline__ void stage_rc(int b, int& R, int& C) { const int st = b / 1024, sb = b % 1024, swz = sb ^ (((sb >> 9) & 1) << 5); R = (st >> 1) * 16 + swz / 64; C = (st & 1) * 32 + (swz % 64) / 2; }
__host__ __device__ __forceinline__ int perm32(int rho) { const int n = rho >> 4, i = rho & 15; return 8 * (i >> 2) + 4 * n + (i & 3); }
struct Unit { int pm, pn; const char* a; const char* b; int e, r0, cnt, row0; };
typedef __bf16 bfv2_t __attribute__((ext_vector_type(2))); typedef float fv2_t __attribute__((ext_vector_type(2)));
__device__ __forceinline__ unsigned cvt_pk_bf16(float lo, float hi) { fv2_t v; v.x = lo; v.y = hi; return __builtin_bit_cast(unsigned, __builtin_convertvector(v, bfv2_t)); }

struct StaticOrder {
    int nM, nN, nwg, G, c, lo, hi; const char* A; const char* Bt; size_t tstepA, tstepB;
    __device__ __forceinline__ void init(const bf16* A_, const bf16* Bt_, int M, int N, int lda, int ldb, int G_, int c_) { nM = M / BM; nN = N / BM; nwg = nM * nN; G = G_; c = c_; lo = 0; hi = nwg; A = (const char*)A_; Bt = (const char*)Bt_; tstepA = (size_t)BM * lda * 2; tstepB = (size_t)BM * ldb * 2; pace = nullptr; }
    __device__ __forceinline__ bool next(int i, Unit& u) const {
        const long L = (long)lo + (long)i * G + c; if (L >= hi) return false;
        int wgid = (int)L; { const int q = nwg / NXCD, r = nwg % NXCD, xcd = wgid % NXCD, off = wgid / NXCD; wgid = (xcd < r ? xcd * (q + 1) : r * (q + 1) + (xcd - r) * q) + off; }
        const int nig = WGM * nN, gid = wgid / nig, fm = gid * WGM, gsz = (nM - fm) < WGM ? (nM - fm) : WGM;
        u.pm = fm + ((wgid % nig) % gsz); u.pn = (wgid % nig) / gsz; u.a = A + (size_t)u.pm * tstepA; u.b = Bt + (size_t)u.pn * tstepB; u.e = 0; u.r0 = 0; u.cnt = 0; u.row0 = 0; return true;
    }
    __device__ __forceinline__ unsigned row_off(const Unit&, int) const { return 0u; }
    unsigned* pace;
    __device__ __forceinline__ void pace_arrive_wait(int ui, int wid, int lane) const {
        if (pace == nullptr || wid != 0) return;
        unsigned* p = pace + 64 * (c & 7);
        if (lane == 0) __hip_atomic_fetch_add(p, 1u, __ATOMIC_RELAXED, __HIP_MEMORY_SCOPE_AGENT);
        const unsigned want = (unsigned)(G >> 3) * (unsigned)(ui + 1);
        for (int sp = 0; sp < 4096; ++sp) { if (__hip_atomic_load(p, __ATOMIC_RELAXED, __HIP_MEMORY_SCOPE_AGENT) >= want) break; __builtin_amdgcn_s_sleep(2); }
    }
    __device__ __forceinline__ void pace_finish(int units_done, int wid, int lane) const {
        if (pace == nullptr || wid != 0 || lane != 0) return;
        const int rmax = (nwg + G - 1) / G;
        if (units_done < rmax) __hip_atomic_fetch_add(pace + 64 * (c & 7), (unsigned)(rmax - units_done), __ATOMIC_RELAXED, __HIP_MEMORY_SCOPE_AGENT);
    }
};

struct PairOrder {
    StaticOrder s0; const char* A1; const char* B1;
    __device__ __forceinline__ bool next(int i, Unit& u) const {
        if (!s0.next(i >> 1, u)) return false;
        if (i & 1) { u.a = A1 + (size_t)u.pm * s0.tstepA; u.b = B1 + (size_t)u.pn * s0.tstepB; u.e = 1; }
        return true;
    }
    __device__ __forceinline__ unsigned row_off(const Unit&, int) const { return 0u; }
    __device__ __forceinline__ void pace_arrive_wait(int, int, int) const {}
    __device__ __forceinline__ void pace_finish(int, int, int) const {}
};

template <class Epi, class Sched, bool ALIGN_EPI, bool GATHER>
__device__ __forceinline__ void gemm_phase(LAS unsigned char* lds, const int K, const int lda, const int ldb, const Sched& S, const Epi& E, const int tid) {
    const int wid = __builtin_amdgcn_readfirstlane(tid >> 6), lane = tid & 63, wr = wid >> 2, wc = wid & 3, fr = lane & 15, fq = lane >> 4;
    const int nt = K / BK;
    int Rr[2], Cc[2];
    unsigned voffA[2][2], voffB[2][2], voffAn[2][2];
#pragma unroll
    for (int i = 0; i < 2; ++i) { stage_rc(tid * 16 + i * 8192, Rr[i], Cc[i]);
#pragma unroll
        for (int h = 0; h < 2; ++h) { const int Rb = Epi::PERM ? (64 * (Rr[i] >> 5) + 32 * h + perm32(Rr[i] & 31)) : h * HALF + Rr[i];
            voffB[h][i] = (unsigned)(Rb * ldb + Cc[i]) * 2u; voffA[h][i] = (unsigned)((h * HALF + Rr[i]) * lda + Cc[i]) * 2u; voffAn[h][i] = voffA[h][i]; } }
    const size_t kstep = (size_t)(BK * 2);
    const unsigned ldsw = (unsigned)wid * 1024u;
    const int aoff = lds_byte(wr * 64 + fr, fq * 8), boff = lds_byte(wc * 32 + fr, fq * 8);
#define PG8_SA(b, h) (((b) * 2 + (h)) * HTB)
#define PG8_SB(b, h) ((4 + (b) * 2 + (h)) * HTB)
#define PG8_STAGE(bufoff, gbase, voff) do { const char* _gb = (const char*)(gbase); asm volatile("" : "+s"(_gb));     \
        _Pragma("unroll") for (int _i = 0; _i < 2; ++_i) \
        __builtin_amdgcn_global_load_lds((const unsigned*)(_gb + (voff)[_i]), (LAS unsigned*)(lds + (bufoff) + ldsw + _i * 8192), 16, 0, 0); } while (0)
#define PG8_LDA(dst, b, h) do { _Pragma("unroll") for (int m = 0; m < 4; ++m) _Pragma("unroll") for (int k = 0; k < 2; ++k) dst[m][k] = *(const LAS bf16x8*)(lds + PG8_SA(b, h) + aoff + m * 2048 + k * 1024); } while (0)
#define PG8_LDB(dst, b, h) do { _Pragma("unroll") for (int n = 0; n < 2; ++n) _Pragma("unroll") for (int k = 0; k < 2; ++k) dst[n][k] = *(const LAS bf16x8*)(lds + PG8_SB(b, h) + boff + n * 2048 + k * 1024); } while (0)
#define PG8_MMA(ai, bj, At, Bt) do { __builtin_amdgcn_s_setprio(1); _Pragma("unroll") for (int m = 0; m < 4; ++m) _Pragma("unroll") for (int n = 0; n < 2; ++n) _Pragma("unroll") for (int k = 0; k < 2; ++k) \
        acc[ai][bj][m][n] = __builtin_amdgcn_mfma_f32_16x16x32_bf16(Bt[n][k], At[m][k], acc[ai][bj][m][n], 0, 0, 0); __builtin_amdgcn_s_setprio(0); } while (0)
#define PG8_WAIT_V(n) asm volatile("s_waitcnt vmcnt(" #n ")" ::: "memory")
#define PG8_WAIT_L(n) asm volatile("s_waitcnt lgkmcnt(" #n ")" ::: "memory")
#define PG8_BAR __builtin_amdgcn_s_barrier()
#define PG8_SCHED __builtin_amdgcn_sched_barrier(0)
    Unit cur, nxt; int ui = 0;
    if (!S.next(0, cur)) return;
    if constexpr (GATHER) {
#pragma unroll
        for (int h = 0; h < 2; ++h)
#pragma unroll
            for (int i = 0; i < 2; ++i) voffA[h][i] = S.row_off(cur, h * HALF + Rr[i]) + (unsigned)Cc[i] * 2u;
    }
    f32x4 acc[2][2][4][2];
#pragma unroll
    for (int a = 0; a < 2; ++a)
#pragma unroll
        for (int b = 0; b < 2; ++b)
#pragma unroll
            for (int m = 0; m < 4; ++m)
#pragma unroll
                for (int n = 0; n < 2; ++n) acc[a][b][m][n] = (f32x4){0.f, 0.f, 0.f, 0.f};
    bf16x8 At[4][2], B0[2][2], B1[2][2];
    const char* cA = cur.a; const char* cB = cur.b;
    PG8_STAGE(PG8_SB(0, 0), cB, voffB[0]); PG8_STAGE(PG8_SB(0, 1), cB, voffB[1]); PG8_STAGE(PG8_SA(0, 0), cA, voffA[0]); PG8_STAGE(PG8_SA(0, 1), cA, voffA[1]);
    if (wr == 1) PG8_BAR;
    PG8_WAIT_V(2); PG8_BAR;
    PG8_STAGE(PG8_SB(1, 0), cB + kstep, voffB[0]); PG8_STAGE(PG8_SA(1, 0), cA + kstep, voffA[0]); PG8_STAGE(PG8_SB(1, 1), cB + kstep, voffB[1]);
    PG8_WAIT_V(6); PG8_BAR;
    for (;;) {
        const bool has_next = S.next(ui + 1, nxt);
        const char* nA = has_next ? nxt.a : cA; const char* nB = has_next ? nxt.b : cB;
        if constexpr (GATHER) {
#pragma unroll
            for (int h = 0; h < 2; ++h)
#pragma unroll
                for (int i = 0; i < 2; ++i) voffAn[h][i] = has_next ? S.row_off(nxt, h * HALF + Rr[i]) + (unsigned)Cc[i] * 2u : voffA[h][i];
        }
        for (int t = 0; t < nt; t += 2) {
            const bool last = (t == nt - 2);
            if (last) S.pace_arrive_wait(ui, wid, lane);
            const char* a1 = cA + (size_t)(t + 1) * kstep;
            const char* a2 = last ? nA : cA + (size_t)(t + 2) * kstep; const char* b2 = last ? nB : cB + (size_t)(t + 2) * kstep;
            const char* a3 = a2 + kstep; const char* b3 = b2 + kstep;
            PG8_LDB(B0, 0, 0); PG8_LDB(B1, 0, 1); PG8_SCHED; PG8_LDA(At, 0, 0); PG8_STAGE(PG8_SA(1, 1), a1, voffA[1]);
            if constexpr (GATHER) { if (last) {
#pragma unroll
                for (int h = 0; h < 2; ++h)
#pragma unroll
                    for (int i = 0; i < 2; ++i) voffA[h][i] = voffAn[h][i]; } }
            PG8_WAIT_V(8); PG8_WAIT_L(0); PG8_BAR; PG8_MMA(0, 0, At, B0); PG8_MMA(0, 1, At, B1); PG8_BAR; PG8_SCHED;
            PG8_LDA(At, 0, 1); PG8_STAGE(PG8_SB(0, 0), b2, voffB[0]); PG8_STAGE(PG8_SB(0, 1), b2, voffB[1]); PG8_STAGE(PG8_SA(0, 0), a2, voffA[0]);
            PG8_WAIT_V(8); PG8_WAIT_L(0); PG8_BAR; PG8_MMA(1, 0, At, B0); PG8_MMA(1, 1, At, B1); PG8_BAR; PG8_SCHED;
            PG8_LDB(B0, 1, 0); PG8_LDB(B1, 1, 1); PG8_SCHED; PG8_LDA(At, 1, 0); PG8_STAGE(PG8_SA(0, 1), a2, voffA[1]);
            PG8_WAIT_V(8); PG8_WAIT_L(0); PG8_BAR; PG8_MMA(0, 0, At, B0); PG8_MMA(0, 1, At, B1); PG8_BAR; PG8_SCHED;
            PG8_LDA(At, 1, 1); PG8_STAGE(PG8_SB(1, 0), b3, voffB[0]); PG8_STAGE(PG8_SB(1, 1), b3, voffB[1]); PG8_STAGE(PG8_SA(1, 0), a3, voffA[0]);
            PG8_WAIT_V(8); PG8_WAIT_L(0); PG8_BAR; PG8_MMA(1, 0, At, B0); PG8_MMA(1, 1, At, B1); PG8_BAR; PG8_SCHED;
        }
        if constexpr (ALIGN_EPI) { if (wr == 0) PG8_BAR; }
        E(acc, cur, wr, wc, fr, fq);
        if (!has_next) { S.pace_finish(ui + 1, wid, lane); break; }
#pragma unroll
        for (int a = 0; a < 2; ++a)
#pragma unroll
            for (int b = 0; b < 2; ++b)
#pragma unroll
                for (int m = 0; m < 4; ++m)
#pragma unroll
                    for (int n = 0; n < 2; ++n) acc[a][b][m][n] = (f32x4){0.f, 0.f, 0.f, 0.f};
        cur = nxt; cA = nA; cB = nB; ++ui;
        if constexpr (ALIGN_EPI) { if (wr == 1) PG8_BAR; }
    }
    PG8_WAIT_V(0);
    if constexpr (!ALIGN_EPI) { if (wr == 0) PG8_BAR; }
    PG8_BAR;
#undef PG8_SA
#undef PG8_SB
#undef PG8_STAGE
#undef PG8_LDA
#undef PG8_LDB
#undef PG8_MMA
#undef PG8_WAIT_V
#undef PG8_WAIT_L
#undef PG8_BAR
#undef PG8_SCHED
}

__device__ __forceinline__ void line_pair(const u32x4 v0, const u32x4 v1, const bool odd, u32x4& a, u32x4& b) {
#pragma unroll
    for (int j = 0; j < 4; ++j) { const unsigned x = odd ? v0[j] : v1[j]; const unsigned y = (unsigned)__builtin_amdgcn_update_dpp(0, (int)x, 0xB1, 0xf, 0xf, false);
        a[j] = odd ? y : v0[j]; b[j] = odd ? v1[j] : y; }
}
__device__ __forceinline__ float fsig(float x) { return __builtin_amdgcn_rcpf(1.f + fexp2(x * -LOG2E)); }
__device__ __forceinline__ u32x4 pack8(const f32x4 a, const f32x4 b) { u32x4 w; w.x = cvt_pk_bf16(a[0], a[1]); w.y = cvt_pk_bf16(a[2], a[3]); w.z = cvt_pk_bf16(b[0], b[1]); w.w = cvt_pk_bf16(b[2], b[3]); return w; }
__device__ __forceinline__ void unpack8(const u32x4 w, f32x4& a, f32x4& b) {
    a[0] = __uint_as_float(w.x << 16); a[1] = __uint_as_float(w.x & 0xffff0000u); a[2] = __uint_as_float(w.y << 16); a[3] = __uint_as_float(w.y & 0xffff0000u);
    b[0] = __uint_as_float(w.z << 16); b[1] = __uint_as_float(w.z & 0xffff0000u); b[2] = __uint_as_float(w.w << 16); b[3] = __uint_as_float(w.w & 0xffff0000u); }

__device__ __forceinline__ unsigned pack4u8(const f32x4 g) { return (unsigned)(g[0] * 255.f + 0.5f) | ((unsigned)(g[1] * 255.f + 0.5f) << 8) | ((unsigned)(g[2] * 255.f + 0.5f) << 16) | ((unsigned)(g[3] * 255.f + 0.5f) << 24); }
__device__ __forceinline__ f32x4 unpack4u8(const unsigned w) { f32x4 g; g[0] = (float)(w & 0xffu); g[1] = (float)((w >> 8) & 0xffu); g[2] = (float)((w >> 16) & 0xffu); g[3] = (float)(w >> 24); return g * (1.f / 255.f); }
template <int MODE>
__device__ __forceinline__ void epiz_body(const f32x4 (&acc)[2][2][4][2], bf16* base, const int ldc, const int row0, const int oc, const float* vec, const int img_off = 0, const bool odd = false) {
    f32x4 bv[2][2];
#pragma unroll
    for (int bj = 0; bj < 2; ++bj)
#pragma unroll
        for (int n = 0; n < 2; ++n) bv[bj][n] = (MODE == 0 || MODE == 1 || MODE == 3) ? *(const f32x4*)(vec + bj * 32 + 4 * n) : (f32x4){0.f, 0.f, 0.f, 0.f};
#pragma unroll
    for (int ai = 0; ai < 2; ++ai)
#pragma unroll
        for (int m = 0; m < 4; ++m) { bf16* rowp = base + (size_t)(row0 + ai * HALF + m * 16) * ldc + oc; u32x4 pk[2], gb;
#pragma unroll
            for (int bj = 0; bj < 2; ++bj) { f32x4 v[2];
#pragma unroll
                for (int n = 0; n < 2; ++n) { f32x4 x = acc[ai][bj][m][n];
                    if (MODE == 0) x = (x + bv[bj][n]) * (0.125f * LOG2E);
                    else if (MODE == 1) x = x + bv[bj][n];
                    else if (MODE == 2) {
#pragma unroll
                        for (int j = 0; j < 4; ++j) x[j] = x[j] * fsig(x[j]); }
                    else if (MODE == 3) {
#pragma unroll
                        for (int j = 0; j < 4; ++j) { const float l = bv[bj][n][j]; x[j] = flog2(l + (1.f - l) * fsig(x[j])); } }
                    else if (MODE == 6) {
#pragma unroll
                        for (int j = 0; j < 4; ++j) x[j] = fsig(x[j]); }
                    v[n] = x; }
                if (MODE == 6) { gb[bj * 2] = pack4u8(v[0]); gb[bj * 2 + 1] = pack4u8(v[1]); }
                else pk[bj] = pack8(v[0], v[1]); }
            if (MODE == 6) *(u32x4*)((unsigned char*)base + (ai * 4 + m) * 8192 + img_off) = gb;
            if (MODE != 6) { u32x4 a, b; line_pair(pk[0], pk[1], odd, a, b); *(u32x4*)rowp = a; *(u32x4*)(rowp + ldc) = b; } }
}
struct EpiZ {
    static constexpr bool PERM = true;
    const float* bqkv; const float* lb; bf16* Q; bf16* KV; bf16* HG; bf16* GT;
    __device__ __forceinline__ void operator()(const f32x4 (&acc)[2][2][4][2], const Unit& u, int wr, int wc, int fr, int fq) const {
        const bool odd = fr & 1; const int row0 = u.pm * BM + wr * 64 + (fr & ~1), cb = u.pn * BM + wc * 64 + 8 * fq, cl = cb + (odd ? 32 : 0);
        if (u.pn < 4) epiz_body<0>(acc, Q, QW, row0, cl, bqkv + cb, 0, odd);
        else if (u.pn == 4) epiz_body<1>(acc, KV, 256, row0, cl - QW, bqkv + cb, 0, odd);
        else if (u.pn < 21) { const int ct = (u.pn - 5) * 256 + (wc >> 1) * 128; bf16* hb = HG + (size_t)((ct >> 10) * 8 + ((ct >> 7) & 7)) * HGPS; const int oc = (wc & 1) * 64 + 8 * fq + (odd ? 32 : 0);
            if (u.pn < 9) epiz_body<2>(acc, hb, 128, row0, oc, nullptr, 0, odd);
            else if (u.pn < 13) epiz_body<3>(acc, hb, 128, row0, oc, lb + ((cb - QKVW) & 1023), 0, odd);
            else if (u.pn < 17) epiz_body<4>(acc, hb, 128, row0, oc, nullptr, 0, odd);
            else epiz_body<2>(acc, hb, 128, row0, oc, nullptr, 0, odd); }
        else epiz_body<6>(acc, (bf16*)((unsigned char*)GT + (size_t)(u.pm * 16 + (u.pn - 21)) * 65536), 0, 0, 0, nullptr, (wr * 4 + wc) * 1024 + (fq * 16 + fr) * 16);
    }
};
struct EpiMix {
    static constexpr bool PERM = true;
    const bf16* GT; bf16* MIX; unsigned char* PART;
    template <bool SECOND>
    __device__ __forceinline__ void body(const f32x4 (&acc)[2][2][4][2], const int row0, const int cl, const bool odd, const unsigned char* gimg, unsigned char* pimg) const {
#pragma unroll
        for (int ai = 0; ai < 2; ++ai)
#pragma unroll
        for (int mh = 0; mh < 2; ++mh) {
            u32x4 g[2], o[2][2];
#pragma unroll
            for (int m2 = 0; m2 < 2; ++m2) {
                g[m2] = __builtin_nontemporal_load((const u32x4*)(gimg + (ai * 4 + 2 * mh + m2) * 8192));
#pragma unroll
                for (int bj = 0; bj < 2; ++bj) {
                    if (SECOND) o[m2][bj] = *(const u32x4*)(pimg + ((ai * 4 + 2 * mh + m2) * 2 + bj) * 8192); } }
#pragma unroll
            for (int m2 = 0; m2 < 2; ++m2) { const int m = 2 * mh + m2; u32x4 pk[2];
#pragma unroll
                for (int bj = 0; bj < 2; ++bj) {
                    const f32x4 g0 = unpack4u8(g[m2][bj * 2]), g1 = unpack4u8(g[m2][bj * 2 + 1]);
                    f32x4 v0 = acc[ai][bj][m][0] * g0, v1 = acc[ai][bj][m][1] * g1;
                    if (SECOND) { f32x4 o0, o1; unpack8(o[m2][bj], o0, o1); v0 += o0; v1 += o1; }
                    if (SECOND) pk[bj] = pack8(v0, v1); else *(u32x4*)(pimg + ((ai * 4 + m) * 2 + bj) * 8192) = pack8(v0, v1); }
                if (SECOND) { u32x4 a, b; line_pair(pk[0], pk[1], odd, a, b); bf16* rp = MIX + (size_t)(row0 + ai * HALF + m * 16) * D + cl; *(u32x4*)rp = a; *(u32x4*)(rp + D) = b; } }
        }
    }
    __device__ __forceinline__ void operator()(const f32x4 (&acc)[2][2][4][2], const Unit& u, int wr, int wc, int fr, int fq) const {
        const bool odd = fr & 1; const int row0 = u.pm * BM + wr * 64 + (fr & ~1), cl = u.pn * BM + wc * 64 + 8 * fq + (odd ? 32 : 0);
        const unsigned char* gimg = (const unsigned char*)GT + (size_t)(u.pm * 16 + (u.e ? 8 : 0) + u.pn) * 65536 + (wr * 4 + wc) * 1024 + (fq * 16 + fr) * 16;
        unsigned char* pimg = PART + (wr * 4 + wc) * 1024 + (fq * 16 + fr) * 16;
        if (u.e) body<true>(acc, row0, cl, odd, gimg, pimg); else body<false>(acc, row0, cl, odd, gimg, pimg);
    }
};
__device__ __forceinline__ void ss_slot(float s, float* SS, int row, int slot, int fq) {
    s += __shfl_xor(s, 16); s += __shfl_xor(s, 32);
    if (fq == 0) SS[(size_t)row * 32 + slot] = s;
}
struct EpiDelta {
    static constexpr bool PERM = true;
    bf16* DL;
    __device__ __forceinline__ void operator()(const f32x4 (&acc)[2][2][4][2], const Unit& u, int wr, int wc, int fr, int fq) const {
        unsigned char* dimg = (unsigned char*)DL + (size_t)(u.pm * 8 + u.pn) * 131072 + (wr * 4 + wc) * 1024 + (fq * 16 + fr) * 16;
#pragma unroll
        for (int ai = 0; ai < 2; ++ai)
#pragma unroll
            for (int m = 0; m < 4; ++m)
#pragma unroll
                for (int bj = 0; bj < 2; ++bj) *(u32x4*)(dimg + ((ai * 4 + m) * 2 + bj) * 8192) = pack8(acc[ai][bj][m][0], acc[ai][bj][m][1]);
    }
};
struct EpiPleRaw {
    static constexpr bool PERM = true;
    bf16* PL; float* SS;
    __device__ __forceinline__ void operator()(const f32x4 (&acc)[2][2][4][2], const Unit& u, int wr, int wc, int fr, int fq) const {
        const int row0 = u.pm * BM + wr * 64 + fr;
        unsigned char* pimg = (unsigned char*)PL + (size_t)(u.pm * 8 + u.pn) * 131072 + (wr * 4 + wc) * 1024 + (fq * 16 + fr) * 16;
#pragma unroll
        for (int ai = 0; ai < 2; ++ai)
#pragma unroll
            for (int m = 0; m < 4; ++m) { const int row = row0 + ai * HALF + m * 16; float s = 0.f;
#pragma unroll
                for (int bj = 0; bj < 2; ++bj) { const f32x4 a = acc[ai][bj][m][0], b = acc[ai][bj][m][1];
                    s += ((a[0] * a[0] + a[1] * a[1]) + (a[2] * a[2] + a[3] * a[3])) + ((b[0] * b[0] + b[1] * b[1]) + (b[2] * b[2] + b[3] * b[3]));
                    *(u32x4*)(pimg + ((ai * 4 + m) * 2 + bj) * 8192) = pack8(a, b); }
                ss_slot(s, SS, row, u.pn * 4 + wc, fq); }
    }
};
struct EpiPleGate {
    static constexpr bool PERM = true;
    bf16* UPD; const bf16* PL; const float* rstd3; const float* rstdp; const float* gple;
    __device__ __forceinline__ void operator()(const f32x4 (&acc)[2][2][4][2], const Unit& u, int wr, int wc, int fr, int fq) const {
        const bool odd = fr & 1; const int row0 = u.pm * BM + wr * 64 + fr, cb = u.pn * BM + wc * 64 + 8 * fq, cl = cb + (odd ? 32 : 0);
        const unsigned char* pimg = (const unsigned char*)PL + (size_t)(u.pm * 8 + u.pn) * 131072 + (wr * 4 + wc) * 1024 + (fq * 16 + fr) * 16;
        f32x4 gp[2][2];
#pragma unroll
        for (int bj = 0; bj < 2; ++bj)
#pragma unroll
            for (int n = 0; n < 2; ++n) gp[bj][n] = *(const f32x4*)(gple + cb + bj * 32 + 4 * n);
#pragma unroll
        for (int ai = 0; ai < 2; ++ai) {
            u32x4 pp[4][2]; float r3[4], rp[4];
#pragma unroll
            for (int m = 0; m < 4; ++m) { const int row = row0 + ai * HALF + m * 16; r3[m] = rstd3[row]; rp[m] = rstdp[row];
#pragma unroll
                for (int bj = 0; bj < 2; ++bj) pp[m][bj] = __builtin_nontemporal_load((const u32x4*)(pimg + ((ai * 4 + m) * 2 + bj) * 8192)); }
#pragma unroll
            for (int m = 0; m < 4; ++m) { const int row = (row0 & ~1) + ai * HALF + m * 16; u32x4 pk[2];
#pragma unroll
                for (int bj = 0; bj < 2; ++bj) {
                    f32x4 p0, p1; unpack8(pp[m][bj], p0, p1);
                    f32x4 g0 = acc[ai][bj][m][0] * r3[m], g1 = acc[ai][bj][m][1] * r3[m];
#pragma unroll
                    for (int j = 0; j < 4; ++j) { g0[j] = fsig(g0[j]); g1[j] = fsig(g1[j]); }
                    pk[bj] = pack8(p0 * rp[m] * gp[bj][0] * g0, p1 * rp[m] * gp[bj][1] * g1); }
                u32x4 a, b; line_pair(pk[0], pk[1], odd, a, b); bf16* up = UPD + (size_t)row * D + cl; *(u32x4*)up = a; *(u32x4*)(up + D) = b; }
        }
    }
};

struct MoeOrder {
    const LAS int* eoff; const LAS int* ecnt; int NT, G, c, total_rb; const char* A; const char* W; size_t wexp, tstepB, arow_bytes; const unsigned short* LIST; int gather;
    __device__ __forceinline__ bool next(int i, Unit& u) const {
        const int it = i * G + c; if (it >= total_rb * NT) return false;
        const int rb = it / NT, pn = it % NT, row0 = rb * BM;
        int e = 0; { int hi = NEXP;
#pragma unroll
            for (int st = 0; st < 6; ++st) { const int mid = (e + hi) >> 1; if (eoff[mid] <= row0) e = mid; else hi = mid; } }
        e = __builtin_amdgcn_readfirstlane(e);
        u.pm = rb; u.pn = pn; u.e = e; u.r0 = __builtin_amdgcn_readfirstlane(row0 - eoff[e]); u.cnt = __builtin_amdgcn_readfirstlane(ecnt[e]); u.row0 = row0;
        u.a = gather ? A : A + (size_t)row0 * arow_bytes; u.b = W + (size_t)e * wexp + (size_t)pn * tstepB; return true;
    }
    __device__ __forceinline__ void pace_arrive_wait(int, int, int) const {}
    __device__ __forceinline__ void pace_finish(int, int, int) const {}
    __device__ __forceinline__ unsigned row_off(const Unit& u, int row) const {
        const unsigned short* lp = LIST + (size_t)u.e * NTOK + u.r0;
        const unsigned tok = (row < u.cnt - u.r0) ? (unsigned)(lp[row] & 0x7fffu) : 0u; return tok * (unsigned)arow_bytes;
    }
};
struct EpiGateUp {
    static constexpr bool PERM = true;
    bf16* HID; const unsigned short* LIST; const float* RSTD2;
    __device__ __forceinline__ void operator()(const f32x4 (&acc)[2][2][4][2], const Unit& u, int wr, int wc, int fr, int fq) const {
        const int row0 = u.row0 + wr * 64 + fr, cb = u.pn * HALF + wc * 32 + 8 * fq;
        const unsigned short* lp = LIST + (size_t)u.e * NTOK + u.r0;
        unsigned tk[2][4]; float rs[2][4];
#pragma unroll
        for (int ai = 0; ai < 2; ++ai)
#pragma unroll
            for (int m = 0; m < 4; ++m) { const int lr = ai * HALF + wr * 64 + m * 16 + fr; tk[ai][m] = (lr < u.cnt - u.r0) ? (unsigned)(lp[lr] & 0x7fffu) : 0u; }
#pragma unroll
        for (int ai = 0; ai < 2; ++ai)
#pragma unroll
            for (int m = 0; m < 4; ++m) rs[ai][m] = RSTD2[tk[ai][m]];
#pragma unroll
        for (int ai = 0; ai < 2; ++ai)
#pragma unroll
            for (int m = 0; m < 4; ++m) { f32x4 v[2];
#pragma unroll
                for (int n = 0; n < 2; ++n) { const f32x4 g = acc[ai][0][m][n] * rs[ai][m], up = acc[ai][1][m][n] * rs[ai][m];
#pragma unroll
                    for (int j = 0; j < 4; ++j) v[n][j] = g[j] * fsig(g[j]) * up[j]; }
                *(u32x4*)(HID + (size_t)(row0 + ai * HALF + m * 16) * MH + cb) = pack8(v[0], v[1]); }
    }
};
struct EpiDown {
    static constexpr bool PERM = true;
    const unsigned short* LIST; const float* TW; bf16* Y;
    __device__ __forceinline__ void operator()(const f32x4 (&acc)[2][2][4][2], const Unit& u, int wr, int wc, int fr, int fq) const {
        const bool odd = fr & 1; const int cl = u.pn * BM + wc * 64 + 8 * fq + (odd ? 32 : 0);
        const unsigned short* lp = LIST + (size_t)u.e * NTOK + u.r0;
        unsigned entE[2][4], entO[2][4]; float w[2][4];
#pragma unroll
        for (int ai = 0; ai < 2; ++ai)
#pragma unroll
            for (int m = 0; m < 4; ++m) { const int lr = ai * HALF + wr * 64 + m * 16 + (fr & ~1), nv = u.cnt - u.r0;
                entE[ai][m] = (lr < nv) ? (unsigned)lp[lr] : 0x10000u; entO[ai][m] = (lr + 1 < nv) ? (unsigned)lp[lr + 1] : 0x10000u; }
#pragma unroll
        for (int ai = 0; ai < 2; ++ai)
#pragma unroll
            for (int m = 0; m < 4; ++m) { const unsigned a = entE[ai][m], b = entO[ai][m], eo = odd ? b : a; w[ai][m] = TW[(eo & 0x7fffu) * 2 + ((eo >> 15) & 1u)]; }
#pragma unroll
        for (int ai = 0; ai < 2; ++ai)
#pragma unroll
            for (int m = 0; m < 4; ++m) { u32x4 a, b;
                line_pair(pack8(acc[ai][0][m][0] * w[ai][m], acc[ai][0][m][1] * w[ai][m]), pack8(acc[ai][1][m][0] * w[ai][m], acc[ai][1][m][1] * w[ai][m]), odd, a, b);
#pragma unroll
                for (int o = 0; o < 2; ++o) { const unsigned e = o ? entO[ai][m] : entE[ai][m]; if (!(e & 0x10000u)) { const unsigned tok = e & 0x7fffu, k = (e >> 15) & 1u;
                    *(u32x4*)(Y + (size_t)k * NTOK * D + (size_t)tok * D + cl) = o ? b : a; } } }
    }
};
}

namespace hg {
typedef short s16x4 __attribute__((ext_vector_type(4)));
typedef short bf16x8 __attribute__((ext_vector_type(8)));
typedef __bf16 bfv2 __attribute__((ext_vector_type(2)));
typedef float fv2 __attribute__((ext_vector_type(2)));
constexpr int RS = 272, IMG = 64 * RS;
constexpr int L_QI = 0, L_QR = IMG, L_KR = 2 * IMG, L_KL = 3 * IMG, L_V = 4 * IMG;
constexpr int L_SEG = 5 * IMG, L_D = L_SEG + 4096, L_RED = L_D + 512, L_RSTD = L_RED + 2048, L_END = L_RSTD + 256;
__device__ __forceinline__ unsigned cvtpk(float lo, float hi) { fv2 v; v.x = lo; v.y = hi; return __builtin_bit_cast(unsigned, __builtin_convertvector(v, bfv2)); }
__device__ __forceinline__ float blo(unsigned u) { return __uint_as_float(u << 16); }
__device__ __forceinline__ float bhi(unsigned u) { return __uint_as_float(u & 0xffff0000u); }
__device__ __forceinline__ bf16x8 frag_from2(const f32x4 a, const f32x4 b) { v4u w; w.x = cvtpk(a[0], a[1]); w.y = cvtpk(a[2], a[3]); w.z = cvtpk(b[0], b[1]); w.w = cvtpk(b[2], b[3]); return __builtin_bit_cast(bf16x8, w); }
__device__ __forceinline__ bf16x8 frag_tr2(LAS unsigned char* p0, LAS unsigned char* p1) {
    const s16x4 lo = __builtin_amdgcn_ds_read_tr16_b64_v4i16((LAS s16x4*)p0), hi = __builtin_amdgcn_ds_read_tr16_b64_v4i16((LAS s16x4*)p1);
    return __builtin_shufflevector(lo, hi, 0, 1, 2, 3, 4, 5, 6, 7); }
__device__ __forceinline__ bf16x8 frag_2x8(LAS unsigned char* p0, LAS unsigned char* p1) { v4u w; const v2u a = *(const LAS v2u*)p0, b = *(const LAS v2u*)p1; w.x = a.x; w.y = a.y; w.z = b.x; w.w = b.y; return __builtin_bit_cast(bf16x8, w); }
__device__ __forceinline__ float row_sum16(float s) {
    s += __int_as_float(__builtin_amdgcn_update_dpp(0, __float_as_int(s), 0x128, 0xf, 0xf, false));
    s += __int_as_float(__builtin_amdgcn_update_dpp(0, __float_as_int(s), 0x124, 0xf, 0xf, false));
    s += __int_as_float(__builtin_amdgcn_update_dpp(0, __float_as_int(s), 0x122, 0xf, 0xf, false));
    s += __int_as_float(__builtin_amdgcn_update_dpp(0, __float_as_int(s), 0x121, 0xf, 0xf, false));
    return s; }
#define HG_MFMA(a, b, c) __builtin_amdgcn_mfma_f32_16x16x32_bf16((a), (b), (c), 0, 0, 0)

template <bool P1>
__device__ __forceinline__ void unit(LAS unsigned char* lds, const bf16* HG, bf16* OREC, float* UST, float* DST, const float* ghg, const int u, const int tid) {
    const int lane = tid & 63, w = __builtin_amdgcn_readfirstlane(tid >> 6), r = lane & 15, q = lane >> 4;
    const int bh = u >> 5, j = u & 31, b = bh >> 3, h = bh & 7;
    const size_t row0 = (size_t)b * SEQ + (size_t)j * 512;
    f32x4 Sacc[8];
    float* ust = UST + (size_t)u * 16384 + (size_t)w * 2048 + lane;
#pragma unroll
    for (int kt = 0; kt < 8; ++kt)
#pragma unroll
        for (int rg = 0; rg < 4; ++rg) Sacc[kt][rg] = P1 ? 0.f : ust[(kt * 4 + rg) * 64];
    fv2 btot; btot.x = 0.f; btot.y = 0.f;
    unsigned gq[8], gg[8]; v4u rv[2], rgr[2];
#define HG_LOAD_RAW(c) do { const bf16* gp_ = HG + (size_t)h * HGPS + (row0 + (size_t)(c) * 64 + 8 * w) * 128 + 2 * lane; \
        _Pragma("unroll") for (int i = 0; i < 8; ++i) { if (!P1) { gq[i] = __builtin_nontemporal_load((const unsigned*)(gp_ + (size_t)i * 128)); gg[i] = __builtin_nontemporal_load((const unsigned*)(gp_ + (size_t)i * 128 + 8 * HGPS)); } else gg[i] = *(const unsigned*)(gp_ + (size_t)i * 128 + 8 * HGPS); } \
        _Pragma("unroll") for (int i = 0; i < 2; ++i) { const int ci_ = tid + 512 * i; const bf16* vp_ = HG + (size_t)h * HGPS + (row0 + (size_t)(c) * 64 + (ci_ >> 4)) * 128 + (ci_ & 15) * 8; \
            if (!P1) { rv[i] = __builtin_nontemporal_load((const v4u*)(vp_ + 16 * HGPS)); rgr[i] = __builtin_nontemporal_load((const v4u*)(vp_ + 24 * HGPS)); } else rv[i] = *(const v4u*)(vp_ + 16 * HGPS); } } while (0)
    HG_LOAD_RAW(0);
#pragma unroll 1
    for (int c = 0; c < 8; ++c) {
        const size_t rowc = row0 + (size_t)c * 64;
#pragma unroll
        for (int i = 0; i < 2; ++i) { const int ci = tid + 512 * i; *(LAS v4u*)(lds + L_V + (ci >> 4) * RS + (ci & 15) * 16) = rv[i]; }
        float c0[8], c1[8]; { float r0 = 0.f, r1 = 0.f;
#pragma unroll
            for (int i = 0; i < 8; ++i) { r0 += blo(gg[i]); r1 += bhi(gg[i]); c0[i] = r0; c1[i] = r1; }
            fv2 sv; sv.x = r0; sv.y = r1; *(LAS fv2*)(lds + L_SEG + (w * 128 + 2 * lane) * 4) = sv; }
        v4u grk[2];
        if (!P1) { grk[0] = rgr[0]; grk[1] = rgr[1]; }
        __syncthreads();
        float off0 = 0.f, off1 = 0.f, ref0 = 0.f, ref1 = 0.f, tot0 = 0.f, tot1 = 0.f;
#pragma unroll
        for (int s = 0; s < 8; ++s) { const fv2 sv = *(const LAS fv2*)(lds + L_SEG + (s * 128 + 2 * lane) * 4);
            if (s < w) { off0 += sv.x; off1 += sv.y; } if (s < 4) { ref0 += sv.x; ref1 += sv.y; } tot0 += sv.x; tot1 += sv.y; }
        if (w == 0) { fv2 dv; dv.x = fexp2(tot0); dv.y = fexp2(tot1); *(LAS fv2*)(lds + L_D + 2 * lane * 4) = dv; btot.x += tot0; btot.y += tot1; }
#pragma unroll
        for (int i = 0; i < 8; ++i) {
            const int t = 8 * w + i; const float b0 = off0 + c0[i], b1 = off1 + c1[i];
            const float k0 = 1.f - fexp2(blo(gg[i])), k1 = 1.f - fexp2(bhi(gg[i]));
            *(LAS unsigned*)(lds + L_KL + t * RS + 4 * lane) = cvtpk(k0 * fexp2(tot0 - b0), k1 * fexp2(tot1 - b1));
            if (!P1) { const float q0 = blo(gq[i]), q1 = bhi(gq[i]);
                *(LAS unsigned*)(lds + L_QI + t * RS + 4 * lane) = cvtpk(q0 * fexp2(b0), q1 * fexp2(b1));
                *(LAS unsigned*)(lds + L_QR + t * RS + 4 * lane) = cvtpk(q0 * fexp2(b0 - ref0), q1 * fexp2(b1 - ref1));
                *(LAS unsigned*)(lds + L_KR + t * RS + 4 * lane) = cvtpk(k0 * fexp2(ref0 - b0), k1 * fexp2(ref1 - b1)); }
        }
        __syncthreads();
        if (c + 1 < 8) HG_LOAD_RAW(c + 1);
        bf16x8 Vf[2];
#pragma unroll
        for (int cp = 0; cp < 2; ++cp) { LAS unsigned char* p0 = lds + L_V + (32 * cp + 4 * q + (r >> 2)) * RS + (16 * w + 4 * (r & 3)) * 2; Vf[cp] = frag_tr2(p0, p0 + 16 * RS); }
        f32x4 Oacc[4];
        if (!P1) {
#pragma unroll
            for (int ti = 0; ti < 4; ++ti) Oacc[ti] = (f32x4){0.f, 0.f, 0.f, 0.f};
#pragma unroll
            for (int cc = 0; cc < 4; ++cc) { const bf16x8 Sf = frag_from2(Sacc[2 * cc], Sacc[2 * cc + 1]);
#pragma unroll
                for (int ti = 0; ti < 4; ++ti) { LAS unsigned char* p = lds + L_QI + (16 * ti + r) * RS + 64 * cc + 8 * q; Oacc[ti] = HG_MFMA(frag_2x8(p, p + 32), Sf, Oacc[ti]); } }
#pragma unroll
            for (int ti = 0; ti < 4; ++ti) {
                f32x4 AT[4];
#pragma unroll
                for (int si = 0; si < 4; ++si) { AT[si] = (f32x4){0.f, 0.f, 0.f, 0.f};
                    if (si <= ti) {
#pragma unroll
                        for (int cc = 0; cc < 4; ++cc) { const bf16x8 A = *(const LAS bf16x8*)(lds + L_KR + (16 * si + r) * RS + 64 * cc + 16 * q); const bf16x8 B = *(const LAS bf16x8*)(lds + L_QR + (16 * ti + r) * RS + 64 * cc + 16 * q);
                            AT[si] = HG_MFMA(A, B, AT[si]); }
                        if (si == ti) {
#pragma unroll
                            for (int rg = 0; rg < 4; ++rg) if (4 * q + rg > r) AT[si][rg] = 0.f; }
                    } }
#pragma unroll
                for (int cp = 0; cp < 2; ++cp) if (cp <= (ti >> 1)) Oacc[ti] = HG_MFMA(frag_from2(AT[2 * cp], AT[2 * cp + 1]), Vf[cp], Oacc[ti]);
            }
        }
#pragma unroll
        for (int kt = 0; kt < 8; ++kt) { const f32x4 dv = *(const LAS f32x4*)(lds + L_D + (16 * kt + 4 * q) * 4); Sacc[kt] = Sacc[kt] * dv;
#pragma unroll
            for (int cp = 0; cp < 2; ++cp) { LAS unsigned char* p0 = lds + L_KL + (32 * cp + 4 * q + (r >> 2)) * RS + (16 * kt + 4 * (r & 3)) * 2; Sacc[kt] = HG_MFMA(frag_tr2(p0, p0 + 16 * RS), Vf[cp], Sacc[kt]); } }
        if (P1) { __syncthreads(); }
        else {
#pragma unroll
            for (int ti = 0; ti < 4; ++ti)
#pragma unroll
                for (int rg = 0; rg < 4; ++rg) { float s = Oacc[ti][rg] * Oacc[ti][rg];
                    s = row_sum16(s);
                    if (r == 0) *(LAS float*)(lds + L_RED + ((16 * ti + 4 * q + rg) * 8 + w) * 4) = s; }
            __syncthreads();
            if (tid < 64) { const f32x4 a = *(const LAS f32x4*)(lds + L_RED + tid * 32), bq = *(const LAS f32x4*)(lds + L_RED + tid * 32 + 16);
                *(LAS float*)(lds + L_RSTD + tid * 4) = rsqrtf((((a[0] + a[1]) + (a[2] + a[3])) + ((bq[0] + bq[1]) + (bq[2] + bq[3]))) * (1.f / 128.f) + EPS); }
            __syncthreads();
            { const float gv = ghg[16 * w + r];
#pragma unroll
                for (int ti = 0; ti < 4; ++ti) { const f32x4 rs = *(const LAS f32x4*)(lds + L_RSTD + (16 * ti + 4 * q) * 4);
#pragma unroll
                    for (int rg = 0; rg < 4; ++rg) *(LAS bf16*)(lds + L_QI + (16 * ti + 4 * q + rg) * RS + (16 * w + r) * 2) = (bf16)(cvtpk(Oacc[ti][rg] * rs[rg] * gv, 0.f) & 0xffffu); } }
            __syncthreads();
#pragma unroll
            for (int i = 0; i < 2; ++i) { const int ci = tid + 512 * i, row = ci >> 4, c16 = ci & 15;
                const v4u ov = *(const LAS v4u*)(lds + L_QI + row * RS + c16 * 16); const v4u gv = grk[i]; v4u o;
                o.x = cvtpk(blo(ov.x) * blo(gv.x), bhi(ov.x) * bhi(gv.x)); o.y = cvtpk(blo(ov.y) * blo(gv.y), bhi(ov.y) * bhi(gv.y));
                o.z = cvtpk(blo(ov.z) * blo(gv.z), bhi(ov.z) * bhi(gv.z)); o.w = cvtpk(blo(ov.w) * blo(gv.w), bhi(ov.w) * bhi(gv.w));
                *(v4u*)(OREC + (rowc + row) * HW + h * 128 + c16 * 8) = o; }
        }
    }
    if (P1) {
#pragma unroll
        for (int kt = 0; kt < 8; ++kt)
#pragma unroll
            for (int rg = 0; rg < 4; ++rg) ust[(kt * 4 + rg) * 64] = Sacc[kt][rg];
        if (w == 0) { fv2 dv; dv.x = fexp2(btot.x); dv.y = fexp2(btot.y); *(fv2*)(DST + (size_t)u * 128 + 2 * lane) = dv; }
    }
    __syncthreads();
#undef HG_LOAD_RAW
}
__device__ __forceinline__ void scan(float* UST, const float* DST, int gtid, int nthr) {
    for (int e = gtid; e < 16 * 16384; e += nthr) {
        const int bh = e >> 14, el = e & 16383, ln = el & 63, rg = (el >> 6) & 3, kt = (el >> 8) & 7, k = 16 * kt + 4 * (ln >> 4) + rg;
        float uu[32], dd[32];
        float* p0 = UST + (size_t)bh * 32 * 16384 + el; const float* d0 = DST + (size_t)bh * 32 * 128 + k;
#pragma unroll
        for (int j = 0; j < 32; ++j) { uu[j] = p0[(size_t)j * 16384]; dd[j] = d0[j * 128]; }
        float T = 0.f;
#pragma unroll
        for (int j = 0; j < 32; ++j) { p0[(size_t)j * 16384] = T; T = dd[j] * T + uu[j]; }
    }
}
}

namespace at {
typedef short bf16x8 __attribute__((ext_vector_type(8)));
constexpr int RSK = 144;
constexpr int L_K = 0, L_V = 272 * RSK, L_B = 2 * 272 * RSK, L_O = L_B + 4096, OW = 16 * RSK, L_END = L_O + 8 * OW;
__device__ __forceinline__ void item(LAS unsigned char* lds, bf16* QB, const bf16* KVB, const float* sinks, const float* rel, const int it, const int tid) {
    const int lane = tid & 63, w = __builtin_amdgcn_readfirstlane(tid >> 6), r = lane & 15, q = lane >> 4;
    const int kvh = it & 1, blk = (it >> 1) & 127, b = it >> 8, head = kvh * 8 + w;
    const size_t tok0 = (size_t)b * SEQ + (size_t)blk * 128;
    __syncthreads();
#pragma unroll
    for (int i = 0; i < 4; ++i) { const int ci = tid + 512 * i, row = ci >> 3, c8 = ci & 7; v4u kk = (v4u){0u, 0u, 0u, 0u}, vv = (v4u){0u, 0u, 0u, 0u};
        if (blk > 0 || row >= 128) { const bf16* p = KVB + (tok0 - 128 + row) * 256 + kvh * 64 + c8 * 8; kk = *(const v4u*)p; vv = *(const v4u*)(p + 128); }
        *(LAS v4u*)(lds + L_K + row * RSK + c8 * 16) = kk; *(LAS v4u*)(lds + L_V + row * RSK + c8 * 16) = vv; }
    if (tid < 128) *(LAS v4u*)(lds + L_V + (256 + (tid >> 3)) * RSK + (tid & 7) * 16) = (v4u){0u, 0u, 0u, 0u};
#pragma unroll
    for (int i = 0; i < 2; ++i) { const int e = tid + 512 * i, g = e >> 7, d = e & 127; int bk;
        if (d < 16) bk = d; else { bk = 16 + (int)(__logf((float)d * (1.f / 16.f)) / 2.0794415416798357f * 16.f); if (bk > 31) bk = 31; }
        *(LAS float*)(lds + L_B + e * 4) = rel[bk * 16 + kvh * 8 + g] * LOG2E; }
    __syncthreads();
    float bv[9][4];
#pragma unroll
    for (int kt = 0; kt < 9; ++kt)
#pragma unroll
        for (int rg = 0; rg < 4; ++rg) { const int dist = 128 - 16 * kt + r - 4 * q - rg; const bool ok = dist >= 0 && dist < 128;
            const float bb = *(const LAS float*)(lds + L_B + (w * 128 + (ok ? dist : 0)) * 4); bv[kt][rg] = ok ? bb : -1e30f; }
    const float sink = sinks[head] * LOG2E;
    bf16x8 Qn0, Qn1; { const bf16* qrow = QB + (tok0 + r) * QW + head * 64 + 8 * q; Qn0 = *(const bf16x8*)qrow; Qn1 = *(const bf16x8*)(qrow + 32); }
#pragma unroll 1
    for (int qt = 0; qt < 8; ++qt) {
        const bf16x8 Qf0 = Qn0, Qf1 = Qn1;
        if (qt + 1 < 8) { const bf16* qrow = QB + (tok0 + 16 * (qt + 1) + r) * QW + head * 64 + 8 * q; Qn0 = *(const bf16x8*)qrow; Qn1 = *(const bf16x8*)(qrow + 32); }
        f32x4 ST[9];
#pragma unroll
        for (int kt = 0; kt < 9; ++kt) {
            if (blk == 0 && qt + kt < 8) { ST[kt] = (f32x4){-1e30f, -1e30f, -1e30f, -1e30f}; }
            else { LAS unsigned char* kp = lds + L_K + (16 * (qt + kt) + r) * RSK + 16 * q; f32x4 a = (f32x4){0.f, 0.f, 0.f, 0.f};
                a = __builtin_amdgcn_mfma_f32_16x16x32_bf16(*(const LAS bf16x8*)kp, Qf0, a, 0, 0, 0); a = __builtin_amdgcn_mfma_f32_16x16x32_bf16(*(const LAS bf16x8*)(kp + 64), Qf1, a, 0, 0, 0);
#pragma unroll
                for (int rg = 0; rg < 4; ++rg) ST[kt][rg] = a[rg] + bv[kt][rg]; } }
        float m = sink;
#pragma unroll
        for (int kt = 0; kt < 9; ++kt)
#pragma unroll
            for (int rg = 0; rg < 4; ++rg) m = fmaxf(m, ST[kt][rg]);
        m = fmaxf(m, __shfl_xor(m, 16)); m = fmaxf(m, __shfl_xor(m, 32));
        float l = 0.f;
#pragma unroll
        for (int kt = 0; kt < 9; ++kt)
#pragma unroll
            for (int rg = 0; rg < 4; ++rg) { const float p = fexp2(ST[kt][rg] - m); ST[kt][rg] = p; l += p; }
        l += __shfl_xor(l, 16); l += __shfl_xor(l, 32);
        const float inv = 1.f / (l + fexp2(sink - m));
        f32x4 O[4];
#pragma unroll
        for (int dt = 0; dt < 4; ++dt) O[dt] = (f32x4){0.f, 0.f, 0.f, 0.f};
#pragma unroll
        for (int cp = 0; cp < 5; ++cp) {
            const f32x4 pa = ST[2 * cp] * inv, pb = (2 * cp + 1 < 9) ? ST[(2 * cp + 1 < 9) ? 2 * cp + 1 : 8] * inv : (f32x4){0.f, 0.f, 0.f, 0.f};
            const bf16x8 P = hg::frag_from2(pa, pb);
#pragma unroll
            for (int dt = 0; dt < 4; ++dt) { LAS unsigned char* p0 = lds + L_V + (16 * (qt + 2 * cp) + 4 * q + (r >> 2)) * RSK + (16 * dt + 4 * (r & 3)) * 2;
                O[dt] = __builtin_amdgcn_mfma_f32_16x16x32_bf16(P, hg::frag_tr2(p0, p0 + 16 * RSK), O[dt], 0, 0, 0); } }
        LAS unsigned char* ow = lds + L_O + w * OW;
#pragma unroll
        for (int dt = 0; dt < 4; ++dt)
#pragma unroll
            for (int rg = 0; rg < 4; ++rg) *(LAS bf16*)(ow + (4 * q + rg) * RSK + (16 * dt + r) * 2) = (bf16)(hg::cvtpk(O[dt][rg], 0.f) & 0xffffu);
#pragma unroll
        for (int i = 0; i < 2; ++i) { const int ci = lane + 64 * i, row = ci >> 3, c8 = ci & 7;
            const v4u v = *(const LAS v4u*)(ow + row * RSK + c8 * 16); *(v4u*)(QB + (tok0 + 16 * qt + row) * QW + head * 64 + c8 * 8) = v; }
    }
}
}

namespace rt {
typedef short bf16x8 __attribute__((ext_vector_type(8)));
__device__ __forceinline__ void prep_w(const float* wco, const float* wfi, const float* gf, bf16* WRH, bf16* WRL, int gtid, int nthr) {
    for (int e = gtid; e < 80 * D; e += nthr) { const int n = e >> 11, k = e & 2047;
        const float w = (n < 8) ? wco[k * 8 + n] : (n < 72 ? wfi[k * 64 + (n - 8)] : 0.f); const float v = w * gf[k];
        const unsigned h = hg::cvtpk(v, 0.f) & 0xffffu; const float l = v - __uint_as_float(h << 16);
        WRH[e] = (bf16)h; WRL[e] = (bf16)(hg::cvtpk(l, 0.f) & 0xffffu); }
}
constexpr int RSB = 272, BUFB = 2 * 80 * RSB, L_G = 2 * BUFB, L_LW = L_G + 8192, L_HIST = L_LW + 8 * 5120;
__device__ __forceinline__ void pass(LAS unsigned char* lds, const float* x, const bf16* DL, float* RSTD2, const float* gf, const bf16* WRH, const bf16* WRL, const float* bco, const float* bfi,
                                     bf16* XN, float* TW, const int tl, const bool live, const int tid, int& ea_out, int& eb_out) {
    const int lane = tid & 63, w = __builtin_amdgcn_readfirstlane(tid >> 6), r = lane & 15, q = lane >> 4;
    const int tok = live ? tl * 16 + r : r;
    LAS float* lw = (LAS float*)(lds + L_LW + w * 5120);
    v4u st[5];
#define RT_BLOAD(ck_) do { _Pragma("unroll") for (int i = 0; i < 5; ++i) { const int p_ = tid + 512 * i, mat_ = p_ >= 1280, rem_ = p_ - 1280 * mat_, n_ = rem_ >> 4, j_ = rem_ & 15; \
        st[i] = *(const v4u*)((mat_ ? WRL : WRH) + (size_t)n_ * D + (ck_) * 128 + j_ * 8); } } while (0)
#define RT_BSTORE(buf_) do { _Pragma("unroll") for (int i = 0; i < 5; ++i) { const int p_ = tid + 512 * i, mat_ = p_ >= 1280, rem_ = p_ - 1280 * mat_, n_ = rem_ >> 4, j_ = rem_ & 15; \
        *(LAS v4u*)(lds + (buf_) * BUFB + mat_ * 80 * RSB + n_ * RSB + j_ * 16) = st[i]; } } while (0)
    RT_BLOAD(0);
    const float* xr = x + (size_t)tok * D + 8 * q; bf16* xo = XN + (size_t)tok * D + 8 * q;
    const int tl0 = live ? tl : 0, t0 = (tl0 & 15) * 16;
    const unsigned char* dbase = (const unsigned char*)DL + (size_t)(tl0 >> 4) * 8 * 131072 + (((t0 >> 7) * 4 + ((t0 >> 4) & 3)) * 2) * 8192 + (((t0 >> 6) & 1) * 4) * 1024 + (q * 16 + r) * 16;
    f32x4 X[4][2]; v4u Dl[4];
#define RT_XLOAD(ck_) do { _Pragma("unroll") for (int s_ = 0; s_ < 4; ++s_) { const int c_ = 4 * (ck_) + s_; X[s_][0] = __builtin_nontemporal_load((const f32x4*)(xr + 32 * c_)); \
        X[s_][1] = __builtin_nontemporal_load((const f32x4*)(xr + 32 * c_ + 4)); Dl[s_] = __builtin_nontemporal_load((const v4u*)(dbase + (size_t)(c_ >> 3) * 131072 + (c_ & 1) * 8192 + ((c_ >> 1) & 3) * 1024)); } } while (0)
    RT_XLOAD(0);
    RT_BSTORE(0);
    __syncthreads();
    f32x4 acc[5];
#pragma unroll
    for (int nt = 0; nt < 5; ++nt) acc[nt] = (f32x4){0.f, 0.f, 0.f, 0.f};
    float ssq = 0.f;
#pragma unroll 1
    for (int ck = 0; ck < 16; ++ck) {
        f32x4 Xc[4][2]; v4u Dc[4];
#pragma unroll
        for (int s_ = 0; s_ < 4; ++s_) { Xc[s_][0] = X[s_][0]; Xc[s_][1] = X[s_][1]; Dc[s_] = Dl[s_]; }
        if (ck + 1 < 16) { RT_BLOAD(ck + 1); RT_XLOAD(ck + 1); }
        LAS unsigned char* bb = lds + (ck & 1) * BUFB + r * RSB + 16 * q;
#pragma unroll
        for (int s_ = 0; s_ < 4; ++s_) {
            const int c = 4 * ck + s_;
            f32x4 x0 = Xc[s_][0], x1 = Xc[s_][1]; { f32x4 d0, d1; pg8::unpack8(Dc[s_], d0, d1); x0 += d0; x1 += d1; }
            ssq += ((x0[0] * x0[0] + x0[1] * x0[1]) + (x0[2] * x0[2] + x0[3] * x0[3])) + ((x1[0] * x1[0] + x1[1] * x1[1]) + (x1[2] * x1[2] + x1[3] * x1[3]));
            v4u hi; hi.x = hg::cvtpk(x0[0], x0[1]); hi.y = hg::cvtpk(x0[2], x0[3]); hi.z = hg::cvtpk(x1[0], x1[1]); hi.w = hg::cvtpk(x1[2], x1[3]);
            if (live) *(v4u*)(xo + 32 * c) = hi;
            v4u lo; lo.x = hg::cvtpk(x0[0] - hg::blo(hi.x), x0[1] - hg::bhi(hi.x)); lo.y = hg::cvtpk(x0[2] - hg::blo(hi.y), x0[3] - hg::bhi(hi.y));
            lo.z = hg::cvtpk(x1[0] - hg::blo(hi.z), x1[1] - hg::bhi(hi.z)); lo.w = hg::cvtpk(x1[2] - hg::blo(hi.w), x1[3] - hg::bhi(hi.w));
            const bf16x8 Ah = __builtin_bit_cast(bf16x8, hi), Al = __builtin_bit_cast(bf16x8, lo);
#pragma unroll
            for (int nt = 0; nt < 5; ++nt) { const bf16x8 Bh = *(const LAS bf16x8*)(bb + nt * 16 * RSB + 64 * s_), Bl = *(const LAS bf16x8*)(bb + 80 * RSB + nt * 16 * RSB + 64 * s_);
                acc[nt] = __builtin_amdgcn_mfma_f32_16x16x32_bf16(Ah, Bh, acc[nt], 0, 0, 0); acc[nt] = __builtin_amdgcn_mfma_f32_16x16x32_bf16(Ah, Bl, acc[nt], 0, 0, 0);
                acc[nt] = __builtin_amdgcn_mfma_f32_16x16x32_bf16(Al, Bh, acc[nt], 0, 0, 0); }
        }
        if (ck + 1 < 16) RT_BSTORE((ck + 1) & 1);
        __syncthreads();
    }
#undef RT_BLOAD
#undef RT_BSTORE
#undef RT_XLOAD
    ssq += __shfl_xor(ssq, 16); ssq += __shfl_xor(ssq, 32);
    const float rstd = rsqrtf(ssq * (1.f / D) + EPS);
    if (live && q == 0) RSTD2[tok] = rstd;
#pragma unroll
    for (int nt = 0; nt < 5; ++nt)
#pragma unroll
        for (int rg = 0; rg < 4; ++rg) lw[(4 * q + rg) * 80 + 16 * nt + r] = acc[nt][rg];
    asm volatile("s_waitcnt lgkmcnt(0)" ::: "memory");
    if (live && lane < 16) {
        const LAS float* L = lw + lane * 80;
        float cm = L[0] * rstd + bco[0]; int grp = 0; float cv[8]; cv[0] = cm;
#pragma unroll
        for (int j = 1; j < 8; ++j) { cv[j] = L[j] * rstd + bco[j]; if (cv[j] > cm) { cm = cv[j]; grp = j; } }
        float den = 0.f;
#pragma unroll
        for (int j = 0; j < 8; ++j) den += fexp(cv[j] - cm);
        const float psel = 1.f / den;
        float f[8];
#pragma unroll
        for (int j = 0; j < 8; ++j) f[j] = L[8 + grp * 8 + j] * rstd + bfi[grp * 8 + j];
        int i0 = 0; float f0 = f[0];
#pragma unroll
        for (int j = 1; j < 8; ++j) if (f[j] > f0) { f0 = f[j]; i0 = j; }
        int i1 = -1; float f1 = 0.f;
#pragma unroll
        for (int j = 0; j < 8; ++j) if (j != i0 && (i1 < 0 || f[j] > f1)) { f1 = f[j]; i1 = j; }
        const float e1 = fexp(f1 - f0), w0 = psel / (1.f + e1), w1 = psel * e1 / (1.f + e1);
        ea_out = grp * 8 + i0; eb_out = grp * 8 + i1;
        TW[tok * 2] = w0; TW[tok * 2 + 1] = w1;
    }
}
}

constexpr int LDS_BYTES = 155648;
constexpr int LDS_MISC = 152576;

__global__ void __launch_bounds__(NTHR, 2) fwd_kernel(Args args) {
    extern __shared__ __attribute__((aligned(16))) unsigned char lds_raw[];
    LAS unsigned char* lds = (LAS unsigned char*)lds_raw;
    LAS float* ldsf = (LAS float*)lds;
    volatile LAS unsigned* MISC = (volatile LAS unsigned*)(lds + LDS_MISC);
    int tid = threadIdx.x; asm volatile("" : "+v"(tid));
    int lane = tid & 63, wave = __builtin_amdgcn_readfirstlane(tid >> 6);
#define GRID_SYNC() do { xcd_barrier(bar, tid); asm volatile("" : "+v"(tid)); lane = tid & 63; wave = __builtin_amdgcn_readfirstlane(tid >> 6); gw = bx * NWAVES + wave; } while (0)
    const int G = gridDim.x, bx = blockIdx.x;
    int gw = bx * NWAVES + wave; const int NGW = G * NWAVES;
    unsigned char* ws = args.ws;
    unsigned* ctl = (unsigned*)(ws + WS_CTL);
    if (tid < 64) MISC[tid] = 0u;
    __syncthreads();
    XcdBarrier bar = xcd_barrier_post(ctl + CW_BAR, MISC + 8, tid);

    const float* x = args.in[I_X];
    float* hbuf = args.out;
    float* LB = (float*)(ws + WS_SMALL);
    float* TW = (float*)(ws + WS_SMALL + 65536);
    unsigned short* LIST = (unsigned short*)(ws + WS_LIST);
    bf16* W_IN_T = (bf16*)(ws + WS_WIN); bf16* W_UA_T = (bf16*)(ws + WS_WUA); bf16* W_UR_T = (bf16*)(ws + WS_WUR);
    bf16* W_OUT_T = (bf16*)(ws + WS_WOUT); bf16* W_PG_T = (bf16*)(ws + WS_WPG); bf16* W_PI_T = (bf16*)(ws + WS_WPI);
    bf16* U = (bf16*)(ws + WS_RA); bf16* OREC = (bf16*)(ws + WS_RA); bf16* XN = (bf16*)(ws + WS_RA);
    bf16* QB = (bf16*)(ws + WS_RB); bf16* KVB = (bf16*)(ws + WS_RB + 64 * MiB); bf16* HID = (bf16*)(ws + WS_RB); bf16* PB = (bf16*)(ws + WS_PB);
    bf16* HG = (bf16*)(ws + WS_RC); bf16* MIX = (bf16*)(ws + WS_RC); bf16* Y = (bf16*)(ws + WS_RE);
    bf16* GT = (bf16*)(ws + WS_RD); bf16* W_DN_T = (bf16*)(ws + WS_RD); bf16* PL = (bf16*)(ws + WS_RD + 128 * MiB);
    bf16* W_GU_T = (bf16*)(ws + WS_RE);
    float* RSTDP = (float*)(ws + WS_SMALL + 393216); float* RSTD3 = (float*)(ws + WS_SMALL + 524288); float* RSTD2 = (float*)(ws + WS_SMALL + 655360);
    bf16* DELTA = (bf16*)(ws + WS_RC + 128 * MiB);
    bf16* H3B = (bf16*)(ws + WS_RC);
    bf16* WRH = (bf16*)(ws + 6 * MiB); bf16* WRL = (bf16*)(ws + 6 * MiB + 512 * 1024);
    float* UST = (float*)(ws + WS_RA + 64 * MiB); float* DST = (float*)(ws + WS_RA + 96 * MiB);
    float* SS_H1 = (float*)(ws + WS_SS); float* SS_PL = (float*)(ws + WS_SS + 4 * MiB); float* SS_FIN = (float*)(ws + WS_SS + 8 * MiB);
    unsigned* CNT = ctl + CW_CNT;
    LAS unsigned char* ring = lds;

#ifndef REP_P0
#define REP_P0 1
#endif
#ifndef REP_P1
#define REP_P1 1
#endif
#pragma unroll 1
    for (int rep = 0; rep < REP_P0; ++rep) {
        LAS float* scr = ldsf + wave * 4096;
        transpose_all(args.in[I_WIN], D, INC, W_IN_T, scr, gw, NGW, lane, D);
        transpose_all(args.in[I_WUA], QW, D, W_UA_T, scr, gw, NGW, lane, QW);
        transpose_all(args.in[I_WUR], HW, D, W_UR_T, scr, gw, NGW, lane, HW);
        transpose_all(args.in[I_WOUT], D, D, W_OUT_T, scr, gw, NGW, lane, D);
        transpose_all(args.in[I_WPG], D, D, W_PG_T, scr, gw, NGW, lane, D);
        transpose_all(args.in[I_WPI], PLE, D, W_PI_T, scr, gw, NGW, lane, PLE);
        for (int it = gw; it < (NEXP - 16) * 1024; it += NGW) { const int e = it >> 10, r = it & 1023, mat = r >> 9, item = r & 511;
            transpose_item(args.in[mat ? I_WU : I_WG] + (size_t)e * D * MH, D, MH, W_GU_T + (size_t)e * 1024 * D, scr, item, lane, 1 + mat, D, args.in[I_GFFN]); }
        for (int m = gw; m < NTOK; m += NGW) { const f32x4 pv = __builtin_nontemporal_load((const f32x4*)(args.in[I_P] + (size_t)m * PLE) + lane);
            v2u w; w.x = pk2(pv.x, pv.y); w.y = pk2(pv.z, pv.w); *((v2u*)(PB + (size_t)m * PLE) + lane) = w; }
        const float* gm = args.in[I_GMIX];
        for (int m = gw; m < NTOK; m += NGW) {
            const f32x4* xr = (const f32x4*)(x + (size_t)m * D) + lane;
            f32x4 v[8]; float s = 0.f;
#pragma unroll
            for (int j = 0; j < 8; ++j) { v[j] = __builtin_nontemporal_load(xr + 64 * j); s += (v[j].x * v[j].x + v[j].y * v[j].y) + (v[j].z * v[j].z + v[j].w * v[j].w); }
            const float rstd = rsqrtf(wave_sum(s) * (1.f / D) + EPS);
            v2u* o = (v2u*)(U + (size_t)m * D) + lane;
#pragma unroll
            for (int j = 0; j < 8; ++j) { const f32x4 g = *((const f32x4*)gm + 64 * j + lane); v2u w; w.x = pk2(v[j].x * rstd * g.x, v[j].y * rstd * g.y); w.y = pk2(v[j].z * rstd * g.z, v[j].w * rstd * g.w); o[64 * j] = w; }
        }
        rt::prep_w(args.in[I_WCO], args.in[I_WFI], args.in[I_GFFN], WRH, WRL, bx * NTHR + tid, G * NTHR);
        const float* lbl = args.in[I_LBL];
        for (int j = bx * NTHR + tid; j < HW; j += G * NTHR) LB[j] = 1.f / (1.f + __expf(lbl[HW + j] - lbl[j]));
    }
    GRID_SYNC();

#pragma unroll 1
    for (int rep = 0; rep < REP_P1; ++rep) {
        pg8::StaticOrder S; S.init(U, W_IN_T, NTOK, INC, D, D, G, bx);
        pg8::EpiZ E{args.in[I_BQKV], LB, QB, KVB, HG, GT};
        pg8::gemm_phase<pg8::EpiZ, pg8::StaticOrder, true, false>(ring, D, D, D, S, E, tid);
        const int nshort = G - (S.nwg % G);
        if (S.nwg % G != 0 && bx >= S.nwg % G) { LAS float* scr = ldsf + wave * 4096; const int sw = (bx - S.nwg % G) * NWAVES + wave, nsw = nshort * NWAVES;
            for (int it = sw; it < 16 * 1024; it += nsw) { const int e = (NEXP - 16) + (it >> 10), r = it & 1023, mat = r >> 9, item = r & 511;
                transpose_item(args.in[mat ? I_WU : I_WG] + (size_t)e * D * MH, D, MH, W_GU_T + (size_t)e * 1024 * D, scr, item, lane, 1 + mat, D, args.in[I_GFFN]); } }
        else if (S.nwg % G == 0) { LAS float* scr = ldsf + wave * 4096;
            for (int it = gw; it < 16 * 1024; it += NGW) { const int e = (NEXP - 16) + (it >> 10), r = it & 1023, mat = r >> 9, item = r & 511;
                transpose_item(args.in[mat ? I_WU : I_WG] + (size_t)e * D * MH, D, MH, W_GU_T + (size_t)e * 1024 * D, scr, item, lane, 1 + mat, D, args.in[I_GFFN]); } }
    }
    GRID_SYNC();

    for (int u = bx; u < 512; u += G) hg::unit<true>(lds, HG, OREC, UST, DST, args.in[I_GHGRN], u, tid);
    for (int it = bx; it < 2 * 128 * 2; it += G) at::item(lds, QB, KVB, args.in[I_SINKS], args.in[I_REL], it, tid);
    GRID_SYNC();

    hg::scan(UST, DST, bx * NTHR + tid, G * NTHR);
    GRID_SYNC();
    for (int u = bx; u < 512; u += G) hg::unit<false>(lds, HG, OREC, UST, DST, args.in[I_GHGRN], u, tid);
    GRID_SYNC();

    {
        pg8::PairOrder S; S.s0.init(QB, W_UA_T, NTOK, D, QW, QW, G, bx); S.A1 = (const char*)OREC; S.B1 = (const char*)W_UR_T;
        pg8::EpiMix E{GT, MIX, (unsigned char*)UST + (size_t)bx * 131072};
        pg8::gemm_phase<pg8::EpiMix, pg8::PairOrder, true, false>(ring, QW, QW, QW, S, E, tid);
    }
    GRID_SYNC();

    {
        pg8::StaticOrder S; S.init(MIX, W_OUT_T, NTOK, D, D, D, G, bx);
        pg8::EpiDelta E{DELTA};
        pg8::gemm_phase<pg8::EpiDelta, pg8::StaticOrder, true, false>(ring, D, D, D, S, E, tid);
    }
    GRID_SYNC();

    {
        {
            LAS float* scr = ldsf + wave * 4096;
            for (int it = gw; it < NEXP * 512; it += NGW) { const int e = it >> 9, item = it & 511;
                transpose_item(args.in[I_WD] + (size_t)e * MH * D, MH, D, W_DN_T + (size_t)e * D * MH, scr, item, lane, 0, MH); }
        }
        __syncthreads();
        LAS unsigned* hist = (LAS unsigned*)(lds + rt::L_HIST);
        for (int i = 0; i * NGW < NTOK / 16; ++i) {
            const int tl = gw + i * NGW; const bool live = tl < NTOK / 16;
            __syncthreads();
            if (tid < 64) hist[tid] = 0u;
            int ea = 0, eb = 0; unsigned ra = 0u, rb = 0u;
            rt::pass(lds, x, DELTA, RSTD2, args.in[I_GFFN], WRH, WRL, args.in[I_BCO], args.in[I_BFI], XN, TW, tl, live, tid, ea, eb);
            if (live && lane < 16) { ra = atomicAdd((unsigned*)(hist + ea), 1u); rb = atomicAdd((unsigned*)(hist + eb), 1u); }
            __syncthreads();
            if (tid < 64) { const unsigned c = hist[tid]; hist[64 + tid] = c ? atomicAdd(CNT + 64 * tid, c) : 0u; }
            __syncthreads();
            if (live && lane < 16) { const int m = tl * 16 + lane;
                LIST[(size_t)ea * NTOK + hist[64 + ea] + ra] = (unsigned short)m; LIST[(size_t)eb * NTOK + hist[64 + eb] + rb] = (unsigned short)(m | 0x8000); }
        }
    }
    GRID_SYNC();

    LAS int* eoff = (LAS int*)(lds + 150528);
    LAS int* ecnt = (LAS int*)(lds + 150528 + 512);
    if (tid < 64) {
        const int c = (int)__hip_atomic_load(CNT + 64 * tid, __ATOMIC_RELAXED, __HIP_MEMORY_SCOPE_AGENT); int v = (c + 255) & ~255;
#pragma unroll
        for (int d = 1; d < 64; d <<= 1) { const int t = __shfl_up(v, d); if (lane >= d) v += t; }
        ecnt[tid] = c; eoff[tid] = v - ((c + 255) & ~255); if (tid == 63) eoff[NEXP] = v;
    }
    __syncthreads();
    const int vcu = (G % 8 == 0) ? (bx % 8) * (G / 8) + bx / 8 : bx;
    const int nrb = eoff[NEXP] / 256;
    {
        pg8::MoeOrder S{eoff, ecnt, 4, G, vcu, nrb, (const char*)XN, (const char*)W_GU_T, (size_t)1024 * D * 2, (size_t)256 * D * 2, (size_t)D * 2, LIST, 1};
        pg8::EpiGateUp E{HID, LIST, RSTD2};
        pg8::gemm_phase<pg8::EpiGateUp, pg8::MoeOrder, true, true>(ring, D, D, D, S, E, tid);
    }
    const int r6 = (nrb * 4) % G, ple_early = r6 ? ((G - r6) * 8 < 1024 ? (G - r6) * 8 : 1024) : 0;
    if (r6 && vcu >= r6) {
        pg8::StaticOrder S; S.init(PB, W_PI_T, NTOK, D, PLE, PLE, 1, 0); S.lo = (vcu - r6) * 8; S.hi = S.lo + 8 < ple_early ? S.lo + 8 : ple_early;
        pg8::EpiPleRaw E{PL, SS_PL};
        pg8::gemm_phase<pg8::EpiPleRaw, pg8::StaticOrder, true, false>(ring, PLE, PLE, PLE, S, E, tid);
    }
    GRID_SYNC();
    {
        pg8::MoeOrder S{eoff, ecnt, 8, G, vcu, nrb, (const char*)HID, (const char*)W_DN_T, (size_t)D * MH * 2, (size_t)256 * MH * 2, (size_t)MH * 2, LIST, 0};
        pg8::EpiDown E{LIST, TW, Y};
        pg8::gemm_phase<pg8::EpiDown, pg8::MoeOrder, true, false>(ring, MH, MH, MH, S, E, tid);
    }
    {
        pg8::StaticOrder S; S.init(PB, W_PI_T, NTOK, D, PLE, PLE, G, bx); S.lo = ple_early;
        pg8::EpiPleRaw E{PL, SS_PL};
        pg8::gemm_phase<pg8::EpiPleRaw, pg8::StaticOrder, true, false>(ring, PLE, PLE, PLE, S, E, tid);
    }
    GRID_SYNC();

    {
        for (int m = gw; m < NTOK; m += NGW) {
            const v2u* hb = (const v2u*)(XN + (size_t)m * D) + lane;
            const v2u* y0 = (const v2u*)(Y + (size_t)m * D) + lane; const v2u* y1 = (const v2u*)(Y + (size_t)NTOK * D + (size_t)m * D) + lane;
            v2u* o = (v2u*)(XN + (size_t)m * D) + lane;
            float s = 0.f;
#pragma unroll
            for (int j = 0; j < 8; ++j) { const v2u a = __builtin_nontemporal_load(y0 + 64 * j), c = __builtin_nontemporal_load(y1 + 64 * j), dd = __builtin_nontemporal_load(hb + 64 * j);
                f32x4 v; v.x = __uint_as_float(dd.x << 16); v.y = __uint_as_float(dd.x & 0xffff0000u); v.z = __uint_as_float(dd.y << 16); v.w = __uint_as_float(dd.y & 0xffff0000u);
                v.x += __uint_as_float(a.x << 16) + __uint_as_float(c.x << 16); v.y += __uint_as_float(a.x & 0xffff0000u) + __uint_as_float(c.x & 0xffff0000u);
                v.z += __uint_as_float(a.y << 16) + __uint_as_float(c.y << 16); v.w += __uint_as_float(a.y & 0xffff0000u) + __uint_as_float(c.y & 0xffff0000u);
                s += (v.x * v.x + v.y * v.y) + (v.z * v.z + v.w * v.w);
                v2u w; w.x = hg::cvtpk(v.x, v.y); w.y = hg::cvtpk(v.z, v.w); o[64 * j] = w; }
            const float ssum = wave_sum(s);
            const float sp = wave_sum(lane < 32 ? SS_PL[(size_t)m * 32 + lane] : 0.f);
            if (lane == 0) { RSTD3[m] = rsqrtf(ssum * (1.f / D) + EPS); RSTDP[m] = rsqrtf(sp * (1.f / D) + EPS); }
        }
    }
    GRID_SYNC();

    {
        pg8::StaticOrder S; S.init(XN, W_PG_T, NTOK, D, D, D, G, bx);
        pg8::EpiPleGate E{H3B, PL, RSTD3, RSTDP, args.in[I_GPLE]};
        pg8::gemm_phase<pg8::EpiPleGate, pg8::StaticOrder, true, false>(ring, D, D, D, S, E, tid);
    }
    GRID_SYNC();

    {
        const float* gfin = args.in[I_GFIN];
        f32x4 gv[8];
#pragma unroll
        for (int j = 0; j < 8; ++j) gv[j] = *((const f32x4*)gfin + 64 * j + lane);
        for (int m = gw; m < NTOK; m += 2 * NGW) {
            const int m1 = (m + NGW < NTOK) ? m + NGW : m;
            f32x4* o0 = (f32x4*)(hbuf + (size_t)m * D) + lane; f32x4* o1 = (f32x4*)(hbuf + (size_t)m1 * D) + lane;
            const v2u* u0 = (const v2u*)(H3B + (size_t)m * D) + lane; const v2u* u1 = (const v2u*)(H3B + (size_t)m1 * D) + lane;
            const v2u* h0 = (const v2u*)(XN + (size_t)m * D) + lane; const v2u* h1 = (const v2u*)(XN + (size_t)m1 * D) + lane;
            v2u a0[8], a1[8], b0[8], b1[8];
#pragma unroll
            for (int j = 0; j < 8; ++j) { a0[j] = __builtin_nontemporal_load(u0 + 64 * j); a1[j] = __builtin_nontemporal_load(u1 + 64 * j); b0[j] = __builtin_nontemporal_load(h0 + 64 * j); b1[j] = __builtin_nontemporal_load(h1 + 64 * j); }
            f32x4 y0[8], y1[8]; float s0 = 0.f, s1 = 0.f;
#pragma unroll
            for (int j = 0; j < 8; ++j) {
                y0[j].x = __uint_as_float(a0[j].x << 16) + __uint_as_float(b0[j].x << 16); y0[j].y = __uint_as_float(a0[j].x & 0xffff0000u) + __uint_as_float(b0[j].x & 0xffff0000u);
                y0[j].z = __uint_as_float(a0[j].y << 16) + __uint_as_float(b0[j].y << 16); y0[j].w = __uint_as_float(a0[j].y & 0xffff0000u) + __uint_as_float(b0[j].y & 0xffff0000u);
                y1[j].x = __uint_as_float(a1[j].x << 16) + __uint_as_float(b1[j].x << 16); y1[j].y = __uint_as_float(a1[j].x & 0xffff0000u) + __uint_as_float(b1[j].x & 0xffff0000u);
                y1[j].z = __uint_as_float(a1[j].y << 16) + __uint_as_float(b1[j].y << 16); y1[j].w = __uint_as_float(a1[j].y & 0xffff0000u) + __uint_as_float(b1[j].y & 0xffff0000u);
                s0 += (y0[j].x * y0[j].x + y0[j].y * y0[j].y) + (y0[j].z * y0[j].z + y0[j].w * y0[j].w); s1 += (y1[j].x * y1[j].x + y1[j].y * y1[j].y) + (y1[j].z * y1[j].z + y1[j].w * y1[j].w); }
            const float r0 = rsqrtf(wave_sum(s0) * (1.f / D) + EPS), r1 = rsqrtf(wave_sum(s1) * (1.f / D) + EPS);
#pragma unroll
            for (int j = 0; j < 8; ++j) { __builtin_nontemporal_store(y0[j] * r0 * gv[j], o0 + 64 * j); __builtin_nontemporal_store(y1[j] * r1 * gv[j], o1 + 64 * j); }
        }
    }
}

extern "C" void kernel_launch(void* const* d_in, const int* in_sizes, int n_in, void* d_out, int out_size, void* d_ws, size_t ws_size, hipStream_t stream) {
    static int grid = 0;
    if (grid == 0) {
        if (n_in != 24 || out_size != NTOK * D || ws_size < WS_END) { fprintf(stderr, "kernel_launch: unexpected shapes (n_in %d, out %d, ws %zu)\n", n_in, out_size, ws_size); grid = -1; return; }
        int dev = 0, cus = 0;
        if (hipGetDevice(&dev) != hipSuccess || hipDeviceGetAttribute(&cus, hipDeviceAttributeMultiprocessorCount, dev) != hipSuccess) { grid = -1; return; }
        if (hipFuncSetAttribute((const void*)fwd_kernel, hipFuncAttributeMaxDynamicSharedMemorySize, LDS_BYTES) != hipSuccess) { fprintf(stderr, "kernel_launch: hipFuncSetAttribute failed\n"); grid = -1; return; }
        int per_cu = 0;
        if (hipOccupancyMaxActiveBlocksPerMultiprocessor(&per_cu, (const void*)fwd_kernel, NTHR, LDS_BYTES) != hipSuccess || per_cu < 1) { fprintf(stderr, "kernel_launch: occupancy query says %d\n", per_cu); }
        (void)hipGetLastError();
        grid = cus;
    }
    if (grid < 0) return;
    if (hipMemsetAsync((char*)d_ws + WS_CTL, 0, CTL_ZERO_BYTES, stream) != hipSuccess) return;
    Args a{};
    for (int i = 0; i < 24; ++i) a.in[i] = (const float*)d_in[i];
    a.out = (float*)d_out; a.ws = (unsigned char*)d_ws;
    hipLaunchKernelGGL(fwd_kernel, dim3(grid), dim3(NTHR), LDS_BYTES, stream, a);
}
```

```cpp
#include <hip/hip_runtime.h>
#include <cstdio>
#include <cstdint>

#define GAS __attribute__((address_space(1)))
#define LAS __attribute__((address_space(3)))
typedef unsigned short bf16;
typedef float f32x4 __attribute__((ext_vector_type(4)));
typedef unsigned v4u __attribute__((ext_vector_type(4)));
typedef unsigned v2u __attribute__((ext_vector_type(2)));

constexpr int NTOK = 32768, SEQ = 16384, D = 2048;
constexpr int QW = 1024, KVW = 128, QKVW = 1280, HW = 1024, INC = 9472;
constexpr int NEXP = 64, MH = 512, PLE = 256;
constexpr float EPS = 1e-6f;
constexpr int NWAVES = 8, NTHR = 512;
constexpr size_t HGPS = (size_t)NTOK * 128;
constexpr int HIDCAP = 81920;

constexpr size_t MiB = 1u << 20;
constexpr size_t WS_CTL = 0, CTL_ZERO_BYTES = 1 * MiB;
constexpr size_t WS_SMALL = 1 * MiB;
constexpr size_t WS_LIST = 2 * MiB;
constexpr size_t WS_WIN = 8 * MiB, WS_WUA = 45 * MiB, WS_WUR = 49 * MiB, WS_WOUT = 53 * MiB, WS_WPG = 61 * MiB, WS_WPI = 69 * MiB;
constexpr size_t WS_RA = 70 * MiB;
constexpr size_t WS_RB = 198 * MiB;
constexpr size_t WS_RC = 278 * MiB;
constexpr size_t WS_RD = 534 * MiB;
constexpr size_t WS_RE = 790 * MiB;
constexpr size_t WS_PB = 1046 * MiB;
constexpr size_t WS_SS = 1062 * MiB;
constexpr size_t WS_END = 1074 * MiB;
constexpr int CW_BAR = 4096;
constexpr int CW_CNT = 16384;
constexpr int CW_PACE = 32768;

__device__ __forceinline__ float bf2f(bf16 h) { return __uint_as_float(((unsigned)h) << 16); }
__device__ __forceinline__ unsigned f2bf(float f) { unsigned u = __float_as_uint(f); return (u + 0x7fffu + ((u >> 16) & 1u)) >> 16; }
__device__ __forceinline__ unsigned pk2(float lo, float hi) { return f2bf(lo) | (f2bf(hi) << 16); }
constexpr float LOG2E = 1.4426950408889634f;
__device__ __forceinline__ float fexp2(float x) { return __builtin_amdgcn_exp2f(x); }
__device__ __forceinline__ float fexp(float x) { return __builtin_amdgcn_exp2f(x * LOG2E); }
__device__ __forceinline__ float flog2(float x) { return __builtin_amdgcn_logf(x); }
__device__ __forceinline__ float wave_sum(float v) {
#pragma unroll
    for (int o = 1; o < 64; o <<= 1) v += __shfl_xor(v, o);
    return v;
}

#define XB_TMO      128
#define XB_XCNT(j)  (256  + 64 * (j))
#define XB_XSUB(j)  (1280 + 64 * (j))
#define XB_XGEN(j)  (2304 + 64 * (j))
#define XB_TOP      3328
#define XB_TOPGEN   3392
#define XCD_BAR_WORDS 3456
#define XB_SPIN_CAP (1u << 23)
__device__ __forceinline__ unsigned xb_ld(unsigned* p)              { return __hip_atomic_load(p, __ATOMIC_RELAXED, __HIP_MEMORY_SCOPE_AGENT); }
__device__ __forceinline__ unsigned xb_add(unsigned* p, unsigned v) { return __hip_atomic_fetch_add(p, v, __ATOMIC_RELAXED, __HIP_MEMORY_SCOPE_AGENT); }
__device__ __forceinline__ unsigned xb_xcc_id() { return (unsigned)__builtin_amdgcn_s_getreg((3 << 11) | 20) & 0xFu; }
#define XB_SPIN(cond, bar) do { unsigned _sp = 0; while (cond) { __builtin_amdgcn_s_sleep(1); \
    if ((++_sp & 255u) == 0u) { if (xb_ld(&(bar)[XB_TMO])) break; if (_sp > XB_SPIN_CAP) { atomicAdd(&(bar)[XB_TMO], 1u); break; } } } } while (0)
struct XcdBarrier { unsigned* bar; unsigned x; volatile LAS unsigned* st; };
__device__ __forceinline__ XcdBarrier xcd_barrier_post(unsigned* bar, volatile LAS unsigned* st, const int tid) {
    XcdBarrier b; b.bar = bar; b.x = xb_xcc_id(); b.st = st;
    if (tid == 0) (void)xb_add(&bar[XB_XCNT(b.x)], 1u);
    return b;
}
__device__ __forceinline__ void xcd_barrier_complete(unsigned* bar, unsigned x, unsigned& nloc, unsigned& nx) {
    const unsigned G = gridDim.x * gridDim.y * gridDim.z;
    unsigned sum, cnt, mine, sp = 0u;
    for (;;) {
        sum = 0u; cnt = 0u; mine = 0u;
#pragma unroll
        for (unsigned j = 0; j < 16; ++j) { const unsigned c = xb_ld(&bar[XB_XCNT(j)]); sum += c; cnt += (c > 0u) ? 1u : 0u; mine = (j == x) ? c : mine; }
        if (sum == G) break;
        __builtin_amdgcn_s_sleep(1);
        if ((++sp & 255u) == 0u) { if (xb_ld(&bar[XB_TMO])) break; if (sp > XB_SPIN_CAP) { atomicAdd(&bar[XB_TMO], 1u); break; } }
    }
    nloc = mine > 0u ? mine : 1u; nx = cnt > 0u ? cnt : 1u;
}
__device__ __forceinline__ void xcd_barrier(const XcdBarrier& b, const int tid) {
    asm volatile("s_waitcnt vmcnt(0)" ::: "memory");
    __syncthreads();
    if (tid == 0) {
        unsigned* bar = b.bar;
        __builtin_amdgcn_s_waitcnt(0);
        unsigned nloc = b.st[0], nx = b.st[1];
        if (nloc == 0u) { xcd_barrier_complete(bar, b.x, nloc, nx); b.st[0] = nloc; b.st[1] = nx; }
        const unsigned old = xb_add(&bar[XB_XSUB(b.x)], 1u);
        const unsigned gen = old / nloc;
        if (old + 1u == (gen + 1u) * nloc) {
            __builtin_amdgcn_fence(__ATOMIC_RELEASE, "agent");
            asm volatile("s_waitcnt vmcnt(0)" ::: "memory");
            const unsigned og = xb_add(&bar[XB_TOP], 1u);
            const unsigned tg = og / nx;
            if (og + 1u == (tg + 1u) * nx) xb_add(&bar[XB_TOPGEN], 1u);
            else XB_SPIN(xb_ld(&bar[XB_TOPGEN]) == tg, bar);
            __builtin_amdgcn_fence(__ATOMIC_ACQUIRE, "agent");
            xb_add(&bar[XB_XGEN(b.x)], 1u);
            asm volatile("s_waitcnt vmcnt(0)" ::: "memory");
        } else {
            XB_SPIN(xb_ld(&bar[XB_XGEN(b.x)]) == gen, bar);
            __builtin_amdgcn_fence(__ATOMIC_ACQUIRE, "agent");
            asm volatile("s_waitcnt vmcnt(0)" ::: "memory");
        }
    }
    __syncthreads();
}

struct Args {
    const float* in[24];
    float* out;
    unsigned char* ws;
};
enum { I_X = 0, I_P, I_GMIX, I_WIN, I_BQKV, I_SINKS, I_REL, I_LBL, I_GHGRN, I_WUA, I_WUR, I_WOUT, I_GFFN, I_WCO, I_BCO, I_WFI, I_BFI,
       I_WG, I_WU, I_WD, I_WPI, I_GPLE, I_WPG, I_GFIN };

__device__ __forceinline__ void transpose_item(const float* W, int K, int N, bf16* WT, LAS float* scr, int item, int lane, int gu, int ldw, const float* ks = nullptr) {
    const int nblk = N / 32, kb = item / nblk, nb = item % nblk, k0 = 64 * kb, n0 = 32 * nb;
    const int d0 = gu ? (256 * (n0 >> 7) + 64 * ((n0 & 127) >> 5) + 32 * (gu - 1)) : n0;
#pragma unroll
    for (int i = 0; i < 32; ++i) { const int kk = 2 * i + (lane >> 5); scr[kk * 33 + (lane & 31)] = __builtin_nontemporal_load(W + (size_t)(k0 + kk) * N + n0 + (lane & 31)); }
    asm volatile("s_waitcnt lgkmcnt(0)" ::: "memory");
    const int c = lane & 7;
    f32x4 k0s = (f32x4){1.f, 1.f, 1.f, 1.f}, k1s = k0s; if (ks) { k0s = *(const f32x4*)(ks + k0 + 8 * c); k1s = *(const f32x4*)(ks + k0 + 8 * c + 4); }
#pragma unroll
    for (int j = 0; j < 4; ++j) { const int n = (lane >> 3) + 8 * j; const LAS float* s = scr + (8 * c) * 33 + n;
        v4u o; o.x = pk2(s[0 * 33] * k0s[0], s[1 * 33] * k0s[1]); o.y = pk2(s[2 * 33] * k0s[2], s[3 * 33] * k0s[3]); o.z = pk2(s[4 * 33] * k1s[0], s[5 * 33] * k1s[1]); o.w = pk2(s[6 * 33] * k1s[2], s[7 * 33] * k1s[3]);
        *(v4u*)(WT + (size_t)(d0 + n) * ldw + k0 + 8 * c) = o; }
    asm volatile("s_waitcnt lgkmcnt(0)" ::: "memory");
}
__device__ __forceinline__ void transpose_all(const float* W, int K, int N, bf16* WT, LAS float* scr, int gw, int ngw, int lane, int ldw) {
    const int nitems = (K / 64) * (N / 32);
    for (int it = gw; it < nitems; it += ngw) transpose_item(W, K, N, WT, scr, it, lane, 0, ldw);
}

namespace pg8 {
typedef short bf16x8 __attribute__((ext_vector_type(8)));
typedef unsigned u32x4 __attribute__((ext_vector_type(4)));
constexpr int BM = 256, BK = 64, HALF = 128, HTB = HALF * BK * 2, STAGE_BYTES = 8 * HTB, NXCD = 8, WGM = 8;
__host__ __device__ __forceinline__ int lds_byte(int r, int c) { const int st = (r >> 4) * 2 + (c >> 5), rr = r & 15, cc = c & 31, ob = rr * 64 + cc * 2; return st * 1024 + (ob ^ (((ob >> 9) & 1) << 5)); }
__host__ __device__ __forceinline__ void stage_rc(int b, int& R, int& C) { const int st = b / 1024, sb = b % 1024, swz = sb ^ (((sb >> 9) & 1) << 5); R = (st >> 1) * 16 + swz / 64; C = (st & 1) * 32 + (swz % 64) / 2; }
__host__ __device__ __forceinline__ int perm32(int rho) { const int n = rho >> 4, i = rho & 15; return 8 * (i >> 2) + 4 * n + (i & 3); }
struct Unit { int pm, pn; const char* a; const char* b; int e, r0, cnt, row0; };
typedef __bf16 bfv2_t __attribute__((ext_vector_type(2))); typedef float fv2_t __attribute__((ext_vector_type(2)));
__device__ __forceinline__ unsigned cvt_pk_bf16(float lo, float hi) { fv2_t v; v.x = lo; v.y = hi; return __builtin_bit_cast(unsigned, __builtin_convertvector(v, bfv2_t)); }

struct StaticOrder {
    int nM, nN, nwg, G, c, lo, hi; const char* A; const char* Bt; size_t tstepA, tstepB;
    __device__ __forceinline__ void init(const bf16* A_, const bf16* Bt_, int M, int N, int lda, int ldb, int G_, int c_) { nM = M / BM; nN = N / BM; nwg = nM * nN; G = G_; c = c_; lo = 0; hi = nwg; A = (const char*)A_; Bt = (const char*)Bt_; tstepA = (size_t)BM * lda * 2; tstepB = (size_t)BM * ldb * 2; pace = nullptr; }
    __device__ __forceinline__ bool next(int i, Unit& u) const {
        const long L = (long)lo + (long)i * G + c; if (L >= hi) return false;
        int wgid = (int)L; { const int q = nwg / NXCD, r = nwg % NXCD, xcd = wgid % NXCD, off = wgid / NXCD; wgid = (xcd < r ? xcd * (q + 1) : r * (q + 1) + (xcd - r) * q) + off; }
        const int nig = WGM * nN, gid = wgid / nig, fm = gid * WGM, gsz = (nM - fm) < WGM ? (nM - fm) : WGM;
        u.pm = fm + ((wgid % nig) % gsz); u.pn = (wgid % nig) / gsz; u.a = A + (size_t)u.pm * tstepA; u.b = Bt + (size_t)u.pn * tstepB; u.e = 0; u.r0 = 0; u.cnt = 0; u.row0 = 0; return true;
    }
    __device__ __forceinline__ unsigned row_off(const Unit&, int) const { return 0u; }
    unsigned* pace;
    __device__ __forceinline__ void pace_arrive_wait(int ui, int wid, int lane) const {
        if (pace == nullptr || wid != 0) return;
        unsigned* p = pace + 64 * (c & 7);
        if (lane == 0) __hip_atomic_fetch_add(p, 1u, __ATOMIC_RELAXED, __HIP_MEMORY_SCOPE_AGENT);
        const unsigned want = (unsigned)(G >> 3) * (unsigned)(ui + 1);
        for (int sp = 0; sp < 4096; ++sp) { if (__hip_atomic_load(p, __ATOMIC_RELAXED, __HIP_MEMORY_SCOPE_AGENT) >= want) break; __builtin_amdgcn_s_sleep(2); }
    }
    __device__ __forceinline__ void pace_finish(int units_done, int wid, int lane) const {
        if (pace == nullptr || wid != 0 || lane != 0) return;
        const int rmax = (nwg + G - 1) / G;
        if (units_done < rmax) __hip_atomic_fetch_add(pace + 64 * (c & 7), (unsigned)(rmax - units_done), __ATOMIC_RELAXED, __HIP_MEMORY_SCOPE_AGENT);
    }
};

struct PairOrder {
    StaticOrder s0; const char* A1; const char* B1;
    __device__ __forceinline__ bool next(int i, Unit& u) const {
        if (!s0.next(i >> 1, u)) return false;
        if (i & 1) { u.a = A1 + (size_t)u.pm * s0.tstepA; u.b = B1 + (size_t)u.pn * s0.tstepB; u.e = 1; }
        return true;
    }
    __device__ __forceinline__ unsigned row_off(const Unit&, int) const { return 0u; }
    __device__ __forceinline__ void pace_arrive_wait(int, int, int) const {}
    __device__ __forceinline__ void pace_finish(int, int, int) const {}
};

template <class Epi, class Sched, bool ALIGN_EPI, bool GATHER>
__device__ __forceinline__ void gemm_phase(LAS unsigned char* lds, const int K, const int lda, const int ldb, const Sched& S, const Epi& E, const int tid) {
    const int wid = __builtin_amdgcn_readfirstlane(tid >> 6), lane = tid & 63, wr = wid >> 2, wc = wid & 3, fr = lane & 15, fq = lane >> 4;
    const int nt = K / BK;
    int Rr[2], Cc[2];
    unsigned voffA[2][2], voffB[2][2], voffAn[2][2];
#pragma unroll
    for (int i = 0; i < 2; ++i) { stage_rc(tid * 16 + i * 8192, Rr[i], Cc[i]);
#pragma unroll
        for (int h = 0; h < 2; ++h) { const int Rb = Epi::PERM ? (64 * (Rr[i] >> 5) + 32 * h + perm32(Rr[i] & 31)) : h * HALF + Rr[i];
            voffB[h][i] = (unsigned)(Rb * ldb + Cc[i]) * 2u; voffA[h][i] = (unsigned)((h * HALF + Rr[i]) * lda + Cc[i]) * 2u; voffAn[h][i] = voffA[h][i]; } }
    const size_t kstep = (size_t)(BK * 2);
    const unsigned ldsw = (unsigned)wid * 1024u;
    const int aoff = lds_byte(wr * 64 + fr, fq * 8), boff = lds_byte(wc * 32 + fr, fq * 8);
#define PG8_SA(b, h) (((b) * 2 + (h)) * HTB)
#define PG8_SB(b, h) ((4 + (b) * 2 + (h)) * HTB)
#define PG8_STAGE(bufoff, gbase, voff) do { const char* _gb = (const char*)(gbase); asm volatile("" : "+s"(_gb));     \
        _Pragma("unroll") for (int _i = 0; _i < 2; ++_i) \
        __builtin_amdgcn_global_load_lds((const unsigned*)(_gb + (voff)[_i]), (LAS unsigned*)(lds + (bufoff) + ldsw + _i * 8192), 16, 0, 0); } while (0)
#define PG8_LDA(dst, b, h) do { _Pragma("unroll") for (int m = 0; m < 4; ++m) _Pragma("unroll") for (int k = 0; k < 2; ++k) dst[m][k] = *(const LAS bf16x8*)(lds + PG8_SA(b, h) + aoff + m * 2048 + k * 1024); } while (0)
#define PG8_LDB(dst, b, h) do { _Pragma("unroll") for (int n = 0; n < 2; ++n) _Pragma("unroll") for (int k = 0; k < 2; ++k) dst[n][k] = *(const LAS bf16x8*)(lds + PG8_SB(b, h) + boff + n * 2048 + k * 1024); } while (0)
#define PG8_MMA(ai, bj, At, Bt) do { __builtin_amdgcn_s_setprio(1); _Pragma("unroll") for (int m = 0; m < 4; ++m) _Pragma("unroll") for (int n = 0; n < 2; ++n) _Pragma("unroll") for (int k = 0; k < 2; ++k) \
        acc[ai][bj][m][n] = __builtin_amdgcn_mfma_f32_16x16x32_bf16(Bt[n][k], At[m][k], acc[ai][bj][m][n], 0, 0, 0); __builtin_amdgcn_s_setprio(0); } while (0)
#define PG8_WAIT_V(n) asm volatile("s_waitcnt vmcnt(" #n ")" ::: "memory")
#define PG8_WAIT_L(n) asm volatile("s_waitcnt lgkmcnt(" #n ")" ::: "memory")
#define PG8_BAR __builtin_amdgcn_s_barrier()
#define PG8_SCHED __builtin_amdgcn_sched_barrier(0)
    Unit cur, nxt; int ui = 0;
    if (!S.next(0, cur)) return;
    if constexpr (GATHER) {
#pragma unroll
        for (int h = 0; h < 2; ++h)
#pragma unroll
            for (int i = 0; i < 2; ++i) voffA[h][i] = S.row_off(cur, h * HALF + Rr[i]) + (unsigned)Cc[i] * 2u;
    }
    f32x4 acc[2][2][4][2];
#pragma unroll
    for (int a = 0; a < 2; ++a)
#pragma unroll
        for (int b = 0; b < 2; ++b)
#pragma unroll
            for (int m = 0; m < 4; ++m)
#pragma unroll
                for (int n = 0; n < 2; ++n) acc[a][b][m][n] = (f32x4){0.f, 0.f, 0.f, 0.f};
    bf16x8 At[4][2], B0[2][2], B1[2][2];
    const char* cA = cur.a; const char* cB = cur.b;
    PG8_STAGE(PG8_SB(0, 0), cB, voffB[0]); PG8_STAGE(PG8_SB(0, 1), cB, voffB[1]); PG8_STAGE(PG8_SA(0, 0), cA, voffA[0]); PG8_STAGE(PG8_SA(0, 1), cA, voffA[1]);
    if (wr == 1) PG8_BAR;
    PG8_WAIT_V(2); PG8_BAR;
    PG8_STAGE(PG8_SB(1, 0), cB + kstep, voffB[0]); PG8_STAGE(PG8_SA(1, 0), cA + kstep, voffA[0]); PG8_STAGE(PG8_SB(1, 1), cB + kstep, voffB[1]);
    PG8_WAIT_V(6); PG8_BAR;
    for (;;) {
        const bool has_next = S.next(ui + 1, nxt);
        const char* nA = has_next ? nxt.a : cA; const char* nB = has_next ? nxt.b : cB;
        if constexpr (GATHER) {
#pragma unroll
            for (int h = 0; h < 2; ++h)
#pragma unroll
                for (int i = 0; i < 2; ++i) voffAn[h][i] = has_next ? S.row_off(nxt, h * HALF + Rr[i]) + (unsigned)Cc[i] * 2u : voffA[h][i];
        }
        for (int t = 0; t < nt; t += 2) {
            const bool last = (t == nt - 2);
            if (last) S.pace_arrive_wait(ui, wid, lane);
            const char* a1 = cA + (size_t)(t + 1) * kstep;
            const char* a2 = last ? nA : cA + (size_t)(t + 2) * kstep; const char* b2 = last ? nB : cB + (size_t)(t + 2) * kstep;
            const char* a3 = a2 + kstep; const char* b3 = b2 + kstep;
            PG8_LDB(B0, 0, 0); PG8_LDB(B1, 0, 1); PG8_SCHED; PG8_LDA(At, 0, 0); PG8_STAGE(PG8_SA(1, 1), a1, voffA[1]);
            if constexpr (GATHER) { if (last) {
#pragma unroll
                for (int h = 0; h < 2; ++h)
#pragma unroll
                    for (int i = 0; i < 2; ++i) voffA[h][i] = voffAn[h][i]; } }
            PG8_WAIT_V(8); PG8_WAIT_L(0); PG8_BAR; PG8_MMA(0, 0, At, B0); PG8_MMA(0, 1, At, B1); PG8_BAR; PG8_SCHED;
            PG8_LDA(At, 0, 1); PG8_STAGE(PG8_SB(0, 0), b2, voffB[0]); PG8_STAGE(PG8_SB(0, 1), b2, voffB[1]); PG8_STAGE(PG8_SA(0, 0), a2, voffA[0]);
            PG8_WAIT_V(8); PG8_WAIT_L(0); PG8_BAR; PG8_MMA(1, 0, At, B0); PG8_MMA(1, 1, At, B1); PG8_BAR; PG8_SCHED;
            PG8_LDB(B0, 1, 0); PG8_LDB(B1, 1, 1); PG8_SCHED; PG8_LDA(At, 1, 0); PG8_STAGE(PG8_SA(0, 1), a2, voffA[1]);
            PG8_WAIT_V(8); PG8_WAIT_L(0); PG8_BAR; PG8_MMA(0, 0, At, B0); PG8_MMA(0, 1, At, B1); PG8_BAR; PG8_SCHED;
            PG8_LDA(At, 1, 1); PG8_STAGE(PG8_SB(1, 0), b3, voffB[0]); PG8_STAGE(PG8_SB(1, 1), b3, voffB[1]); PG8_STAGE(PG8_SA(1, 0), a3, voffA[0]);
            PG8_WAIT_V(8); PG8_WAIT_L(0); PG8_BAR; PG8_MMA(1, 0, At, B0); PG8_MMA(1, 1, At, B1); PG8_BAR; PG8_SCHED;
        }
        if constexpr (ALIGN_EPI) { if (wr == 0) PG8_BAR; }
        E(acc, cur, wr, wc, fr, fq);
        if (!has_next) { S.pace_finish(ui + 1, wid, lane); break; }
#pragma unroll
        for (int a = 0; a < 2; ++a)
#pragma unroll
            for (int b = 0; b < 2; ++b)
#pragma unroll
                for (int m = 0; m < 4; ++m)
#pragma unroll
                    for (int n = 0; n < 2; ++n) acc[a][b][m][n] = (f32x4){0.f, 0.f, 0.f, 0.f};
        cur = nxt; cA = nA; cB = nB; ++ui;
        if constexpr (ALIGN_EPI) { if (wr == 1) PG8_BAR; }
    }
    PG8_WAIT_V(0);
    if constexpr (!ALIGN_EPI) { if (wr == 0) PG8_BAR; }
    PG8_BAR;
#undef PG8_SA
#undef PG8_SB
#undef PG8_STAGE
#undef PG8_LDA
#undef PG8_LDB
#undef PG8_MMA
#undef PG8_WAIT_V
#undef PG8_WAIT_L
#undef PG8_BAR
#undef PG8_SCHED
}

__device__ __forceinline__ void line_pair(const u32x4 v0, const u32x4 v1, const bool odd, u32x4& a, u32x4& b) {
#pragma unroll
    for (int j = 0; j < 4; ++j) { const unsigned x = odd ? v0[j] : v1[j]; const unsigned y = (unsigned)__builtin_amdgcn_update_dpp(0, (int)x, 0xB1, 0xf, 0xf, false);
        a[j] = odd ? y : v0[j]; b[j] = odd ? v1[j] : y; }
}
__device__ __forceinline__ float fsig(float x) { return __builtin_amdgcn_rcpf(1.f + fexp2(x * -LOG2E)); }
__device__ __forceinline__ u32x4 pack8(const f32x4 a, const f32x4 b) { u32x4 w; w.x = cvt_pk_bf16(a[0], a[1]); w.y = cvt_pk_bf16(a[2], a[3]); w.z = cvt_pk_bf16(b[0], b[1]); w.w = cvt_pk_bf16(b[2], b[3]); return w; }
__device__ __forceinline__ void unpack8(const u32x4 w, f32x4& a, f32x4& b) {
    a[0] = __uint_as_float(w.x << 16); a[1] = __uint_as_float(w.x & 0xffff0000u); a[2] = __uint_as_float(w.y << 16); a[3] = __uint_as_float(w.y & 0xffff0000u);
    b[0] = __uint_as_float(w.z << 16); b[1] = __uint_as_float(w.z & 0xffff0000u); b[2] = __uint_as_float(w.w << 16); b[3] = __uint_as_float(w.w & 0xffff0000u); }

__device__ __forceinline__ unsigned pack4u8(const f32x4 g) { return (unsigned)(g[0] * 255.f + 0.5f) | ((unsigned)(g[1] * 255.f + 0.5f) << 8) | ((unsigned)(g[2] * 255.f + 0.5f) << 16) | ((unsigned)(g[3] * 255.f + 0.5f) << 24); }
__device__ __forceinline__ f32x4 unpack4u8(const unsigned w) { f32x4 g; g[0] = (float)(w & 0xffu); g[1] = (float)((w >> 8) & 0xffu); g[2] = (float)((w >> 16) & 0xffu); g[3] = (float)(w >> 24); return g * (1.f / 255.f); }
template <int MODE>
__device__ __forceinline__ void epiz_body(const f32x4 (&acc)[2][2][4][2], bf16* base, const int ldc, const int row0, const int oc, const float* vec, const int img_off = 0, const bool odd = false) {
    f32x4 bv[2][2];
#pragma unroll
    for (int bj = 0; bj < 2; ++bj)
#pragma unroll
        for (int n = 0; n < 2; ++n) bv[bj][n] = (MODE == 0 || MODE == 1 || MODE == 3) ? *(const f32x4*)(vec + bj * 32 + 4 * n) : (f32x4){0.f, 0.f, 0.f, 0.f};
#pragma unroll
    for (int ai = 0; ai < 2; ++ai)
#pragma unroll
        for (int m = 0; m < 4; ++m) { bf16* rowp = base + (size_t)(row0 + ai * HALF + m * 16) * ldc + oc; u32x4 pk[2], gb;
#pragma unroll
            for (int bj = 0; bj < 2; ++bj) { f32x4 v[2];
#pragma unroll
                for (int n = 0; n < 2; ++n) { f32x4 x = acc[ai][bj][m][n];
                    if (MODE == 0) x = (x + bv[bj][n]) * (0.125f * LOG2E);
                    else if (MODE == 1) x = x + bv[bj][n];
                    else if (MODE == 2) {
#pragma unroll
                        for (int j = 0; j < 4; ++j) x[j] = x[j] * fsig(x[j]); }
                    else if (MODE == 3) {
#pragma unroll
                        for (int j = 0; j < 4; ++j) { const float l = bv[bj][n][j]; x[j] = flog2(l + (1.f - l) * fsig(x[j])); } }
                    else if (MODE == 6) {
#pragma unroll
                        for (int j = 0; j < 4; ++j) x[j] = fsig(x[j]); }
                    v[n] = x; }
                if (MODE == 6) { gb[bj * 2] = pack4u8(v[0]); gb[bj * 2 + 1] = pack4u8(v[1]); }
                else pk[bj] = pack8(v[0], v[1]); }
            if (MODE == 6) *(u32x4*)((unsigned char*)base + (ai * 4 + m) * 8192 + img_off) = gb;
            if (MODE != 6) { u32x4 a, b; line_pair(pk[0], pk[1], odd, a, b); *(u32x4*)rowp = a; *(u32x4*)(rowp + ldc) = b; } }
}
struct EpiZ {
    static constexpr bool PERM = true;
    const float* bqkv; const float* lb; bf16* Q; bf16* KV; bf16* HG; bf16* GT;
    __device__ __forceinline__ void operator()(const f32x4 (&acc)[2][2][4][2], const Unit& u, int wr, int wc, int fr, int fq) const {
        const bool odd = fr & 1; const int row0 = u.pm * BM + wr * 64 + (fr & ~1), cb = u.pn * BM + wc * 64 + 8 * fq, cl = cb + (odd ? 32 : 0);
        if (u.pn < 4) epiz_body<0>(acc, Q, QW, row0, cl, bqkv + cb, 0, odd);
        else if (u.pn == 4) epiz_body<1>(acc, KV, 256, row0, cl - QW, bqkv + cb, 0, odd);
        else if (u.pn < 21) { const int ct = (u.pn - 5) * 256 + (wc >> 1) * 128; bf16* hb = HG + (size_t)((ct >> 10) * 8 + ((ct >> 7) & 7)) * HGPS; const int oc = (wc & 1) * 64 + 8 * fq + (odd ? 32 : 0);
            if (u.pn < 9) epiz_body<2>(acc, hb, 128, row0, oc, nullptr, 0, odd);
            else if (u.pn < 13) epiz_body<3>(acc, hb, 128, row0, oc, lb + ((cb - QKVW) & 1023), 0, odd);
            else if (u.pn < 17) epiz_body<4>(acc, hb, 128, row0, oc, nullptr, 0, odd);
            else epiz_body<2>(acc, hb, 128, row0, oc, nullptr, 0, odd); }
        else epiz_body<6>(acc, (bf16*)((unsigned char*)GT + (size_t)(u.pm * 16 + (u.pn - 21)) * 65536), 0, 0, 0, nullptr, (wr * 4 + wc) * 1024 + (fq * 16 + fr) * 16);
    }
};
struct EpiMix {
    static constexpr bool PERM = true;
    const bf16* GT; bf16* MIX; unsigned char* PART;
    template <bool SECOND>
    __device__ __forceinline__ void body(const f32x4 (&acc)[2][2][4][2], const int row0, const int cl, const bool odd, const unsigned char* gimg, unsigned char* pimg) const {
#pragma unroll
        for (int ai = 0; ai < 2; ++ai)
#pragma unroll
        for (int mh = 0; mh < 2; ++mh) {
            u32x4 g[2], o[2][2];
#pragma unroll
            for (int m2 = 0; m2 < 2; ++m2) {
                g[m2] = __builtin_nontemporal_load((const u32x4*)(gimg + (ai * 4 + 2 * mh + m2) * 8192));
#pragma unroll
                for (int bj = 0; bj < 2; ++bj) {
                    if (SECOND) o[m2][bj] = *(const u32x4*)(pimg + ((ai * 4 + 2 * mh + m2) * 2 + bj) * 8192); } }
#pragma unroll
            for (int m2 = 0; m2 < 2; ++m2) { const int m = 2 * mh + m2; u32x4 pk[2];
#pragma unroll
                for (int bj = 0; bj < 2; ++bj) {
                    const f32x4 g0 = unpack4u8(g[m2][bj * 2]), g1 = unpack4u8(g[m2][bj * 2 + 1]);
                    f32x4 v0 = acc[ai][bj][m][0] * g0, v1 = acc[ai][bj][m][1] * g1;
                    if (SECOND) { f32x4 o0, o1; unpack8(o[m2][bj], o0, o1); v0 += o0; v1 += o1; }
                    if (SECOND) pk[bj] = pack8(v0, v1); else *(u32x4*)(pimg + ((ai * 4 + m) * 2 + bj) * 8192) = pack8(v0, v1); }
                if (SECOND) { u32x4 a, b; line_pair(pk[0], pk[1], odd, a, b); bf16* rp = MIX + (size_t)(row0 + ai * HALF + m * 16) * D + cl; *(u32x4*)rp = a; *(u32x4*)(rp + D) = b; } }
        }
    }
    __device__ __forceinline__ void operator()(const f32x4 (&acc)[2][2][4][2], const Unit& u, int wr, int wc, int fr, int fq) const {
        const bool odd = fr & 1; const int row0 = u.pm * BM + wr * 64 + (fr & ~1), cl = u.pn * BM + wc * 64 + 8 * fq + (odd ? 32 : 0);
        const unsigned char* gimg = (const unsigned char*)GT + (size_t)(u.pm * 16 + (u.e ? 8 : 0) + u.pn) * 65536 + (wr * 4 + wc) * 1024 + (fq * 16 + fr) * 16;
        unsigned char* pimg = PART + (wr * 4 + wc) * 1024 + (fq * 16 + fr) * 16;
        if (u.e) body<true>(acc, row0, cl, odd, gimg, pimg); else body<false>(acc, row0, cl, odd, gimg, pimg);
    }
};
__device__ __forceinline__ void ss_slot(float s, float* SS, int row, int slot, int fq) {
    s += __shfl_xor(s, 16); s += __shfl_xor(s, 32);
    if (fq == 0) SS[(size_t)row * 32 + slot] = s;
}
struct EpiDelta {
    static constexpr bool PERM = true;
    bf16* DL;
    __device__ __forceinline__ void operator()(const f32x4 (&acc)[2][2][4][2], const Unit& u, int wr, int wc, int fr, int fq) const {
        unsigned char* dimg = (unsigned char*)DL + (size_t)(u.pm * 8 + u.pn) * 131072 + (wr * 4 + wc) * 1024 + (fq * 16 + fr) * 16;
#pragma unroll
        for (int ai = 0; ai < 2; ++ai)
#pragma unroll
            for (int m = 0; m < 4; ++m)
#pragma unroll
                for (int bj = 0; bj < 2; ++bj) *(u32x4*)(dimg + ((ai * 4 + m) * 2 + bj) * 8192) = pack8(acc[ai][bj][m][0], acc[ai][bj][m][1]);
    }
};
struct EpiPleRaw {
    static constexpr bool PERM = true;
    bf16* PL; float* SS;
    __device__ __forceinline__ void operator()(const f32x4 (&acc)[2][2][4][2], const Unit& u, int wr, int wc, int fr, int fq) const {
        const int row0 = u.pm * BM + wr * 64 + fr;
        unsigned char* pimg = (unsigned char*)PL + (size_t)(u.pm * 8 + u.pn) * 131072 + (wr * 4 + wc) * 1024 + (fq * 16 + fr) * 16;
#pragma unroll
        for (int ai = 0; ai < 2; ++ai)
#pragma unroll
            for (int m = 0; m < 4; ++m) { const int row = row0 + ai * HALF + m * 16; float s = 0.f;
#pragma unroll
                for (int bj = 0; bj < 2; ++bj) { const f32x4 a = acc[ai][bj][m][0], b = acc[ai][bj][m][1];
                    s += ((a[0] * a[0] + a[1] * a[1]) + (a[2] * a[2] + a[3] * a[3])) + ((b[0] * b[0] + b[1] * b[1]) + (b[2] * b[2] + b[3] * b[3]));
                    *(u32x4*)(pimg + ((ai * 4 + m) * 2 + bj) * 8192) = pack8(a, b); }
                ss_slot(s, SS, row, u.pn * 4 + wc, fq); }
    }
};
struct EpiPleGate {
    static constexpr bool PERM = true;
    bf16* UPD; const bf16* PL; const float* rstd3; const float* rstdp; const float* gple;
    __device__ __forceinline__ void operator()(const f32x4 (&acc)[2][2][4][2], const Unit& u, int wr, int wc, int fr, int fq) const {
        const bool odd = fr & 1; const int row0 = u.pm * BM + wr * 64 + fr, cb = u.pn * BM + wc * 64 + 8 * fq, cl = cb + (odd ? 32 : 0);
        const unsigned char* pimg = (const unsigned char*)PL + (size_t)(u.pm * 8 + u.pn) * 131072 + (wr * 4 + wc) * 1024 + (fq * 16 + fr) * 16;
        f32x4 gp[2][2];
#pragma unroll
        for (int bj = 0; bj < 2; ++bj)
#pragma unroll
            for (int n = 0; n < 2; ++n) gp[bj][n] = *(const f32x4*)(gple + cb + bj * 32 + 4 * n);
#pragma unroll
        for (int ai = 0; ai < 2; ++ai) {
            u32x4 pp[4][2]; float r3[4], rp[4];
#pragma unroll
            for (int m = 0; m < 4; ++m) { const int row = row0 + ai * HALF + m * 16; r3[m] = rstd3[row]; rp[m] = rstdp[row];
#pragma unroll
                for (int bj = 0; bj < 2; ++bj) pp[m][bj] = __builtin_nontemporal_load((const u32x4*)(pimg + ((ai * 4 + m) * 2 + bj) * 8192)); }
#pragma unroll
            for (int m = 0; m < 4; ++m) { const int row = (row0 & ~1) + ai * HALF + m * 16; u32x4 pk[2];
#pragma unroll
                for (int bj = 0; bj < 2; ++bj) {
                    f32x4 p0, p1; unpack8(pp[m][bj], p0, p1);
                    f32x4 g0 = acc[ai][bj][m][0] * r3[m], g1 = acc[ai][bj][m][1] * r3[m];
#pragma unroll
                    for (int j = 0; j < 4; ++j) { g0[j] = fsig(g0[j]); g1[j] = fsig(g1[j]); }
                    pk[bj] = pack8(p0 * rp[m] * gp[bj][0] * g0, p1 * rp[m] * gp[bj][1] * g1); }
                u32x4 a, b; line_pair(pk[0], pk[1], odd, a, b); bf16* up = UPD + (size_t)row * D + cl; *(u32x4*)up = a; *(u32x4*)(up + D) = b; }
        }
    }
};

struct MoeOrder {
    const LAS int* eoff; const LAS int* ecnt; int NT, G, c, total_rb; const char* A; const char* W; size_t wexp, tstepB, arow_bytes; const unsigned short* LIST; int gather;
    __device__ __forceinline__ bool next(int i, Unit& u) const {
        const int it = i * G + c; if (it >= total_rb * NT) return false;
        const int rb = it / NT, pn = it % NT, row0 = rb * BM;
        int e = 0; { int hi = NEXP;
#pragma unroll
            for (int st = 0; st < 6; ++st) { const int mid = (e + hi) >> 1; if (eoff[mid] <= row0) e = mid; else hi = mid; } }
        e = __builtin_amdgcn_readfirstlane(e);
        u.pm = rb; u.pn = pn; u.e = e; u.r0 = __builtin_amdgcn_readfirstlane(row0 - eoff[e]); u.cnt = __builtin_amdgcn_readfirstlane(ecnt[e]); u.row0 = row0;
        u.a = gather ? A : A + (size_t)row0 * arow_bytes; u.b = W + (size_t)e * wexp + (size_t)pn * tstepB; return true;
    }
    __device__ __forceinline__ void pace_arrive_wait(int, int, int) const {}
    __device__ __forceinline__ void pace_finish(int, int, int) const {}
    __device__ __forceinline__ unsigned row_off(const Unit& u, int row) const {
        const unsigned short* lp = LIST + (size_t)u.e * NTOK + u.r0;
        const unsigned tok = (row < u.cnt - u.r0) ? (unsigned)(lp[row] & 0x7fffu) : 0u; return tok * (unsigned)arow_bytes;
    }
};
struct EpiGateUp {
    static constexpr bool PERM = true;
    bf16* HID; const unsigned short* LIST; const float* RSTD2;
    __device__ __forceinline__ void operator()(const f32x4 (&acc)[2][2][4][2], const Unit& u, int wr, int wc, int fr, int fq) const {
        const int row0 = u.row0 + wr * 64 + fr, cb = u.pn * HALF + wc * 32 + 8 * fq;
        const unsigned short* lp = LIST + (size_t)u.e * NTOK + u.r0;
        unsigned tk[2][4]; float rs[2][4];
#pragma unroll
        for (int ai = 0; ai < 2; ++ai)
#pragma unroll
            for (int m = 0; m < 4; ++m) { const int lr = ai * HALF + wr * 64 + m * 16 + fr; tk[ai][m] = (lr < u.cnt - u.r0) ? (unsigned)(lp[lr] & 0x7fffu) : 0u; }
#pragma unroll
        for (int ai = 0; ai < 2; ++ai)
#pragma unroll
            for (int m = 0; m < 4; ++m) rs[ai][m] = RSTD2[tk[ai][m]];
#pragma unroll
        for (int ai = 0; ai < 2; ++ai)
#pragma unroll
            for (int m = 0; m < 4; ++m) { f32x4 v[2];
#pragma unroll
                for (int n = 0; n < 2; ++n) { const f32x4 g = acc[ai][0][m][n] * rs[ai][m], up = acc[ai][1][m][n] * rs[ai][m];
#pragma unroll
                    for (int j = 0; j < 4; ++j) v[n][j] = g[j] * fsig(g[j]) * up[j]; }
                *(u32x4*)(HID + (size_t)(row0 + ai * HALF + m * 16) * MH + cb) = pack8(v[0], v[1]); }
    }
};
struct EpiDown {
    static constexpr bool PERM = true;
    const unsigned short* LIST; const float* TW; bf16* Y;
    __device__ __forceinline__ void operator()(const f32x4 (&acc)[2][2][4][2], const Unit& u, int wr, int wc, int fr, int fq) const {
        const bool odd = fr & 1; const int cl = u.pn * BM + wc * 64 + 8 * fq + (odd ? 32 : 0);
        const unsigned short* lp = LIST + (size_t)u.e * NTOK + u.r0;
        unsigned entE[2][4], entO[2][4]; float w[2][4];
#pragma unroll
        for (int ai = 0; ai < 2; ++ai)
#pragma unroll
            for (int m = 0; m < 4; ++m) { const int lr = ai * HALF + wr * 64 + m * 16 + (fr & ~1), nv = u.cnt - u.r0;
                entE[ai][m] = (lr < nv) ? (unsigned)lp[lr] : 0x10000u; entO[ai][m] = (lr + 1 < nv) ? (unsigned)lp[lr + 1] : 0x10000u; }
#pragma unroll
        for (int ai = 0; ai < 2; ++ai)
#pragma unroll
            for (int m = 0; m < 4; ++m) { const unsigned a = entE[ai][m], b = entO[ai][m], eo = odd ? b : a; w[ai][m] = TW[(eo & 0x7fffu) * 2 + ((eo >> 15) & 1u)]; }
#pragma unroll
        for (int ai = 0; ai < 2; ++ai)
#pragma unroll
            for (int m = 0; m < 4; ++m) { u32x4 a, b;
                line_pair(pack8(acc[ai][0][m][0] * w[ai][m], acc[ai][0][m][1] * w[ai][m]), pack8(acc[ai][1][m][0] * w[ai][m], acc[ai][1][m][1] * w[ai][m]), odd, a, b);
#pragma unroll
                for (int o = 0; o < 2; ++o) { const unsigned e = o ? entO[ai][m] : entE[ai][m]; if (!(e & 0x10000u)) { const unsigned tok = e & 0x7fffu, k = (e >> 15) & 1u;
                    *(u32x4*)(Y + (size_t)k * NTOK * D + (size_t)tok * D + cl) = o ? b : a; } } }
    }
};
}

namespace hg {
typedef short s16x4 __attribute__((ext_vector_type(4)));
typedef short bf16x8 __attribute__((ext_vector_type(8)));
typedef __bf16 bfv2 __attribute__((ext_vector_type(2)));
typedef float fv2 __attribute__((ext_vector_type(2)));
constexpr int RS = 272, IMG = 64 * RS;
constexpr int L_QI = 0, L_QR = IMG, L_KR = 2 * IMG, L_KL = 3 * IMG, L_V = 4 * IMG;
constexpr int L_SEG = 5 * IMG, L_D = L_SEG + 4096, L_RED = L_D + 512, L_RSTD = L_RED + 2048, L_END = L_RSTD + 256;
__device__ __forceinline__ unsigned cvtpk(float lo, float hi) { fv2 v; v.x = lo; v.y = hi; return __builtin_bit_cast(unsigned, __builtin_convertvector(v, bfv2)); }
__device__ __forceinline__ float blo(unsigned u) { return __uint_as_float(u << 16); }
__device__ __forceinline__ float bhi(unsigned u) { return __uint_as_float(u & 0xffff0000u); }
__device__ __forceinline__ bf16x8 frag_from2(const f32x4 a, const f32x4 b) { v4u w; w.x = cvtpk(a[0], a[1]); w.y = cvtpk(a[2], a[3]); w.z = cvtpk(b[0], b[1]); w.w = cvtpk(b[2], b[3]); return __builtin_bit_cast(bf16x8, w); }
__device__ __forceinline__ bf16x8 frag_tr2(LAS unsigned char* p0, LAS unsigned char* p1) {
    const s16x4 lo = __builtin_amdgcn_ds_read_tr16_b64_v4i16((LAS s16x4*)p0), hi = __builtin_amdgcn_ds_read_tr16_b64_v4i16((LAS s16x4*)p1);
    return __builtin_shufflevector(lo, hi, 0, 1, 2, 3, 4, 5, 6, 7); }
__device__ __forceinline__ bf16x8 frag_2x8(LAS unsigned char* p0, LAS unsigned char* p1) { v4u w; const v2u a = *(const LAS v2u*)p0, b = *(const LAS v2u*)p1; w.x = a.x; w.y = a.y; w.z = b.x; w.w = b.y; return __builtin_bit_cast(bf16x8, w); }
__device__ __forceinline__ float row_sum16(float s) {
    s += __int_as_float(__builtin_amdgcn_update_dpp(0, __float_as_int(s), 0x128, 0xf, 0xf, false));
    s += __int_as_float(__builtin_amdgcn_update_dpp(0, __float_as_int(s), 0x124, 0xf, 0xf, false));
    s += __int_as_float(__builtin_amdgcn_update_dpp(0, __float_as_int(s), 0x122, 0xf, 0xf, false));
    s += __int_as_float(__builtin_amdgcn_update_dpp(0, __float_as_int(s), 0x121, 0xf, 0xf, false));
    return s; }
#define HG_MFMA(a, b, c) __builtin_amdgcn_mfma_f32_16x16x32_bf16((a), (b), (c), 0, 0, 0)

template <bool P1>
__device__ __forceinline__ void unit(LAS unsigned char* lds, const bf16* HG, bf16* OREC, float* UST, float* DST, const float* ghg, const int u, const int tid) {
    const int lane = tid & 63, w = __builtin_amdgcn_readfirstlane(tid >> 6), r = lane & 15, q = lane >> 4;
    const int bh = u >> 5, j = u & 31, b = bh >> 3, h = bh & 7;
    const size_t row0 = (size_t)b * SEQ + (size_t)j * 512;
    f32x4 Sacc[8];
    float* ust = UST + (size_t)u * 16384 + (size_t)w * 2048 + lane;
#pragma unroll
    for (int kt = 0; kt < 8; ++kt)
#pragma unroll
        for (int rg = 0; rg < 4; ++rg) Sacc[kt][rg] = P1 ? 0.f : ust[(kt * 4 + rg) * 64];
    fv2 btot; btot.x = 0.f; btot.y = 0.f;
    unsigned gq[8], gg[8]; v4u rv[2], rgr[2];
#define HG_LOAD_RAW(c) do { const bf16* gp_ = HG + (size_t)h * HGPS + (row0 + (size_t)(c) * 64 + 8 * w) * 128 + 2 * lane; \
        _Pragma("unroll") for (int i = 0; i < 8; ++i) { if (!P1) { gq[i] = __builtin_nontemporal_load((const unsigned*)(gp_ + (size_t)i * 128)); gg[i] = __builtin_nontemporal_load((const unsigned*)(gp_ + (size_t)i * 128 + 8 * HGPS)); } else gg[i] = *(const unsigned*)(gp_ + (size_t)i * 128 + 8 * HGPS); } \
        _Pragma("unroll") for (int i = 0; i < 2; ++i) { const int ci_ = tid + 512 * i; const bf16* vp_ = HG + (size_t)h * HGPS + (row0 + (size_t)(c) * 64 + (ci_ >> 4)) * 128 + (ci_ & 15) * 8; \
            if (!P1) { rv[i] = __builtin_nontemporal_load((const v4u*)(vp_ + 16 * HGPS)); rgr[i] = __builtin_nontemporal_load((const v4u*)(vp_ + 24 * HGPS)); } else rv[i] = *(const v4u*)(vp_ + 16 * HGPS); } } while (0)
    HG_LOAD_RAW(0);
#pragma unroll 1
    for (int c = 0; c < 8; ++c) {
        const size_t rowc = row0 + (size_t)c * 64;
#pragma unroll
        for (int i = 0; i < 2; ++i) { const int ci = tid + 512 * i; *(LAS v4u*)(lds + L_V + (ci >> 4) * RS + (ci & 15) * 16) = rv[i]; }
        float c0[8], c1[8]; { float r0 = 0.f, r1 = 0.f;
#pragma unroll
            for (int i = 0; i < 8; ++i) { r0 += blo(gg[i]); r1 += bhi(gg[i]); c0[i] = r0; c1[i] = r1; }
            fv2 sv; sv.x = r0; sv.y = r1; *(LAS fv2*)(lds + L_SEG + (w * 128 + 2 * lane) * 4) = sv; }
        v4u grk[2];
        if (!P1) { grk[0] = rgr[0]; grk[1] = rgr[1]; }
        __syncthreads();
        float off0 = 0.f, off1 = 0.f, ref0 = 0.f, ref1 = 0.f, tot0 = 0.f, tot1 = 0.f;
#pragma unroll
        for (int s = 0; s < 8; ++s) { const fv2 sv = *(const LAS fv2*)(lds + L_SEG + (s * 128 + 2 * lane) * 4);
            if (s < w) { off0 += sv.x; off1 += sv.y; } if (s < 4) { ref0 += sv.x; ref1 += sv.y; } tot0 += sv.x; tot1 += sv.y; }
        if (w == 0) { fv2 dv; dv.x = fexp2(tot0); dv.y = fexp2(tot1); *(LAS fv2*)(lds + L_D + 2 * lane * 4) = dv; btot.x += tot0; btot.y += tot1; }
#pragma unroll
        for (int i = 0; i < 8; ++i) {
            const int t = 8 * w + i; const float b0 = off0 + c0[i], b1 = off1 + c1[i];
            const float k0 = 1.f - fexp2(blo(gg[i])), k1 = 1.f - fexp2(bhi(gg[i]));
            *(LAS unsigned*)(lds + L_KL + t * RS + 4 * lane) = cvtpk(k0 * fexp2(tot0 - b0), k1 * fexp2(tot1 - b1));
            if (!P1) { const float q0 = blo(gq[i]), q1 = bhi(gq[i]);
                *(LAS unsigned*)(lds + L_QI + t * RS + 4 * lane) = cvtpk(q0 * fexp2(b0), q1 * fexp2(b1));
                *(LAS unsigned*)(lds + L_QR + t * RS + 4 * lane) = cvtpk(q0 * fexp2(b0 - ref0), q1 * fexp2(b1 - ref1));
                *(LAS unsigned*)(lds + L_KR + t * RS + 4 * lane) = cvtpk(k0 * fexp2(ref0 - b0), k1 * fexp2(ref1 - b1)); }
        }
        __syncthreads();
        if (c + 1 < 8) HG_LOAD_RAW(c + 1);
        bf16x8 Vf[2];
#pragma unroll
        for (int cp = 0; cp < 2; ++cp) { LAS unsigned char* p0 = lds + L_V + (32 * cp + 4 * q + (r >> 2)) * RS + (16 * w + 4 * (r & 3)) * 2; Vf[cp] = frag_tr2(p0, p0 + 16 * RS); }
        f32x4 Oacc[4];
        if (!P1) {
#pragma unroll
            for (int ti = 0; ti < 4; ++ti) Oacc[ti] = (f32x4){0.f, 0.f, 0.f, 0.f};
#pragma unroll
            for (int cc = 0; cc < 4; ++cc) { const bf16x8 Sf = frag_from2(Sacc[2 * cc], Sacc[2 * cc + 1]);
#pragma unroll
                for (int ti = 0; ti < 4; ++ti) { LAS unsigned char* p = lds + L_QI + (16 * ti + r) * RS + 64 * cc + 8 * q; Oacc[ti] = HG_MFMA(frag_2x8(p, p + 32), Sf, Oacc[ti]); } }
#pragma unroll
            for (int ti = 0; ti < 4; ++ti) {
                f32x4 AT[4];
#pragma unroll
                for (int si = 0; si < 4; ++si) { AT[si] = (f32x4){0.f, 0.f, 0.f, 0.f};
                    if (si <= ti) {
#pragma unroll
                        for (int cc = 0; cc < 4; ++cc) { const bf16x8 A = *(const LAS bf16x8*)(lds + L_KR + (16 * si + r) * RS + 64 * cc + 16 * q); const bf16x8 B = *(const LAS bf16x8*)(lds + L_QR + (16 * ti + r) * RS + 64 * cc + 16 * q);
                            AT[si] = HG_MFMA(A, B, AT[si]); }
                        if (si == ti) {
#pragma unroll
                            for (int rg = 0; rg < 4; ++rg) if (4 * q + rg > r) AT[si][rg] = 0.f; }
                    } }
#pragma unroll
                for (int cp = 0; cp < 2; ++cp) if (cp <= (ti >> 1)) Oacc[ti] = HG_MFMA(frag_from2(AT[2 * cp], AT[2 * cp + 1]), Vf[cp], Oacc[ti]);
            }
        }
#pragma unroll
        for (int kt = 0; kt < 8; ++kt) { const f32x4 dv = *(const LAS f32x4*)(lds + L_D + (16 * kt + 4 * q) * 4); Sacc[kt] = Sacc[kt] * dv;
#pragma unroll
            for (int cp = 0; cp < 2; ++cp) { LAS unsigned char* p0 = lds + L_KL + (32 * cp + 4 * q + (r >> 2)) * RS + (16 * kt + 4 * (r & 3)) * 2; Sacc[kt] = HG_MFMA(frag_tr2(p0, p0 + 16 * RS), Vf[cp], Sacc[kt]); } }
        if (P1) { __syncthreads(); }
        else {
#pragma unroll
            for (int ti = 0; ti < 4; ++ti)
#pragma unroll
                for (int rg = 0; rg < 4; ++rg) { float s = Oacc[ti][rg] * Oacc[ti][rg];
                    s = row_sum16(s);
                    if (r == 0) *(LAS float*)(lds + L_RED + ((16 * ti + 4 * q + rg) * 8 + w) * 4) = s; }
            __syncthreads();
            if (tid < 64) { const f32x4 a = *(const LAS f32x4*)(lds + L_RED + tid * 32), bq = *(const LAS f32x4*)(lds + L_RED + tid * 32 + 16);
                *(LAS float*)(lds + L_RSTD + tid * 4) = rsqrtf((((a[0] + a[1]) + (a[2] + a[3])) + ((bq[0] + bq[1]) + (bq[2] + bq[3]))) * (1.f / 128.f) + EPS); }
            __syncthreads();
            { const float gv = ghg[16 * w + r];
#pragma unroll
                for (int ti = 0; ti < 4; ++ti) { const f32x4 rs = *(const LAS f32x4*)(lds + L_RSTD + (16 * ti + 4 * q) * 4);
#pragma unroll
                    for (int rg = 0; rg < 4; ++rg) *(LAS bf16*)(lds + L_QI + (16 * ti + 4 * q + rg) * RS + (16 * w + r) * 2) = (bf16)(cvtpk(Oacc[ti][rg] * rs[rg] * gv, 0.f) & 0xffffu); } }
            __syncthreads();
#pragma unroll
            for (int i = 0; i < 2; ++i) { const int ci = tid + 512 * i, row = ci >> 4, c16 = ci & 15;
                const v4u ov = *(const LAS v4u*)(lds + L_QI + row * RS + c16 * 16); const v4u gv = grk[i]; v4u o;
                o.x = cvtpk(blo(ov.x) * blo(gv.x), bhi(ov.x) * bhi(gv.x)); o.y = cvtpk(blo(ov.y) * blo(gv.y), bhi(ov.y) * bhi(gv.y));
                o.z = cvtpk(blo(ov.z) * blo(gv.z), bhi(ov.z) * bhi(gv.z)); o.w = cvtpk(blo(ov.w) * blo(gv.w), bhi(ov.w) * bhi(gv.w));
                *(v4u*)(OREC + (rowc + row) * HW + h * 128 + c16 * 8) = o; }
        }
    }
    if (P1) {
#pragma unroll
        for (int kt = 0; kt < 8; ++kt)
#pragma unroll
            for (int rg = 0; rg < 4; ++rg) ust[(kt * 4 + rg) * 64] = Sacc[kt][rg];
        if (w == 0) { fv2 dv; dv.x = fexp2(btot.x); dv.y = fexp2(btot.y); *(fv2*)(DST + (size_t)u * 128 + 2 * lane) = dv; }
    }
    __syncthreads();
#undef HG_LOAD_RAW
}
__device__ __forceinline__ void scan(float* UST, const float* DST, int gtid, int nthr) {
    for (int e = gtid; e < 16 * 16384; e += nthr) {
        const int bh = e >> 14, el = e & 16383, ln = el & 63, rg = (el >> 6) & 3, kt = (el >> 8) & 7, k = 16 * kt + 4 * (ln >> 4) + rg;
        float uu[32], dd[32];
        float* p0 = UST + (size_t)bh * 32 * 16384 + el; const float* d0 = DST + (size_t)bh * 32 * 128 + k;
#pragma unroll
        for (int j = 0; j < 32; ++j) { uu[j] = p0[(size_t)j * 16384]; dd[j] = d0[j * 128]; }
        float T = 0.f;
#pragma unroll
        for (int j = 0; j < 32; ++j) { p0[(size_t)j * 16384] = T; T = dd[j] * T + uu[j]; }
    }
}
}

namespace at {
typedef short bf16x8 __attribute__((ext_vector_type(8)));
constexpr int RSK = 144;
constexpr int L_K = 0, L_V = 272 * RSK, L_B = 2 * 272 * RSK, L_O = L_B + 4096, OW = 16 * RSK, L_END = L_O + 8 * OW;
__device__ __forceinline__ void item(LAS unsigned char* lds, bf16* QB, const bf16* KVB, const float* sinks, const float* rel, const int it, const int tid) {
    const int lane = tid & 63, w = __builtin_amdgcn_readfirstlane(tid >> 6), r = lane & 15, q = lane >> 4;
    const int kvh = it & 1, blk = (it >> 1) & 127, b = it >> 8, head = kvh * 8 + w;
    const size_t tok0 = (size_t)b * SEQ + (size_t)blk * 128;
    __syncthreads();
#pragma unroll
    for (int i = 0; i < 4; ++i) { const int ci = tid + 512 * i, row = ci >> 3, c8 = ci & 7; v4u kk = (v4u){0u, 0u, 0u, 0u}, vv = (v4u){0u, 0u, 0u, 0u};
        if (blk > 0 || row >= 128) { const bf16* p = KVB + (tok0 - 128 + row) * 256 + kvh * 64 + c8 * 8; kk = *(const v4u*)p; vv = *(const v4u*)(p + 128); }
        *(LAS v4u*)(lds + L_K + row * RSK + c8 * 16) = kk; *(LAS v4u*)(lds + L_V + row * RSK + c8 * 16) = vv; }
    if (tid < 128) *(LAS v4u*)(lds + L_V + (256 + (tid >> 3)) * RSK + (tid & 7) * 16) = (v4u){0u, 0u, 0u, 0u};
#pragma unroll
    for (int i = 0; i < 2; ++i) { const int e = tid + 512 * i, g = e >> 7, d = e & 127; int bk;
        if (d < 16) bk = d; else { bk = 16 + (int)(__logf((float)d * (1.f / 16.f)) / 2.0794415416798357f * 16.f); if (bk > 31) bk = 31; }
        *(LAS float*)(lds + L_B + e * 4) = rel[bk * 16 + kvh * 8 + g] * LOG2E; }
    __syncthreads();
    float bv[9][4];
#pragma unroll
    for (int kt = 0; kt < 9; ++kt)
#pragma unroll
        for (int rg = 0; rg < 4; ++rg) { const int dist = 128 - 16 * kt + r - 4 * q - rg; const bool ok = dist >= 0 && dist < 128;
            const float bb = *(const LAS float*)(lds + L_B + (w * 128 + (ok ? dist : 0)) * 4); bv[kt][rg] = ok ? bb : -1e30f; }
    const float sink = sinks[head] * LOG2E;
    bf16x8 Qn0, Qn1; { const bf16* qrow = QB + (tok0 + r) * QW + head * 64 + 8 * q; Qn0 = *(const bf16x8*)qrow; Qn1 = *(const bf16x8*)(qrow + 32); }
#pragma unroll 1
    for (int qt = 0; qt < 8; ++qt) {
        const bf16x8 Qf0 = Qn0, Qf1 = Qn1;
        if (qt + 1 < 8) { const bf16* qrow = QB + (tok0 + 16 * (qt + 1) + r) * QW + head * 64 + 8 * q; Qn0 = *(const bf16x8*)qrow; Qn1 = *(const bf16x8*)(qrow + 32); }
        f32x4 ST[9];
#pragma unroll
        for (int kt = 0; kt < 9; ++kt) {
            if (blk == 0 && qt + kt < 8) { ST[kt] = (f32x4){-1e30f, -1e30f, -1e30f, -1e30f}; }
            else { LAS unsigned char* kp = lds + L_K + (16 * (qt + kt) + r) * RSK + 16 * q; f32x4 a = (f32x4){0.f, 0.f, 0.f, 0.f};
                a = __builtin_amdgcn_mfma_f32_16x16x32_bf16(*(const LAS bf16x8*)kp, Qf0, a, 0, 0, 0); a = __builtin_amdgcn_mfma_f32_16x16x32_bf16(*(const LAS bf16x8*)(kp + 64), Qf1, a, 0, 0, 0);
#pragma unroll
                for (int rg = 0; rg < 4; ++rg) ST[kt][rg] = a[rg] + bv[kt][rg]; } }
        float m = sink;
#pragma unroll
        for (int kt = 0; kt < 9; ++kt)
#pragma unroll
            for (int rg = 0; rg < 4; ++rg) m = fmaxf(m, ST[kt][rg]);
        m = fmaxf(m, __shfl_xor(m, 16)); m = fmaxf(m, __shfl_xor(m, 32));
        float l = 0.f;
#pragma unroll
        for (int kt = 0; kt < 9; ++kt)
#pragma unroll
            for (int rg = 0; rg < 4; ++rg) { const float p = fexp2(ST[kt][rg] - m); ST[kt][rg] = p; l += p; }
        l += __shfl_xor(l, 16); l += __shfl_xor(l, 32);
        const float inv = 1.f / (l + fexp2(sink - m));
        f32x4 O[4];
#pragma unroll
        for (int dt = 0; dt < 4; ++dt) O[dt] = (f32x4){0.f, 0.f, 0.f, 0.f};
#pragma unroll
        for (int cp = 0; cp < 5; ++cp) {
            const f32x4 pa = ST[2 * cp] * inv, pb = (2 * cp + 1 < 9) ? ST[(2 * cp + 1 < 9) ? 2 * cp + 1 : 8] * inv : (f32x4){0.f, 0.f, 0.f, 0.f};
            const bf16x8 P = hg::frag_from2(pa, pb);
#pragma unroll
            for (int dt = 0; dt < 4; ++dt) { LAS unsigned char* p0 = lds + L_V + (16 * (qt + 2 * cp) + 4 * q + (r >> 2)) * RSK + (16 * dt + 4 * (r & 3)) * 2;
                O[dt] = __builtin_amdgcn_mfma_f32_16x16x32_bf16(P, hg::frag_tr2(p0, p0 + 16 * RSK), O[dt], 0, 0, 0); } }
        LAS unsigned char* ow = lds + L_O + w * OW;
#pragma unroll
        for (int dt = 0; dt < 4; ++dt)
#pragma unroll
            for (int rg = 0; rg < 4; ++rg) *(LAS bf16*)(ow + (4 * q + rg) * RSK + (16 * dt + r) * 2) = (bf16)(hg::cvtpk(O[dt][rg], 0.f) & 0xffffu);
#pragma unroll
        for (int i = 0; i < 2; ++i) { const int ci = lane + 64 * i, row = ci >> 3, c8 = ci & 7;
            const v4u v = *(const LAS v4u*)(ow + row * RSK + c8 * 16); *(v4u*)(QB + (tok0 + 16 * qt + row) * QW + head * 64 + c8 * 8) = v; }
    }
}
}

namespace rt {
typedef short bf16x8 __attribute__((ext_vector_type(8)));
__device__ __forceinline__ void prep_w(const float* wco, const float* wfi, const float* gf, bf16* WRH, bf16* WRL, int gtid, int nthr) {
    for (int e = gtid; e < 80 * D; e += nthr) { const int n = e >> 11, k = e & 2047;
        const float w = (n < 8) ? wco[k * 8 + n] : (n < 72 ? wfi[k * 64 + (n - 8)] : 0.f); const float v = w * gf[k];
        const unsigned h = hg::cvtpk(v, 0.f) & 0xffffu; const float l = v - __uint_as_float(h << 16);
        WRH[e] = (bf16)h; WRL[e] = (bf16)(hg::cvtpk(l, 0.f) & 0xffffu); }
}
constexpr int RSB = 272, BUFB = 2 * 80 * RSB, L_G = 2 * BUFB, L_LW = L_G + 8192, L_HIST = L_LW + 8 * 5120;
__device__ __forceinline__ void pass(LAS unsigned char* lds, const float* x, const bf16* DL, float* RSTD2, const float* gf, const bf16* WRH, const bf16* WRL, const float* bco, const float* bfi,
                                     bf16* XN, float* TW, const int tl, const bool live, const int tid, int& ea_out, int& eb_out) {
    const int lane = tid & 63, w = __builtin_amdgcn_readfirstlane(tid >> 6), r = lane & 15, q = lane >> 4;
    const int tok = live ? tl * 16 + r : r;
    LAS float* lw = (LAS float*)(lds + L_LW + w * 5120);
    v4u st[5];
#define RT_BLOAD(ck_) do { _Pragma("unroll") for (int i = 0; i < 5; ++i) { const int p_ = tid + 512 * i, mat_ = p_ >= 1280, rem_ = p_ - 1280 * mat_, n_ = rem_ >> 4, j_ = rem_ & 15; \
        st[i] = *(const v4u*)((mat_ ? WRL : WRH) + (size_t)n_ * D + (ck_) * 128 + j_ * 8); } } while (0)
#define RT_BSTORE(buf_) do { _Pragma("unroll") for (int i = 0; i < 5; ++i) { const int p_ = tid + 512 * i, mat_ = p_ >= 1280, rem_ = p_ - 1280 * mat_, n_ = rem_ >> 4, j_ = rem_ & 15; \
        *(LAS v4u*)(lds + (buf_) * BUFB + mat_ * 80 * RSB + n_ * RSB + j_ * 16) = st[i]; } } while (0)
    RT_BLOAD(0);
    const float* xr = x + (size_t)tok * D + 8 * q; bf16* xo = XN + (size_t)tok * D + 8 * q;
    const int tl0 = live ? tl : 0, t0 = (tl0 & 15) * 16;
    const unsigned char* dbase = (const unsigned char*)DL + (size_t)(tl0 >> 4) * 8 * 131072 + (((t0 >> 7) * 4 + ((t0 >> 4) & 3)) * 2) * 8192 + (((t0 >> 6) & 1) * 4) * 1024 + (q * 16 + r) * 16;
    f32x4 X[4][2]; v4u Dl[4];
#define RT_XLOAD(ck_) do { _Pragma("unroll") for (int s_ = 0; s_ < 4; ++s_) { const int c_ = 4 * (ck_) + s_; X[s_][0] = __builtin_nontemporal_load((const f32x4*)(xr + 32 * c_)); \
        X[s_][1] = __builtin_nontemporal_load((const f32x4*)(xr + 32 * c_ + 4)); Dl[s_] = __builtin_nontemporal_load((const v4u*)(dbase + (size_t)(c_ >> 3) * 131072 + (c_ & 1) * 8192 + ((c_ >> 1) & 3) * 1024)); } } while (0)
    RT_XLOAD(0);
    RT_BSTORE(0);
    __syncthreads();
    f32x4 acc[5];
#pragma unroll
    for (int nt = 0; nt < 5; ++nt) acc[nt] = (f32x4){0.f, 0.f, 0.f, 0.f};
    float ssq = 0.f;
#pragma unroll 1
    for (int ck = 0; ck < 16; ++ck) {
        f32x4 Xc[4][2]; v4u Dc[4];
#pragma unroll
        for (int s_ = 0; s_ < 4; ++s_) { Xc[s_][0] = X[s_][0]; Xc[s_][1] = X[s_][1]; Dc[s_] = Dl[s_]; }
        if (ck + 1 < 16) { RT_BLOAD(ck + 1); RT_XLOAD(ck + 1); }
        LAS unsigned char* bb = lds + (ck & 1) * BUFB + r * RSB + 16 * q;
#pragma unroll
        for (int s_ = 0; s_ < 4; ++s_) {
            const int c = 4 * ck + s_;
            f32x4 x0 = Xc[s_][0], x1 = Xc[s_][1]; { f32x4 d0, d1; pg8::unpack8(Dc[s_], d0, d1); x0 += d0; x1 += d1; }
            ssq += ((x0[0] * x0[0] + x0[1] * x0[1]) + (x0[2] * x0[2] + x0[3] * x0[3])) + ((x1[0] * x1[0] + x1[1] * x1[1]) + (x1[2] * x1[2] + x1[3] * x1[3]));
            v4u hi; hi.x = hg::cvtpk(x0[0], x0[1]); hi.y = hg::cvtpk(x0[2], x0[3]); hi.z = hg::cvtpk(x1[0], x1[1]); hi.w = hg::cvtpk(x1[2], x1[3]);
            if (live) *(v4u*)(xo + 32 * c) = hi;
            v4u lo; lo.x = hg::cvtpk(x0[0] - hg::blo(hi.x), x0[1] - hg::bhi(hi.x)); lo.y = hg::cvtpk(x0[2] - hg::blo(hi.y), x0[3] - hg::bhi(hi.y));
            lo.z = hg::cvtpk(x1[0] - hg::blo(hi.z), x1[1] - hg::bhi(hi.z)); lo.w = hg::cvtpk(x1[2] - hg::blo(hi.w), x1[3] - hg::bhi(hi.w));
            const bf16x8 Ah = __builtin_bit_cast(bf16x8, hi), Al = __builtin_bit_cast(bf16x8, lo);
#pragma unroll
            for (int nt = 0; nt < 5; ++nt) { const bf16x8 Bh = *(const LAS bf16x8*)(bb + nt * 16 * RSB + 64 * s_), Bl = *(const LAS bf16x8*)(bb + 80 * RSB + nt * 16 * RSB + 64 * s_);
                acc[nt] = __builtin_amdgcn_mfma_f32_16x16x32_bf16(Ah, Bh, acc[nt], 0, 0, 0); acc[nt] = __builtin_amdgcn_mfma_f32_16x16x32_bf16(Ah, Bl, acc[nt], 0, 0, 0);
                acc[nt] = __builtin_amdgcn_mfma_f32_16x16x32_bf16(Al, Bh, acc[nt], 0, 0, 0); }
        }
        if (ck + 1 < 16) RT_BSTORE((ck + 1) & 1);
        __syncthreads();
    }
#undef RT_BLOAD
#undef RT_BSTORE
#undef RT_XLOAD
    ssq += __shfl_xor(ssq, 16); ssq += __shfl_xor(ssq, 32);
    const float rstd = rsqrtf(ssq * (1.f / D) + EPS);
    if (live && q == 0) RSTD2[tok] = rstd;
#pragma unroll
    for (int nt = 0; nt < 5; ++nt)
#pragma unroll
        for (int rg = 0; rg < 4; ++rg) lw[(4 * q + rg) * 80 + 16 * nt + r] = acc[nt][rg];
    asm volatile("s_waitcnt lgkmcnt(0)" ::: "memory");
    if (live && lane < 16) {
        const LAS float* L = lw + lane * 80;
        float cm = L[0] * rstd + bco[0]; int grp = 0; float cv[8]; cv[0] = cm;
#pragma unroll
        for (int j = 1; j < 8; ++j) { cv[j] = L[j] * rstd + bco[j]; if (cv[j] > cm) { cm = cv[j]; grp = j; } }
        float den = 0.f;
#pragma unroll
        for (int j = 0; j < 8; ++j) den += fexp(cv[j] - cm);
        const float psel = 1.f / den;
        float f[8];
#pragma unroll
        for (int j = 0; j < 8; ++j) f[j] = L[8 + grp * 8 + j] * rstd + bfi[grp * 8 + j];
        int i0 = 0; float f0 = f[0];
#pragma unroll
        for (int j = 1; j < 8; ++j) if (f[j] > f0) { f0 = f[j]; i0 = j; }
        int i1 = -1; float f1 = 0.f;
#pragma unroll
        for (int j = 0; j < 8; ++j) if (j != i0 && (i1 < 0 || f[j] > f1)) { f1 = f[j]; i1 = j; }
        const float e1 = fexp(f1 - f0), w0 = psel / (1.f + e1), w1 = psel * e1 / (1.f + e1);
        ea_out = grp * 8 + i0; eb_out = grp * 8 + i1;
        TW[tok * 2] = w0; TW[tok * 2 + 1] = w1;
    }
}
}

constexpr int LDS_BYTES = 155648;
constexpr int LDS_MISC = 152576;

__global__ void __launch_bounds__(NTHR, 2) fwd_kernel(Args args) {
    extern __shared__ __attribute__((aligned(16))) unsigned char lds_raw[];
    LAS unsigned char* lds = (LAS unsigned char*)lds_raw;
    LAS float* ldsf = (LAS float*)lds;
    volatile LAS unsigned* MISC = (volatile LAS unsigned*)(lds + LDS_MISC);
    int tid = threadIdx.x; asm volatile("" : "+v"(tid));
    int lane = tid & 63, wave = __builtin_amdgcn_readfirstlane(tid >> 6);
#define GRID_SYNC() do { xcd_barrier(bar, tid); asm volatile("" : "+v"(tid)); lane = tid & 63; wave = __builtin_amdgcn_readfirstlane(tid >> 6); gw = bx * NWAVES + wave; } while (0)
    const int G = gridDim.x, bx = blockIdx.x;
    int gw = bx * NWAVES + wave; const int NGW = G * NWAVES;
    unsigned char* ws = args.ws;
    unsigned* ctl = (unsigned*)(ws + WS_CTL);
    if (tid < 64) MISC[tid] = 0u;
    __syncthreads();
    XcdBarrier bar = xcd_barrier_post(ctl + CW_BAR, MISC + 8, tid);

    const float* x = args.in[I_X];
    float* hbuf = args.out;
    float* LB = (float*)(ws + WS_SMALL);
    float* TW = (float*)(ws + WS_SMALL + 65536);
    unsigned short* LIST = (unsigned short*)(ws + WS_LIST);
    bf16* W_IN_T = (bf16*)(ws + WS_WIN); bf16* W_UA_T = (bf16*)(ws + WS_WUA); bf16* W_UR_T = (bf16*)(ws + WS_WUR);
    bf16* W_OUT_T = (bf16*)(ws + WS_WOUT); bf16* W_PG_T = (bf16*)(ws + WS_WPG); bf16* W_PI_T = (bf16*)(ws + WS_WPI);
    bf16* U = (bf16*)(ws + WS_RA); bf16* OREC = (bf16*)(ws + WS_RA); bf16* XN = (bf16*)(ws + WS_RA);
    bf16* QB = (bf16*)(ws + WS_RB); bf16* KVB = (bf16*)(ws + WS_RB + 64 * MiB); bf16* HID = (bf16*)(ws + WS_RB); bf16* PB = (bf16*)(ws + WS_PB);
    bf16* HG = (bf16*)(ws + WS_RC); bf16* MIX = (bf16*)(ws + WS_RC); bf16* Y = (bf16*)(ws + WS_RE);
    bf16* GT = (bf16*)(ws + WS_RD); bf16* W_DN_T = (bf16*)(ws + WS_RD); bf16* PL = (bf16*)(ws + WS_RD + 128 * MiB);
    bf16* W_GU_T = (bf16*)(ws + WS_RE);
    float* RSTDP = (float*)(ws + WS_SMALL + 393216); float* RSTD3 = (float*)(ws + WS_SMALL + 524288); float* RSTD2 = (float*)(ws + WS_SMALL + 655360);
    bf16* DELTA = (bf16*)(ws + WS_RC + 128 * MiB);
    bf16* H3B = (bf16*)(ws + WS_RC);
    bf16* WRH = (bf16*)(ws + 6 * MiB); bf16* WRL = (bf16*)(ws + 6 * MiB + 512 * 1024);
    float* UST = (float*)(ws + WS_RA + 64 * MiB); float* DST = (float*)(ws + WS_RA + 96 * MiB);
    float* SS_H1 = (float*)(ws + WS_SS); float* SS_PL = (float*)(ws + WS_SS + 4 * MiB); float* SS_FIN = (float*)(ws + WS_SS + 8 * MiB);
    unsigned* CNT = ctl + CW_CNT;
    LAS unsigned char* ring = lds;

#ifndef REP_P0
#define REP_P0 1
#endif
#ifndef REP_P1
#define REP_P1 1
#endif
#pragma unroll 1
    for (int rep = 0; rep < REP_P0; ++rep) {
        LAS float* scr = ldsf + wave * 4096;
        transpose_all(args.in[I_WIN], D, INC, W_IN_T, scr, gw, NGW, lane, D);
        transpose_all(args.in[I_WUA], QW, D, W_UA_T, scr, gw, NGW, lane, QW);
        transpose_all(args.in[I_WUR], HW, D, W_UR_T, scr, gw, NGW, lane, HW);
        transpose_all(args.in[I_WOUT], D, D, W_OUT_T, scr, gw, NGW, lane, D);
        transpose_all(args.in[I_WPG], D, D, W_PG_T, scr, gw, NGW, lane, D);
        transpose_all(args.in[I_WPI], PLE, D, W_PI_T, scr, gw, NGW, lane, PLE);
        for (int it = gw; it < (NEXP - 16) * 1024; it += NGW) { const int e = it >> 10, r = it & 1023, mat = r >> 9, item = r & 511;
            transpose_item(args.in[mat ? I_WU : I_WG] + (size_t)e * D * MH, D, MH, W_GU_T + (size_t)e * 1024 * D, scr, item, lane, 1 + mat, D, args.in[I_GFFN]); }
        for (int m = gw; m < NTOK; m += NGW) { const f32x4 pv = __builtin_nontemporal_load((const f32x4*)(args.in[I_P] + (size_t)m * PLE) + lane);
            v2u w; w.x = pk2(pv.x, pv.y); w.y = pk2(pv.z, pv.w); *((v2u*)(PB + (size_t)m * PLE) + lane) = w; }
        const float* gm = args.in[I_GMIX];
        for (int m = gw; m < NTOK; m += NGW) {
            const f32x4* xr = (const f32x4*)(x + (size_t)m * D) + lane;
            f32x4 v[8]; float s = 0.f;
#pragma unroll
            for (int j = 0; j < 8; ++j) { v[j] = __builtin_nontemporal_load(xr + 64 * j); s += (v[j].x * v[j].x + v[j].y * v[j].y) + (v[j].z * v[j].z + v[j].w * v[j].w); }
            const float rstd = rsqrtf(wave_sum(s) * (1.f / D) + EPS);
            v2u* o = (v2u*)(U + (size_t)m * D) + lane;
#pragma unroll
            for (int j = 0; j < 8; ++j) { const f32x4 g = *((const f32x4*)gm + 64 * j + lane); v2u w; w.x = pk2(v[j].x * rstd * g.x, v[j].y * rstd * g.y); w.y = pk2(v[j].z * rstd * g.z, v[j].w * rstd * g.w); o[64 * j] = w; }
        }
        rt::prep_w(args.in[I_WCO], args.in[I_WFI], args.in[I_GFFN], WRH, WRL, bx * NTHR + tid, G * NTHR);
        const float* lbl = args.in[I_LBL];
        for (int j = bx * NTHR + tid; j < HW; j += G * NTHR) LB[j] = 1.f / (1.f + __expf(lbl[HW + j] - lbl[j]));
    }
    GRID_SYNC();

#pragma unroll 1
    for (int rep = 0; rep < REP_P1; ++rep) {
        pg8::StaticOrder S; S.init(U, W_IN_T, NTOK, INC, D, D, G, bx);
        pg8::EpiZ E{args.in[I_BQKV], LB, QB, KVB, HG, GT};
        pg8::gemm_phase<pg8::EpiZ, pg8::StaticOrder, true, false>(ring, D, D, D, S, E, tid);
        const int nshort = G - (S.nwg % G);
        if (S.nwg % G != 0 && bx >= S.nwg % G) { LAS float* scr = ldsf + wave * 4096; const int sw = (bx - S.nwg % G) * NWAVES + wave, nsw = nshort * NWAVES;
            for (int it = sw; it < 16 * 1024; it += nsw) { const int e = (NEXP - 16) + (it >> 10), r = it & 1023, mat = r >> 9, item = r & 511;
                transpose_item(args.in[mat ? I_WU : I_WG] + (size_t)e * D * MH, D, MH, W_GU_T + (size_t)e * 1024 * D, scr, item, lane, 1 + mat, D, args.in[I_GFFN]); } }
        else if (S.nwg % G == 0) { LAS float* scr = ldsf + wave * 4096;
            for (int it = gw; it < 16 * 1024; it += NGW) { const int e = (NEXP - 16) + (it >> 10), r = it & 1023, mat = r >> 9, item = r & 511;
                transpose_item(args.in[mat ? I_WU : I_WG] + (size_t)e * D * MH, D, MH, W_GU_T + (size_t)e * 1024 * D, scr, item, lane, 1 + mat, D, args.in[I_GFFN]); } }
    }
    GRID_SYNC();

    for (int u = bx; u < 512; u += G) hg::unit<true>(lds, HG, OREC, UST, DST, args.in[I_GHGRN], u, tid);
    for (int it = bx; it < 2 * 128 * 2; it += G) at::item(lds, QB, KVB, args.in[I_SINKS], args.in[I_REL], it, tid);
    GRID_SYNC();

    hg::scan(UST, DST, bx * NTHR + tid, G * NTHR);
    GRID_SYNC();
    for (int u = bx; u < 512; u += G) hg::unit<false>(lds, HG, OREC, UST, DST, args.in[I_GHGRN], u, tid);
    GRID_SYNC();

    {
        pg8::PairOrder S; S.s0.init(QB, W_UA_T, NTOK, D, QW, QW, G, bx); S.A1 = (const char*)OREC; S.B1 = (const char*)W_UR_T;
        pg8::EpiMix E{GT, MIX, (unsigned char*)UST + (size_t)bx * 131072};
        pg8::gemm_phase<pg8::EpiMix, pg8::PairOrder, true, false>(ring, QW, QW, QW, S, E, tid);
    }
    GRID_SYNC();

    {
        pg8::StaticOrder S; S.init(MIX, W_OUT_T, NTOK, D, D, D, G, bx);
        pg8::EpiDelta E{DELTA};
        pg8::gemm_phase<pg8::EpiDelta, pg8::StaticOrder, true, false>(ring, D, D, D, S, E, tid);
    }
    GRID_SYNC();

    {
        {
            LAS float* scr = ldsf + wave * 4096;
            for (int it = gw; it < NEXP * 512; it += NGW) { const int e = it >> 9, item = it & 511;
                transpose_item(args.in[I_WD] + (size_t)e * MH * D, MH, D, W_DN_T + (size_t)e * D * MH, scr, item, lane, 0, MH); }
        }
        __syncthreads();
        LAS unsigned* hist = (LAS unsigned*)(lds + rt::L_HIST);
        for (int i = 0; i * NGW < NTOK / 16; ++i) {
            const int tl = gw + i * NGW; const bool live = tl < NTOK / 16;
            __syncthreads();
            if (tid < 64) hist[tid] = 0u;
            int ea = 0, eb = 0; unsigned ra = 0u, rb = 0u;
            rt::pass(lds, x, DELTA, RSTD2, args.in[I_GFFN], WRH, WRL, args.in[I_BCO], args.in[I_BFI], XN, TW, tl, live, tid, ea, eb);
            if (live && lane < 16) { ra = atomicAdd((unsigned*)(hist + ea), 1u); rb = atomicAdd((unsigned*)(hist + eb), 1u); }
            __syncthreads();
            if (tid < 64) { const unsigned c = hist[tid]; hist[64 + tid] = c ? atomicAdd(CNT + 64 * tid, c) : 0u; }
            __syncthreads();
            if (live && lane < 16) { const int m = tl * 16 + lane;
                LIST[(size_t)ea * NTOK + hist[64 + ea] + ra] = (unsigned short)m; LIST[(size_t)eb * NTOK + hist[64 + eb] + rb] = (unsigned short)(m | 0x8000); }
        }
    }
    GRID_SYNC();

    LAS int* eoff = (LAS int*)(lds + 150528);
    LAS int* ecnt = (LAS int*)(lds + 150528 + 512);
    if (tid < 64) {
        const int c = (int)__hip_atomic_load(CNT + 64 * tid, __ATOMIC_RELAXED, __HIP_MEMORY_SCOPE_AGENT); int v = (c + 255) & ~255;
#pragma unroll
        for (int d = 1; d < 64; d <<= 1) { const int t = __shfl_up(v, d); if (lane >= d) v += t; }
        ecnt[tid] = c; eoff[tid] = v - ((c + 255) & ~255); if (tid == 63) eoff[NEXP] = v;
    }
    __syncthreads();
    const int vcu = (G % 8 == 0) ? (bx % 8) * (G / 8) + bx / 8 : bx;
    const int nrb = eoff[NEXP] / 256;
    {
        pg8::MoeOrder S{eoff, ecnt, 4, G, vcu, nrb, (const char*)XN, (const char*)W_GU_T, (size_t)1024 * D * 2, (size_t)256 * D * 2, (size_t)D * 2, LIST, 1};
        pg8::EpiGateUp E{HID, LIST, RSTD2};
        pg8::gemm_phase<pg8::EpiGateUp, pg8::MoeOrder, true, true>(ring, D, D, D, S, E, tid);
    }
    const int r6 = (nrb * 4) % G, ple_early = r6 ? ((G - r6) * 8 < 1024 ? (G - r6) * 8 : 1024) : 0;
    if (r6 && vcu >= r6) {
        pg8::StaticOrder S; S.init(PB, W_PI_T, NTOK, D, PLE, PLE, 1, 0); S.lo = (vcu - r6) * 8; S.hi = S.lo + 8 < ple_early ? S.lo + 8 : ple_early;
        pg8::EpiPleRaw E{PL, SS_PL};
        pg8::gemm_phase<pg8::EpiPleRaw, pg8::StaticOrder, true, false>(ring, PLE, PLE, PLE, S, E, tid);
    }
    GRID_SYNC();
    {
        pg8::MoeOrder S{eoff, ecnt, 8, G, vcu, nrb, (const char*)HID, (const char*)W_DN_T, (size_t)D * MH * 2, (size_t)256 * MH * 2, (size_t)MH * 2, LIST, 0};
        pg8::EpiDown E{LIST, TW, Y};
        pg8::gemm_phase<pg8::EpiDown, pg8::MoeOrder, true, false>(ring, MH, MH, MH, S, E, tid);
    }
    {
        pg8::StaticOrder S; S.init(PB, W_PI_T, NTOK, D, PLE, PLE, G, bx); S.lo = ple_early;
        pg8::EpiPleRaw E{PL, SS_PL};
        pg8::gemm_phase<pg8::EpiPleRaw, pg8::StaticOrder, true, false>(ring, PLE, PLE, PLE, S, E, tid);
    }
    GRID_SYNC();

    {
        for (int m = gw; m < NTOK; m += NGW) {
            const v2u* hb = (const v2u*)(XN + (size_t)m * D) + lane;
            const v2u* y0 = (const v2u*)(Y + (size_t)m * D) + lane; const v2u* y1 = (const v2u*)(Y + (size_t)NTOK * D + (size_t)m * D) + lane;
            v2u* o = (v2u*)(XN + (size_t)m * D) + lane;
            float s = 0.f;
#pragma unroll
            for (int j = 0; j < 8; ++j) { const v2u a = __builtin_nontemporal_load(y0 + 64 * j), c = __builtin_nontemporal_load(y1 + 64 * j), dd = __builtin_nontemporal_load(hb + 64 * j);
                f32x4 v; v.x = __uint_as_float(dd.x << 16); v.y = __uint_as_float(dd.x & 0xffff0000u); v.z = __uint_as_float(dd.y << 16); v.w = __uint_as_float(dd.y & 0xffff0000u);
                v.x += __uint_as_float(a.x << 16) + __uint_as_float(c.x << 16); v.y += __uint_as_float(a.x & 0xffff0000u) + __uint_as_float(c.x & 0xffff0000u);
                v.z += __uint_as_float(a.y << 16) + __uint_as_float(c.y << 16); v.w += __uint_as_float(a.y & 0xffff0000u) + __uint_as_float(c.y & 0xffff0000u);
                s += (v.x * v.x + v.y * v.y) + (v.z * v.z + v.w * v.w);
                v2u w; w.x = hg::cvtpk(v.x, v.y); w.y = hg::cvtpk(v.z, v.w); o[64 * j] = w; }
            const float ssum = wave_sum(s);
            const float sp = wave_sum(lane < 32 ? SS_PL[(size_t)m * 32 + lane] : 0.f);
            if (lane == 0) { RSTD3[m] = rsqrtf(ssum * (1.f / D) + EPS); RSTDP[m] = rsqrtf(sp * (1.f / D) + EPS); }
        }
    }
    GRID_SYNC();

    {
        pg8::StaticOrder S; S.init(XN, W_PG_T, NTOK, D, D, D, G, bx);
        pg8::EpiPleGate E{H3B, PL, RSTD3, RSTDP, args.in[I_GPLE]};
        pg8::gemm_phase<pg8::EpiPleGate, pg8::StaticOrder, true, false>(ring, D, D, D, S, E, tid);
    }
    GRID_SYNC();

    {
        const float* gfin = args.in[I_GFIN];
        f32x4 gv[8];
#pragma unroll
        for (int j = 0; j < 8; ++j) gv[j] = *((const f32x4*)gfin + 64 * j + lane);
        for (int m = gw; m < NTOK; m += 2 * NGW) {
            const int m1 = (m + NGW < NTOK) ? m + NGW : m;
            f32x4* o0 = (f32x4*)(hbuf + (size_t)m * D) + lane; f32x4* o1 = (f32x4*)(hbuf + (size_t)m1 * D) + lane;
            const v2u* u0 = (const v2u*)(H3B + (size_t)m * D) + lane; const v2u* u1 = (const v2u*)(H3B + (size_t)m1 * D) + lane;
            const v2u* h0 = (const v2u*)(XN + (size_t)m * D) + lane; const v2u* h1 = (const v2u*)(XN + (size_t)m1 * D) + lane;
            v2u a0[8], a1[8], b0[8], b1[8];
#pragma unroll
            for (int j = 0; j < 8; ++j) { a0[j] = __builtin_nontemporal_load(u0 + 64 * j); a1[j] = __builtin_nontemporal_load(u1 + 64 * j); b0[j] = __builtin_nontemporal_load(h0 + 64 * j); b1[j] = __builtin_nontemporal_load(h1 + 64 * j); }
            f32x4 y0[8], y1[8]; float s0 = 0.f, s1 = 0.f;
#pragma unroll
            for (int j = 0; j < 8; ++j) {
                y0[j].x = __uint_as_float(a0[j].x << 16) + __uint_as_float(b0[j].x << 16); y0[j].y = __uint_as_float(a0[j].x & 0xffff0000u) + __uint_as_float(b0[j].x & 0xffff0000u);
                y0[j].z = __uint_as_float(a0[j].y << 16) + __uint_as_float(b0[j].y << 16); y0[j].w = __uint_as_float(a0[j].y & 0xffff0000u) + __uint_as_float(b0[j].y & 0xffff0000u);
                y1[j].x = __uint_as_float(a1[j].x << 16) + __uint_as_float(b1[j].x << 16); y1[j].y = __uint_as_float(a1[j].x & 0xffff0000u) + __uint_as_float(b1[j].x & 0xffff0000u);
                y1[j].z = __uint_as_float(a1[j].y << 16) + __uint_as_float(b1[j].y << 16); y1[j].w = __uint_as_float(a1[j].y & 0xffff0000u) + __uint_as_float(b1[j].y & 0xffff0000u);
                s0 += (y0[j].x * y0[j].x + y0[j].y * y0[j].y) + (y0[j].z * y0[j].z + y0[j].w * y0[j].w); s1 += (y1[j].x * y1[j].x + y1[j].y * y1[j].y) + (y1[j].z * y1[j].z + y1[j].w * y1[j].w); }
            const float r0 = rsqrtf(wave_sum(s0) * (1.f / D) + EPS), r1 = rsqrtf(wave_sum(s1) * (1.f / D) + EPS);
#pragma unroll
            for (int j = 0; j < 8; ++j) { __builtin_nontemporal_store(y0[j] * r0 * gv[j], o0 + 64 * j); __builtin_nontemporal_store(y1[j] * r1 * gv[j], o1 + 64 * j); }
        }
    }
}

extern "C" void kernel_launch(void* const* d_in, const int* in_sizes, int n_in, void* d_out, int out_size, void* d_ws, size_t ws_size, hipStream_t stream) {
    static int grid = 0;
    if (grid == 0) {
        if (n_in != 24 || out_size != NTOK * D || ws_size < WS_END) { fprintf(stderr, "kernel_launch: unexpected shapes (n_in %d, out %d, ws %zu)\n", n_in, out_size, ws_size); grid = -1; return; }
        int dev = 0, cus = 0;
        if (hipGetDevice(&dev) != hipSuccess || hipDeviceGetAttribute(&cus, hipDeviceAttributeMultiprocessorCount, dev) != hipSuccess) { grid = -1; return; }
        if (hipFuncSetAttribute((const void*)fwd_kernel, hipFuncAttributeMaxDynamicSharedMemorySize, LDS_BYTES) != hipSuccess) { fprintf(stderr, "kernel_launch: hipFuncSetAttribute failed\n"); grid = -1; return; }
        int per_cu = 0;
        if (hipOccupancyMaxActiveBlocksPerMultiprocessor(&per_cu, (const void*)fwd_kernel, NTHR, LDS_BYTES) != hipSuccess || per_cu < 1) { fprintf(stderr, "kernel_launch: occupancy query says %d\n", per_cu); }
        (void)hipGetLastError();
        grid = cus;
    }
    if (grid < 0) return;
    if (hipMemsetAsync((char*)d_ws + WS_CTL, 0, CTL_ZERO_BYTES, stream) != hipSuccess) return;
    Args a{};
    for (int i = 0; i < 24; ++i) a.in[i] = (const float*)d_in[i];
    a.out = (float*)d_out; a.ws = (unsigned char*)d_ws;
    hipLaunchKernelGGL(fwd_kernel, dim3(grid), dim3(NTHR), LDS_BYTES, stream, a);
}
```

```cpp
#include <hip/hip_runtime.h>
#include <cstdio>
#include <cstdint>

#define GAS __attribute__((address_space(1)))
#define LAS __attribute__((address_space(3)))
typedef unsigned short bf16;
typedef float f32x4 __attribute__((ext_vector_type(4)));
typedef unsigned v4u __attribute__((ext_vector_type(4)));
typedef unsigned v2u __attribute__((ext_vector_type(2)));

constexpr int NTOK = 32768, SEQ = 16384, D = 2048;
constexpr int QW = 1024, KVW = 128, QKVW = 1280, HW = 1024, INC = 9472;
constexpr unsigned long long I8TILES = (1ull << 37) - 1;
__host__ __device__ constexpr bool i8tile(int t) { return (I8TILES >> t) & 1ull; }
constexpr int NEXP = 64, MH = 512, PLE = 256;
constexpr float EPS = 1e-6f;
constexpr int NWAVES = 8, NTHR = 512;
constexpr size_t HGPS = (size_t)NTOK * 128;
constexpr int HIDCAP = 81920;

constexpr size_t MiB = 1u << 20;
constexpr size_t WS_CTL = 0, CTL_ZERO_BYTES = 192 * 1024;
constexpr size_t WS_SMALL = 1 * MiB;
constexpr size_t WS_LIST = 2 * MiB;
constexpr size_t WS_WIN = 8 * MiB, WS_WUA = 45 * MiB, WS_WUR = 49 * MiB, WS_WOUT = 53 * MiB, WS_WPG = 61 * MiB, WS_WPI = 69 * MiB;
constexpr size_t WS_RA = 70 * MiB;
constexpr size_t WS_RB = 198 * MiB;
constexpr size_t WS_RC = 278 * MiB;
constexpr size_t WS_RD = 534 * MiB;
constexpr size_t WS_RE = 790 * MiB;
constexpr size_t WS_PB = 1046 * MiB;
constexpr size_t WS_SS = 1062 * MiB;
constexpr size_t WS_END = 1074 * MiB;
constexpr int CW_BAR = 4096;
constexpr int CW_CNT = 16384;
constexpr int CW_PACE = 32768;

__device__ __forceinline__ float bf2f(bf16 h) { return __uint_as_float(((unsigned)h) << 16); }
__device__ __forceinline__ unsigned f2bf(float f) { unsigned u = __float_as_uint(f); return (u + 0x7fffu + ((u >> 16) & 1u)) >> 16; }
__device__ __forceinline__ unsigned pk2(float lo, float hi) { return f2bf(lo) | (f2bf(hi) << 16); }
constexpr float LOG2E = 1.4426950408889634f;
__device__ __forceinline__ float fexp2(float x) { return __builtin_amdgcn_exp2f(x); }
__device__ __forceinline__ float fexp(float x) { return __builtin_amdgcn_exp2f(x * LOG2E); }
__device__ __forceinline__ float flog2(float x) { return __builtin_amdgcn_logf(x); }
__device__ __forceinline__ float shx(float v, int mask, int lane) { return __int_as_float(__builtin_amdgcn_ds_bpermute((lane ^ mask) << 2, __float_as_int(v))); }
__device__ __forceinline__ float wave_sum(float v, int lane) {
#pragma unroll
    for (int o = 1; o < 64; o <<= 1) v += shx(v, o, lane);
    return v;
}

#define XB_TMO      128
#define XB_XCNT(j)  (256  + 64 * (j))
#define XB_XSUB(j)  (1280 + 64 * (j))
#define XB_XGEN(j)  (2304 + 64 * (j))
#define XB_TOP      3328
#define XB_TOPGEN   3392
#define XCD_BAR_WORDS 3456
#define XB_SPIN_CAP (1u << 23)
__device__ __forceinline__ unsigned xb_ld(unsigned* p)              { return __hip_atomic_load(p, __ATOMIC_RELAXED, __HIP_MEMORY_SCOPE_AGENT); }
__device__ __forceinline__ unsigned xb_add(unsigned* p, unsigned v) { return __hip_atomic_fetch_add(p, v, __ATOMIC_RELAXED, __HIP_MEMORY_SCOPE_AGENT); }
__device__ __forceinline__ unsigned xb_xcc_id() { return (unsigned)__builtin_amdgcn_s_getreg((3 << 11) | 20) & 0xFu; }
#define XB_SPIN(cond, bar) do { unsigned _sp = 0; while (cond) { __builtin_amdgcn_s_sleep(1); \
    if ((++_sp & 255u) == 0u) { if (xb_ld(&(bar)[XB_TMO])) break; if (_sp > XB_SPIN_CAP) { atomicAdd(&(bar)[XB_TMO], 1u); break; } } } } while (0)
struct XcdBarrier { unsigned* bar; unsigned x; volatile LAS unsigned* st; };
__device__ __forceinline__ XcdBarrier xcd_barrier_post(unsigned* bar, volatile LAS unsigned* st, const int tid) {
    XcdBarrier b; b.bar = bar; b.x = xb_xcc_id(); b.st = st;
    if (tid == 0) (void)xb_add(&bar[XB_XCNT(b.x)], 1u);
    return b;
}
__device__ __forceinline__ void xcd_barrier_complete(unsigned* bar, unsigned x, unsigned& nloc, unsigned& nx) {
    const unsigned G = gridDim.x * gridDim.y * gridDim.z;
    unsigned sum, cnt, mine, sp = 0u;
    for (;;) {
        sum = 0u; cnt = 0u; mine = 0u;
#pragma unroll
        for (unsigned j = 0; j < 16; ++j) { const unsigned c = xb_ld(&bar[XB_XCNT(j)]); sum += c; cnt += (c > 0u) ? 1u : 0u; mine = (j == x) ? c : mine; }
        if (sum == G) break;
        __builtin_amdgcn_s_sleep(1);
        if ((++sp & 255u) == 0u) { if (xb_ld(&bar[XB_TMO])) break; if (sp > XB_SPIN_CAP) { atomicAdd(&bar[XB_TMO], 1u); break; } }
    }
    nloc = mine > 0u ? mine : 1u; nx = cnt > 0u ? cnt : 1u;
}
__device__ __forceinline__ void xcd_barrier(const XcdBarrier& b, const int tid) {
    asm volatile("s_waitcnt vmcnt(0)" ::: "memory");
    __syncthreads();
    if (tid == 0) {
        unsigned* bar = b.bar;
        __builtin_amdgcn_s_waitcnt(0);
        unsigned nloc = b.st[0], nx = b.st[1];
        if (nloc == 0u) { xcd_barrier_complete(bar, b.x, nloc, nx); b.st[0] = nloc; b.st[1] = nx; }
        const unsigned old = xb_add(&bar[XB_XSUB(b.x)], 1u);
        const unsigned gen = old / nloc;
        if (old + 1u == (gen + 1u) * nloc) {
            __builtin_amdgcn_fence(__ATOMIC_RELEASE, "agent");
            asm volatile("s_waitcnt vmcnt(0)" ::: "memory");
            const unsigned og = xb_add(&bar[XB_TOP], 1u);
            const unsigned tg = og / nx;
            if (og + 1u == (tg + 1u) * nx) xb_add(&bar[XB_TOPGEN], 1u);
            else XB_SPIN(xb_ld(&bar[XB_TOPGEN]) == tg, bar);
            __builtin_amdgcn_fence(__ATOMIC_ACQUIRE, "agent");
            xb_add(&bar[XB_XGEN(b.x)], 1u);
            asm volatile("s_waitcnt vmcnt(0)" ::: "memory");
        } else {
            XB_SPIN(xb_ld(&bar[XB_XGEN(b.x)]) == gen, bar);
            __builtin_amdgcn_fence(__ATOMIC_ACQUIRE, "agent");
            asm volatile("s_waitcnt vmcnt(0)" ::: "memory");
        }
    }
    __syncthreads();
}

struct Args {
    const float* in[24];
    float* out;
    unsigned char* ws;
};
enum { I_X = 0, I_P, I_GMIX, I_WIN, I_BQKV, I_SINKS, I_REL, I_LBL, I_GHGRN, I_WUA, I_WUR, I_WOUT, I_GFFN, I_WCO, I_BCO, I_WFI, I_BFI,
       I_WG, I_WU, I_WD, I_WPI, I_GPLE, I_WPG, I_GFIN };

__device__ __forceinline__ void transpose_item(const float* W, int K, int N, bf16* WT, LAS float* scr, int item, int lane, int gu, int ldw, const float* ks = nullptr) {
    const int nblk = N / 32, kb = item / nblk, nb = item % nblk, k0 = 64 * kb, n0 = 32 * nb;
    const int d0 = gu ? (256 * (n0 >> 7) + 64 * ((n0 & 127) >> 5) + 32 * (gu - 1)) : n0;
#pragma unroll
    for (int i = 0; i < 32; ++i) { const int kk = 2 * i + (lane >> 5); scr[kk * 33 + (lane & 31)] = __builtin_nontemporal_load(W + (size_t)(k0 + kk) * N + n0 + (lane & 31)); }
    asm volatile("s_waitcnt lgkmcnt(0)" ::: "memory");
    const int c = lane & 7;
    f32x4 k0s = (f32x4){1.f, 1.f, 1.f, 1.f}, k1s = k0s; if (ks) { k0s = *(const f32x4*)(ks + k0 + 8 * c); k1s = *(const f32x4*)(ks + k0 + 8 * c + 4); }
#pragma unroll
    for (int j = 0; j < 4; ++j) { const int n = (lane >> 3) + 8 * j; const LAS float* s = scr + (8 * c) * 33 + n;
        v4u o; o.x = pk2(s[0 * 33] * k0s[0], s[1 * 33] * k0s[1]); o.y = pk2(s[2 * 33] * k0s[2], s[3 * 33] * k0s[3]); o.z = pk2(s[4 * 33] * k1s[0], s[5 * 33] * k1s[1]); o.w = pk2(s[6 * 33] * k1s[2], s[7 * 33] * k1s[3]);
        *(v4u*)(WT + (size_t)(d0 + n) * ldw + k0 + 8 * c) = o; }
    asm volatile("s_waitcnt lgkmcnt(0)" ::: "memory");
}
__device__ __forceinline__ void transpose_item_q(const float* W, int N, unsigned char* WT, int ldb, LAS float* scr, int item, int lane, const unsigned* cmax) {
    const int nblk = N / 32, kb = item / nblk, nb = item % nblk, k0 = 64 * kb, n0 = 32 * nb;
#pragma unroll
    for (int i = 0; i < 32; ++i) { const int kk = 2 * i + (lane >> 5); scr[kk * 33 + (lane & 31)] = __builtin_nontemporal_load(W + (size_t)(k0 + kk) * N + n0 + (lane & 31)); }
    asm volatile("s_waitcnt lgkmcnt(0)" ::: "memory");
    const int c = lane & 7;
#pragma unroll
    for (int j = 0; j < 4; ++j) { const int n = (lane >> 3) + 8 * j; const LAS float* sp = scr + (8 * c) * 33 + n;
        const float cm = __uint_as_float(cmax[n0 + n]), sc = cm > 0.f ? 127.f / cm : 0.f; unsigned w0 = 0u, w1 = 0u;
#pragma unroll
        for (int t = 0; t < 4; ++t) { w0 |= ((unsigned)(int)rintf(sp[t * 33] * sc) & 0xffu) << (8 * t); w1 |= ((unsigned)(int)rintf(sp[(4 + t) * 33] * sc) & 0xffu) << (8 * t); }
        v2u o; o.x = w0; o.y = w1; *(v2u*)(WT + (size_t)(n0 + n) * ldb + k0 + 8 * c) = o; }
    asm volatile("s_waitcnt lgkmcnt(0)" ::: "memory");
}
__device__ __forceinline__ void coop_item_q(const float* W, int N, unsigned char* WT, int ldb, float* cm_out, int n0, int d0, const LAS float* gs, LAS float* scr, LAS float* xch, int wave, int lane) {
    float r[4][32]; float pm = 0.f;
#pragma unroll
    for (int q = 0; q < 4; ++q) { const int k0 = 64 * (4 * wave + q); const float* src = W + (size_t)(k0 + (lane >> 5)) * N + n0 + (lane & 31);
#pragma unroll
        for (int i = 0; i < 32; ++i) r[q][i] = __builtin_nontemporal_load(src + (size_t)(2 * i) * N);
        if (gs) { const LAS float* g2 = gs + k0 + (lane >> 5);
#pragma unroll
            for (int i = 0; i < 32; ++i) r[q][i] *= g2[2 * i]; }
#pragma unroll
        for (int i = 0; i < 32; ++i) pm = fmaxf(pm, fabsf(r[q][i])); }
    pm = fmaxf(pm, __int_as_float(__builtin_amdgcn_ds_bpermute((lane ^ 32) << 2, __float_as_int(pm))));
    if (lane < 32) xch[wave * 32 + lane] = pm;
    __syncthreads();
    float cm = 0.f;
#pragma unroll
    for (int w2 = 0; w2 < 8; ++w2) cm = fmaxf(cm, xch[w2 * 32 + (lane & 31)]);
    const float sc = cm > 0.f ? 127.f / cm : 0.f;
    if (wave == 0 && lane < 32) cm_out[d0 + lane] = cm;
    const int c = lane & 7;
#pragma unroll
    for (int q = 0; q < 4; ++q) { const int k0 = 64 * (4 * wave + q);
#pragma unroll
        for (int i = 0; i < 32; ++i) scr[(2 * i + (lane >> 5)) * 33 + (lane & 31)] = r[q][i] * sc;
        asm volatile("s_waitcnt lgkmcnt(0)" ::: "memory");
#pragma unroll
        for (int j = 0; j < 4; ++j) { const int n = (lane >> 3) + 8 * j; const LAS float* sp = scr + (8 * c) * 33 + n; unsigned w0 = 0u, w1 = 0u;
#pragma unroll
            for (int t = 0; t < 4; ++t) { w0 |= ((unsigned)(int)rintf(sp[t * 33]) & 0xffu) << (8 * t); w1 |= ((unsigned)(int)rintf(sp[(4 + t) * 33]) & 0xffu) << (8 * t); }
            v2u o; o.x = w0; o.y = w1; *(v2u*)(WT + (size_t)(d0 + n) * ldb + k0 + 8 * c) = o; }
        asm volatile("s_waitcnt lgkmcnt(0)" ::: "memory"); }
    __syncthreads();
}
__device__ __forceinline__ void wgu_item_q(const float* W, unsigned char* WT, float* cmu, int nb, int gu, LAS float* scr, LAS float* xch, const LAS float* gs, int wave, int lane) {
    const int n0 = 32 * nb; coop_item_q(W, MH, WT, D, cmu, n0, 256 * (n0 >> 7) + 64 * ((n0 & 127) >> 5) + 32 * (gu - 1), gs, scr, xch, wave, lane);
}
__device__ __forceinline__ void transpose_all(const float* W, int K, int N, bf16* WT, LAS float* scr, int gw, int ngw, int lane, int ldw) {
    const int nitems = (K / 64) * (N / 32);
    for (int it = gw; it < nitems; it += ngw) transpose_item(W, K, N, WT, scr, it, lane, 0, ldw);
}

namespace pg8 {
typedef short bf16x8 __attribute__((ext_vector_type(8)));
typedef unsigned u32x4 __attribute__((ext_vector_type(4)));
typedef int i32x4 __attribute__((ext_vector_type(4)));
constexpr int BM = 256, BK = 64, HALF = 128, HTB = HALF * BK * 2, STAGE_BYTES = 8 * HTB, NXCD = 8, WGM = 8;
__host__ __device__ __forceinline__ int lds_byte(int r, int c) { const int st = (r >> 4) * 2 + (c >> 5), rr = r & 15, cc = c & 31, ob = rr * 64 + cc * 2; return st * 1024 + (ob ^ (((ob >> 9) & 1) << 5)); }
__host__ __device__ __forceinline__ void stage_rc(int b, int& R, int& C) { const int st = b / 1024, sb = b % 1024, swz = sb ^ (((sb >> 9) & 1) << 5); R = (st >> 1) * 16 + swz / 64; C = (st & 1) * 32 + (swz % 64) / 2; }
__host__ __device__ __forceinline__ int perm32(int rho) { const int n = rho >> 4, i = rho & 15; return 8 * (i >> 2) + 4 * n + (i & 3); }
struct I8True { static constexpr bool value = true; }; struct I8False { static constexpr bool value = false; };
struct Unit { int pm, pn; const char* a; const char* b; int e, r0, cnt, row0, nt, i8; };
typedef __bf16 bfv2_t __attribute__((ext_vector_type(2))); typedef float fv2_t __attribute__((ext_vector_type(2)));
__device__ __forceinline__ unsigned cvt_pk_bf16(float lo, float hi) { fv2_t v; v.x = lo; v.y = hi; return __builtin_bit_cast(unsigned, __builtin_convertvector(v, bfv2_t)); }

struct StaticOrder {
    static constexpr bool VARK = false;
    int nM, nN, nwg, G, c, lo, hi; const char* A; const char* Bt; size_t tstepA, tstepB;
    __device__ __forceinline__ void init(const bf16* A_, const bf16* Bt_, int M, int N, int lda, int ldb, int G_, int c_) { nM = M / BM; nN = N / BM; nwg = nM * nN; G = G_; c = c_; lo = 0; hi = nwg; A = (const char*)A_; Bt = (const char*)Bt_; tstepA = (size_t)BM * lda * 2; tstepB = (size_t)BM * ldb * 2; pace = nullptr; }
    __device__ __forceinline__ bool next(int i, Unit& u) const {
        const long L = (long)lo + (long)i * G + c; if (L >= hi) return false;
        int wgid = (int)L; { const int q = nwg / NXCD, r = nwg % NXCD, xcd = wgid % NXCD, off = wgid / NXCD; wgid = (xcd < r ? xcd * (q + 1) : r * (q + 1) + (xcd - r) * q) + off; }
        const int nig = WGM * nN, gid = wgid / nig, fm = gid * WGM, gsz = (nM - fm) < WGM ? (nM - fm) : WGM;
        u.pm = fm + ((wgid % nig) % gsz); u.pn = (wgid % nig) / gsz; u.a = A + (size_t)u.pm * tstepA; u.b = Bt + (size_t)u.pn * tstepB; u.e = 0; u.r0 = 0; u.cnt = 0; u.row0 = 0; u.nt = 0; u.i8 = 0; return true;
    }
    __device__ __forceinline__ unsigned row_off(const Unit&, int) const { return 0u; }
    unsigned* pace;
    __device__ __forceinline__ void pace_arrive_wait(int ui, int wid, int lane) const {
        if (pace == nullptr || wid != 0) return;
        unsigned* p = pace + 64 * (c & 7);
        if (lane == 0) __hip_atomic_fetch_add(p, 1u, __ATOMIC_RELAXED, __HIP_MEMORY_SCOPE_AGENT);
        const unsigned want = (unsigned)(G >> 3) * (unsigned)(ui + 1);
        for (int sp = 0; sp < 4096; ++sp) { if (__hip_atomic_load(p, __ATOMIC_RELAXED, __HIP_MEMORY_SCOPE_AGENT) >= want) break; __builtin_amdgcn_s_sleep(2); }
    }
    __device__ __forceinline__ void pace_finish(int units_done, int wid, int lane) const {
        if (pace == nullptr || wid != 0 || lane != 0) return;
        const int rmax = (nwg + G - 1) / G;
        if (units_done < rmax) __hip_atomic_fetch_add(pace + 64 * (c & 7), (unsigned)(rmax - units_done), __ATOMIC_RELAXED, __HIP_MEMORY_SCOPE_AGENT);
    }
};

struct ZOrder {
    static constexpr bool VARK = true;
    StaticOrder s0; const char* A8; int nt16, nt8;
    __device__ __forceinline__ bool next(int i, Unit& u) const {
        if (!s0.next(i, u)) return false;
        u.nt = nt16;
        if (i8tile(u.pn)) { u.i8 = 1; u.nt = nt8; u.a = A8 + (size_t)u.pm * s0.tstepA; }
        return true;
    }
    __device__ __forceinline__ unsigned row_off(const Unit&, int) const { return 0u; }
    __device__ __forceinline__ void pace_arrive_wait(int, int, int) const {}
    __device__ __forceinline__ void pace_finish(int, int, int) const {}
};
struct PairOrder {
    static constexpr bool VARK = false;
    StaticOrder s0; const char* A1; const char* B1;
    __device__ __forceinline__ bool next(int i, Unit& u) const {
        if (!s0.next(i >> 1, u)) return false;
        if (i & 1) { u.a = A1 + (size_t)u.pm * s0.tstepA; u.b = B1 + (size_t)u.pn * s0.tstepB; u.e = 1; }
        return true;
    }
    __device__ __forceinline__ unsigned row_off(const Unit&, int) const { return 0u; }
    __device__ __forceinline__ void pace_arrive_wait(int, int, int) const {}
    __device__ __forceinline__ void pace_finish(int, int, int) const {}
};

template <class Epi, class Sched, bool ALIGN_EPI, bool GATHER>
__device__ __forceinline__ void gemm_phase(LAS unsigned char* lds, const int K, const int lda, const int ldb, const Sched& S, const Epi& E, const int tid) {
    const int wid = __builtin_amdgcn_readfirstlane(tid >> 6), lane = tid & 63, wr = wid >> 2, wc = wid & 3, fr = lane & 15, fq = lane >> 4;
    const int nt = K / BK;
    int Rr[2], Cc[2];
    unsigned voffA[2][2], voffB[2][2], voffAn[2][2];
#pragma unroll
    for (int i = 0; i < 2; ++i) { stage_rc(tid * 16 + i * 8192, Rr[i], Cc[i]);
#pragma unroll
        for (int h = 0; h < 2; ++h) { const int Rb = Epi::PERM ? (64 * (Rr[i] >> 5) + 32 * h + perm32(Rr[i] & 31)) : h * HALF + Rr[i];
            voffB[h][i] = (unsigned)(Rb * ldb + Cc[i]) * 2u; voffA[h][i] = (unsigned)((h * HALF + Rr[i]) * lda + Cc[i]) * 2u; voffAn[h][i] = voffA[h][i]; } }
    const size_t kstep = (size_t)(BK * 2);
    const unsigned ldsw = (unsigned)wid * 1024u;
    const int aoff = lds_byte(wr * 64 + fr, fq * 8), boff = lds_byte(wc * 32 + fr, fq * 8);
#define PG8_SA(b, h) (((b) * 2 + (h)) * HTB)
#define PG8_SB(b, h) ((4 + (b) * 2 + (h)) * HTB)
#define PG8_STAGE(bufoff, gbase, voff) do { const char* _gb = (const char*)(gbase); asm volatile("" : "+s"(_gb));     \
        _Pragma("unroll") for (int _i = 0; _i < 2; ++_i) \
        __builtin_amdgcn_global_load_lds((const unsigned*)(_gb + (voff)[_i]), (LAS unsigned*)(lds + (bufoff) + ldsw + _i * 8192), 16, 0, 0); } while (0)
#define PG8_LDA(dst, b, h) do { _Pragma("unroll") for (int m = 0; m < 4; ++m) _Pragma("unroll") for (int k = 0; k < 2; ++k) dst[m][k] = *(const LAS bf16x8*)(lds + PG8_SA(b, h) + aoff + m * 2048 + k * 1024); } while (0)
#define PG8_LDB(dst, b, h) do { _Pragma("unroll") for (int n = 0; n < 2; ++n) _Pragma("unroll") for (int k = 0; k < 2; ++k) dst[n][k] = *(const LAS bf16x8*)(lds + PG8_SB(b, h) + boff + n * 2048 + k * 1024); } while (0)
#define PG8_MMA(ai, bj, At, Bt) do { __builtin_amdgcn_s_setprio(1); _Pragma("unroll") for (int m = 0; m < 4; ++m) _Pragma("unroll") for (int n = 0; n < 2; ++n) _Pragma("unroll") for (int k = 0; k < 2; ++k) { \
        if constexpr (I8C) acc[ai][bj][m][n] = __builtin_bit_cast(f32x4, __builtin_amdgcn_mfma_i32_16x16x64_i8(__builtin_bit_cast(i32x4, Bt[n][k]), __builtin_bit_cast(i32x4, At[m][k]), __builtin_bit_cast(i32x4, acc[ai][bj][m][n]), 0, 0, 0)); \
        else acc[ai][bj][m][n] = __builtin_amdgcn_mfma_f32_16x16x32_bf16(Bt[n][k], At[m][k], acc[ai][bj][m][n], 0, 0, 0); } __builtin_amdgcn_s_setprio(0); } while (0)
#define PG8_WAIT_V(n) asm volatile("s_waitcnt vmcnt(" #n ")" ::: "memory")
#define PG8_WAIT_L(n) asm volatile("s_waitcnt lgkmcnt(" #n ")" ::: "memory")
#define PG8_BAR __builtin_amdgcn_s_barrier()
#define PG8_SCHED __builtin_amdgcn_sched_barrier(0)
#define PG8_KLOOP_BODY \
        for (int t = 0; t < ntu; t += 2) { \
            const bool last = (t == ntu - 2); \
            if (last) S.pace_arrive_wait(ui, wid, lane); \
            const char* a1 = cA + (size_t)(t + 1) * kstep; \
            const char* a2 = last ? nA : cA + (size_t)(t + 2) * kstep; const char* b2 = last ? nB : cB + (size_t)(t + 2) * kstep; \
            const char* a3 = a2 + kstep; const char* b3 = b2 + kstep; \
              \
            PG8_LDB(B0, 0, 0); PG8_LDB(B1, 0, 1); PG8_SCHED; PG8_LDA(At, 0, 0); PG8_STAGE(PG8_SA(1, 1), a1, voffA[1]); \
            if constexpr (GATHER) { if (last) {     \
_Pragma("unroll") \
                for (int h = 0; h < 2; ++h) \
_Pragma("unroll") \
                    for (int i = 0; i < 2; ++i) voffA[h][i] = voffAn[h][i]; } } \
            PG8_WAIT_V(8); PG8_WAIT_L(0); PG8_BAR; PG8_MMA(0, 0, At, B0); PG8_MMA(0, 1, At, B1); PG8_BAR; PG8_SCHED; \
              \
            PG8_LDA(At, 0, 1); PG8_STAGE(PG8_SB(0, 0), b2, voffB[0]); PG8_STAGE(PG8_SB(0, 1), b2, voffB[1]); PG8_STAGE(PG8_SA(0, 0), a2, voffA[0]); \
            PG8_WAIT_V(8); PG8_WAIT_L(0); PG8_BAR; PG8_MMA(1, 0, At, B0); PG8_MMA(1, 1, At, B1); PG8_BAR; PG8_SCHED; \
              \
            PG8_LDB(B0, 1, 0); PG8_LDB(B1, 1, 1); PG8_SCHED; PG8_LDA(At, 1, 0); PG8_STAGE(PG8_SA(0, 1), a2, voffA[1]); \
            PG8_WAIT_V(8); PG8_WAIT_L(0); PG8_BAR; PG8_MMA(0, 0, At, B0); PG8_MMA(0, 1, At, B1); PG8_BAR; PG8_SCHED; \
              \
            PG8_LDA(At, 1, 1); PG8_STAGE(PG8_SB(1, 0), b3, voffB[0]); PG8_STAGE(PG8_SB(1, 1), b3, voffB[1]); PG8_STAGE(PG8_SA(1, 0), a3, voffA[0]); \
            PG8_WAIT_V(8); PG8_WAIT_L(0); PG8_BAR; PG8_MMA(1, 0, At, B0); PG8_MMA(1, 1, At, B1); PG8_BAR; PG8_SCHED; \
        }
    Unit cur, nxt; int ui = 0;
    if (!S.next(0, cur)) return;
    if constexpr (GATHER) {
#pragma unroll
        for (int h = 0; h < 2; ++h)
#pragma unroll
            for (int i = 0; i < 2; ++i) voffA[h][i] = S.row_off(cur, h * HALF + Rr[i]) + (unsigned)Cc[i] * 2u;
    }
    f32x4 acc[2][2][4][2];
#pragma unroll
    for (int a = 0; a < 2; ++a)
#pragma unroll
        for (int b = 0; b < 2; ++b)
#pragma unroll
            for (int m = 0; m < 4; ++m)
#pragma unroll
                for (int n = 0; n < 2; ++n) acc[a][b][m][n] = (f32x4){0.f, 0.f, 0.f, 0.f};
    bf16x8 At[4][2], B0[2][2], B1[2][2];
    const char* cA = cur.a; const char* cB = cur.b;
    PG8_STAGE(PG8_SB(0, 0), cB, voffB[0]); PG8_STAGE(PG8_SB(0, 1), cB, voffB[1]); PG8_STAGE(PG8_SA(0, 0), cA, voffA[0]); PG8_STAGE(PG8_SA(0, 1), cA, voffA[1]);
    if (wr == 1) PG8_BAR;
    PG8_WAIT_V(2); PG8_BAR;
    PG8_STAGE(PG8_SB(1, 0), cB + kstep, voffB[0]); PG8_STAGE(PG8_SA(1, 0), cA + kstep, voffA[0]); PG8_STAGE(PG8_SB(1, 1), cB + kstep, voffB[1]);
    PG8_WAIT_V(6); PG8_BAR;
    for (;;) {
        const bool has_next = S.next(ui + 1, nxt);
        const char* nA = has_next ? nxt.a : cA; const char* nB = has_next ? nxt.b : cB;
        if constexpr (GATHER) {
#pragma unroll
            for (int h = 0; h < 2; ++h)
#pragma unroll
                for (int i = 0; i < 2; ++i) voffAn[h][i] = has_next ? S.row_off(nxt, h * HALF + Rr[i]) + (unsigned)Cc[i] * 2u : voffA[h][i];
        }
        const int ntu = Sched::VARK ? cur.nt : nt; const bool i8u = Sched::VARK && cur.i8;
        if constexpr (Sched::VARK) { if (i8u) { constexpr bool I8C = true; PG8_KLOOP_BODY } else { constexpr bool I8C = false; PG8_KLOOP_BODY } }
        else { constexpr bool I8C = Epi::I8; PG8_KLOOP_BODY }
        if constexpr (ALIGN_EPI) { if (wr == 0) PG8_BAR; }
        E(acc, cur, wr, wc, fr, fq);
        if (!has_next) { S.pace_finish(ui + 1, wid, lane); break; }
#pragma unroll
        for (int a = 0; a < 2; ++a)
#pragma unroll
            for (int b = 0; b < 2; ++b)
#pragma unroll
                for (int m = 0; m < 4; ++m)
#pragma unroll
                    for (int n = 0; n < 2; ++n) acc[a][b][m][n] = (f32x4){0.f, 0.f, 0.f, 0.f};
        cur = nxt; cA = nA; cB = nB; ++ui;
        if constexpr (ALIGN_EPI) { if (wr == 1) PG8_BAR; }
    }
    PG8_WAIT_V(0);
    if constexpr (!ALIGN_EPI) { if (wr == 0) PG8_BAR; }
    PG8_BAR;
#undef PG8_SA
#undef PG8_SB
#undef PG8_STAGE
#undef PG8_LDA
#undef PG8_LDB
#undef PG8_MMA
#undef PG8_WAIT_V
#undef PG8_WAIT_L
#undef PG8_BAR
#undef PG8_SCHED
#undef PG8_KLOOP_BODY
}

__device__ __forceinline__ void line_pair(const u32x4 v0, const u32x4 v1, const bool odd, u32x4& a, u32x4& b) {
#pragma unroll
    for (int j = 0; j < 4; ++j) { const unsigned x = odd ? v0[j] : v1[j]; const unsigned y = (unsigned)__builtin_amdgcn_update_dpp(0, (int)x, 0xB1, 0xf, 0xf, false);
        a[j] = odd ? y : v0[j]; b[j] = odd ? v1[j] : y; }
}
__device__ __forceinline__ float fsig(float x) { return __builtin_amdgcn_rcpf(1.f + fexp2(x * -LOG2E)); }
__device__ __forceinline__ u32x4 pack8(const f32x4 a, const f32x4 b) { u32x4 w; w.x = cvt_pk_bf16(a[0], a[1]); w.y = cvt_pk_bf16(a[2], a[3]); w.z = cvt_pk_bf16(b[0], b[1]); w.w = cvt_pk_bf16(b[2], b[3]); return w; }
__device__ __forceinline__ void unpack8(const u32x4 w, f32x4& a, f32x4& b) {
    a[0] = __uint_as_float(w.x << 16); a[1] = __uint_as_float(w.x & 0xffff0000u); a[2] = __uint_as_float(w.y << 16); a[3] = __uint_as_float(w.y & 0xffff0000u);
    b[0] = __uint_as_float(w.z << 16); b[1] = __uint_as_float(w.z & 0xffff0000u); b[2] = __uint_as_float(w.w << 16); b[3] = __uint_as_float(w.w & 0xffff0000u); }

__device__ __forceinline__ unsigned pack4u8(const f32x4 g) { return (unsigned)(g[0] * 255.f + 0.5f) | ((unsigned)(g[1] * 255.f + 0.5f) << 8) | ((unsigned)(g[2] * 255.f + 0.5f) << 16) | ((unsigned)(g[3] * 255.f + 0.5f) << 24); }
__device__ __forceinline__ f32x4 unpack4u8(const unsigned w) { f32x4 g; g[0] = (float)(w & 0xffu); g[1] = (float)((w >> 8) & 0xffu); g[2] = (float)((w >> 16) & 0xffu); g[3] = (float)(w >> 24); return g * (1.f / 255.f); }
template <int MODE, bool Q8 = false>
__device__ __forceinline__ void epiz_body(const f32x4 (&acc)[2][2][4][2], bf16* base, const int ldc, const int row0, const int oc, const float* vec, const int img_off = 0, const bool odd = false, const float* sa = nullptr, const float* cm = nullptr) {
    f32x4 bv[2][2], sw[2][2];
    if (Q8) {
#pragma unroll
        for (int bj = 0; bj < 2; ++bj)
#pragma unroll
            for (int n = 0; n < 2; ++n) sw[bj][n] = *(const f32x4*)(cm + bj * 32 + 4 * n) * (1.f / 127.f); }
#pragma unroll
    for (int bj = 0; bj < 2; ++bj)
#pragma unroll
        for (int n = 0; n < 2; ++n) bv[bj][n] = (MODE == 0 || MODE == 1 || MODE == 3) ? *(const f32x4*)(vec + bj * 32 + 4 * n) : (f32x4){0.f, 0.f, 0.f, 0.f};
#pragma unroll
    for (int ai = 0; ai < 2; ++ai)
#pragma unroll
        for (int m = 0; m < 4; ++m) { bf16* rowp = base + (size_t)(row0 + ai * HALF + m * 16) * ldc + oc; u32x4 pk[2], gb; const float rs = Q8 ? sa[ai * HALF + m * 16] : 0.f;
#pragma unroll
            for (int bj = 0; bj < 2; ++bj) { f32x4 v[2];
#pragma unroll
                for (int n = 0; n < 2; ++n) { f32x4 x = acc[ai][bj][m][n];
                    if (Q8) x = __builtin_convertvector(__builtin_bit_cast(i32x4, acc[ai][bj][m][n]), f32x4) * rs * sw[bj][n];
                    if (MODE == 0) x = (x + bv[bj][n]) * (0.125f * LOG2E);
                    else if (MODE == 1) x = x + bv[bj][n];
                    else if (MODE == 2) {
#pragma unroll
                        for (int j = 0; j < 4; ++j) x[j] = x[j] * fsig(x[j]); }
                    else if (MODE == 3) {
#pragma unroll
                        for (int j = 0; j < 4; ++j) { const float l = bv[bj][n][j]; x[j] = flog2(l + (1.f - l) * fsig(x[j])); } }
                    else if (MODE == 6) {
#pragma unroll
                        for (int j = 0; j < 4; ++j) x[j] = fsig(x[j]); }
                    v[n] = x; }
                if (MODE == 6) { gb[bj * 2] = pack4u8(v[0]); gb[bj * 2 + 1] = pack4u8(v[1]); }
                else pk[bj] = pack8(v[0], v[1]); }
            if (MODE == 6) *(u32x4*)((unsigned char*)base + (ai * 4 + m) * 8192 + img_off) = gb;
            if (MODE != 6) { u32x4 a, b; line_pair(pk[0], pk[1], odd, a, b); *(u32x4*)rowp = a; *(u32x4*)(rowp + ldc) = b; } }
}
struct EpiZ {
    static constexpr bool PERM = true, I8 = false;
    const float* bqkv; const float* lb; bf16* Q; bf16* KV; bf16* HG; bf16* GT; const float* SA; const float* CMG;
    __device__ __forceinline__ void gates_q(const f32x4 (&acc)[2][2][4][2], unsigned char* img, const float* sa, const float* cm) const {
        f32x4 sw[2][2];
#pragma unroll
        for (int bj = 0; bj < 2; ++bj)
#pragma unroll
            for (int n = 0; n < 2; ++n) sw[bj][n] = *(const f32x4*)(cm + bj * 32 + 4 * n) * (1.f / 127.f);
#pragma unroll
        for (int ai = 0; ai < 2; ++ai)
#pragma unroll
            for (int m = 0; m < 4; ++m) { const float rs = sa[ai * HALF + m * 16]; u32x4 gb;
#pragma unroll
                for (int bj = 0; bj < 2; ++bj)
#pragma unroll
                    for (int n = 0; n < 2; ++n) { f32x4 x = __builtin_convertvector(__builtin_bit_cast(i32x4, acc[ai][bj][m][n]), f32x4) * rs * sw[bj][n];
#pragma unroll
                        for (int j = 0; j < 4; ++j) x[j] = fsig(x[j]);
                        gb[bj * 2 + n] = pack4u8(x); }
                *(u32x4*)(img + (ai * 4 + m) * 8192) = gb; }
    }
    __device__ __forceinline__ void operator()(const f32x4 (&acc)[2][2][4][2], const Unit& u, int wr, int wc, int fr, int fq) const {
        asm volatile("" : "+v"(fr), "+v"(fq));
        const bool odd = fr & 1; const int row0 = u.pm * BM + wr * 64 + (fr & ~1), cb = u.pn * BM + wc * 64 + 8 * fq, cl = cb + (odd ? 32 : 0);
        const float* sa = SA + u.pm * BM + wr * 64 + fr; const float* cm = CMG + cb;
        if (u.pn < 4) { if (i8tile(u.pn)) epiz_body<0, true>(acc, Q, QW, row0, cl, bqkv + cb, 0, odd, sa, cm); else epiz_body<0>(acc, Q, QW, row0, cl, bqkv + cb, 0, odd); }
        else if (u.pn == 4) { if (i8tile(u.pn)) epiz_body<1, true>(acc, KV, 256, row0, cl - QW, bqkv + cb, 0, odd, sa, cm); else epiz_body<1>(acc, KV, 256, row0, cl - QW, bqkv + cb, 0, odd); }
        else if (u.pn < 21) { const int ct = (u.pn - 5) * 256 + (wc >> 1) * 128; bf16* hb = HG + (size_t)((ct >> 10) * 8 + ((ct >> 7) & 7)) * HGPS; const int oc = (wc & 1) * 64 + 8 * fq + (odd ? 32 : 0);
            if (i8tile(u.pn)) { if (u.pn >= 13 && u.pn < 17) epiz_body<4, true>(acc, hb, 128, row0, oc, nullptr, 0, odd, sa, cm); else if (u.pn >= 9 && u.pn < 13) epiz_body<3, true>(acc, hb, 128, row0, oc, lb + ((cb - QKVW) & 1023), 0, odd, sa, cm); else epiz_body<2, true>(acc, hb, 128, row0, oc, nullptr, 0, odd, sa, cm); }
            else if (u.pn < 9) epiz_body<2>(acc, hb, 128, row0, oc, nullptr, 0, odd);
            else if (u.pn < 13) epiz_body<3>(acc, hb, 128, row0, oc, lb + ((cb - QKVW) & 1023), 0, odd);
            else if (u.pn < 17) epiz_body<4>(acc, hb, 128, row0, oc, nullptr, 0, odd);
            else epiz_body<2>(acc, hb, 128, row0, oc, nullptr, 0, odd); }
        else gates_q(acc, (unsigned char*)GT + (size_t)(u.pm * 16 + (u.pn - 21)) * 65536 + (wr * 4 + wc) * 1024 + (fq * 16 + fr) * 16, SA + u.pm * BM + wr * 64 + fr, CMG + cb);
    }
};
struct EpiMix {
    static constexpr bool PERM = true, I8 = false;
    const bf16* GT; bf16* MIX; unsigned char* PART;
    template <bool SECOND>
    __device__ __forceinline__ void body(const f32x4 (&acc)[2][2][4][2], const int row0, const int cl, const bool odd, const unsigned char* gimg, unsigned char* pimg) const {
#pragma unroll
        for (int ai = 0; ai < 2; ++ai)
#pragma unroll
        for (int mh = 0; mh < 2; ++mh) {
            u32x4 g[2], o[2][2];
#pragma unroll
            for (int m2 = 0; m2 < 2; ++m2) {
                g[m2] = __builtin_nontemporal_load((const u32x4*)(gimg + (ai * 4 + 2 * mh + m2) * 8192));
#pragma unroll
                for (int bj = 0; bj < 2; ++bj) {
                    if (SECOND) o[m2][bj] = *(const u32x4*)(pimg + ((ai * 4 + 2 * mh + m2) * 2 + bj) * 8192); } }
#pragma unroll
            for (int m2 = 0; m2 < 2; ++m2) { const int m = 2 * mh + m2; u32x4 pk[2];
#pragma unroll
                for (int bj = 0; bj < 2; ++bj) {
                    const f32x4 g0 = unpack4u8(g[m2][bj * 2]), g1 = unpack4u8(g[m2][bj * 2 + 1]);
                    f32x4 v0 = acc[ai][bj][m][0] * g0, v1 = acc[ai][bj][m][1] * g1;
                    if (SECOND) { f32x4 o0, o1; unpack8(o[m2][bj], o0, o1); v0 += o0; v1 += o1; }
                    if (SECOND) pk[bj] = pack8(v0, v1); else *(u32x4*)(pimg + ((ai * 4 + m) * 2 + bj) * 8192) = pack8(v0, v1); }
                if (SECOND) { u32x4 a, b; line_pair(pk[0], pk[1], odd, a, b); bf16* rp = MIX + (size_t)(row0 + ai * HALF + m * 16) * D + cl; *(u32x4*)rp = a; *(u32x4*)(rp + D) = b; } }
        }
    }
    __device__ __forceinline__ void operator()(const f32x4 (&acc)[2][2][4][2], const Unit& u, int wr, int wc, int fr, int fq) const {
        const bool odd = fr & 1; const int row0 = u.pm * BM + wr * 64 + (fr & ~1), cl = u.pn * BM + wc * 64 + 8 * fq + (odd ? 32 : 0);
        const unsigned char* gimg = (const unsigned char*)GT + (size_t)(u.pm * 16 + (u.e ? 8 : 0) + u.pn) * 65536 + (wr * 4 + wc) * 1024 + (fq * 16 + fr) * 16;
        unsigned char* pimg = PART + (wr * 4 + wc) * 1024 + (fq * 16 + fr) * 16;
        if (u.e) body<true>(acc, row0, cl, odd, gimg, pimg); else body<false>(acc, row0, cl, odd, gimg, pimg);
    }
};
__device__ __forceinline__ void ss_slot(float s, float* SS, int row, int slot, int fq, int lane) {
    s += shx(s, 16, lane); s += shx(s, 32, lane);
    if (fq == 0) SS[(size_t)row * 32 + slot] = s;
}
struct EpiDelta {
    static constexpr bool PERM = true, I8 = false;
    bf16* DL;
    __device__ __forceinline__ void operator()(const f32x4 (&acc)[2][2][4][2], const Unit& u, int wr, int wc, int fr, int fq) const {
        unsigned char* dimg = (unsigned char*)DL + (size_t)(u.pm * 8 + u.pn) * 131072 + (wr * 4 + wc) * 1024 + (fq * 16 + fr) * 16;
#pragma unroll
        for (int ai = 0; ai < 2; ++ai)
#pragma unroll
            for (int m = 0; m < 4; ++m)
#pragma unroll
                for (int bj = 0; bj < 2; ++bj) *(u32x4*)(dimg + ((ai * 4 + m) * 2 + bj) * 8192) = pack8(acc[ai][bj][m][0], acc[ai][bj][m][1]);
    }
};
struct EpiDeltaQ {
    static constexpr bool PERM = true, I8 = true;
    bf16* DL; const float* SA; const float* CM;
    __device__ __forceinline__ void operator()(const f32x4 (&acc)[2][2][4][2], const Unit& u, int wr, int wc, int fr, int fq) const {
        unsigned char* dimg = (unsigned char*)DL + (size_t)(u.pm * 8 + u.pn) * 131072 + (wr * 4 + wc) * 1024 + (fq * 16 + fr) * 16;
        const float* sa = SA + u.pm * BM + wr * 64 + fr; const float* cm = CM + u.pn * BM + wc * 64 + 8 * fq; f32x4 sw[2][2];
#pragma unroll
        for (int bj = 0; bj < 2; ++bj)
#pragma unroll
            for (int n = 0; n < 2; ++n) sw[bj][n] = *(const f32x4*)(cm + bj * 32 + 4 * n) * (1.f / 127.f);
#pragma unroll
        for (int ai = 0; ai < 2; ++ai)
#pragma unroll
            for (int m = 0; m < 4; ++m)
#pragma unroll
                for (int bj = 0; bj < 2; ++bj) { const float rs = sa[ai * HALF + m * 16];
                    *(u32x4*)(dimg + ((ai * 4 + m) * 2 + bj) * 8192) = pack8(__builtin_convertvector(__builtin_bit_cast(i32x4, acc[ai][bj][m][0]), f32x4) * rs * sw[bj][0], __builtin_convertvector(__builtin_bit_cast(i32x4, acc[ai][bj][m][1]), f32x4) * rs * sw[bj][1]); }
    }
};
struct EpiPleRaw {
    static constexpr bool PERM = true, I8 = false;
    bf16* PL; float* SS;
    __device__ __forceinline__ void operator()(const f32x4 (&acc)[2][2][4][2], const Unit& u, int wr, int wc, int fr, int fq) const {
        const int row0 = u.pm * BM + wr * 64 + fr;
        unsigned char* pimg = (unsigned char*)PL + (size_t)(u.pm * 8 + u.pn) * 131072 + (wr * 4 + wc) * 1024 + (fq * 16 + fr) * 16;
#pragma unroll
        for (int ai = 0; ai < 2; ++ai)
#pragma unroll
            for (int m = 0; m < 4; ++m) { const int row = row0 + ai * HALF + m * 16; float s = 0.f;
#pragma unroll
                for (int bj = 0; bj < 2; ++bj) { const f32x4 a = acc[ai][bj][m][0], b = acc[ai][bj][m][1];
                    s += ((a[0] * a[0] + a[1] * a[1]) + (a[2] * a[2] + a[3] * a[3])) + ((b[0] * b[0] + b[1] * b[1]) + (b[2] * b[2] + b[3] * b[3]));
                    *(u32x4*)(pimg + ((ai * 4 + m) * 2 + bj) * 8192) = pack8(a, b); }
                ss_slot(s, SS, row, u.pn * 4 + wc, fq, fq * 16 + fr); }
    }
};
struct EpiPleGate {
    static constexpr bool PERM = true, I8 = false;
    bf16* UPD; const bf16* PL; const float* rstd3; const float* rstdp; const float* gple;
    __device__ __forceinline__ void operator()(const f32x4 (&acc)[2][2][4][2], const Unit& u, int wr, int wc, int fr, int fq) const {
        const bool odd = fr & 1; const int row0 = u.pm * BM + wr * 64 + fr, cb = u.pn * BM + wc * 64 + 8 * fq, cl = cb + (odd ? 32 : 0);
        const unsigned char* pimg = (const unsigned char*)PL + (size_t)(u.pm * 8 + u.pn) * 131072 + (wr * 4 + wc) * 1024 + (fq * 16 + fr) * 16;
        f32x4 gp[2][2];
#pragma unroll
        for (int bj = 0; bj < 2; ++bj)
#pragma unroll
            for (int n = 0; n < 2; ++n) gp[bj][n] = *(const f32x4*)(gple + cb + bj * 32 + 4 * n);
#pragma unroll
        for (int ai = 0; ai < 2; ++ai) {
            u32x4 pp[4][2]; float r3[4], rp[4];
#pragma unroll
            for (int m = 0; m < 4; ++m) { const int row = row0 + ai * HALF + m * 16; r3[m] = rstd3[row]; rp[m] = rstdp[row];
#pragma unroll
                for (int bj = 0; bj < 2; ++bj) pp[m][bj] = __builtin_nontemporal_load((const u32x4*)(pimg + ((ai * 4 + m) * 2 + bj) * 8192)); }
#pragma unroll
            for (int m = 0; m < 4; ++m) { const int row = (row0 & ~1) + ai * HALF + m * 16; u32x4 pk[2];
#pragma unroll
                for (int bj = 0; bj < 2; ++bj) {
                    f32x4 p0, p1; unpack8(pp[m][bj], p0, p1);
                    f32x4 g0 = acc[ai][bj][m][0] * r3[m], g1 = acc[ai][bj][m][1] * r3[m];
#pragma unroll
                    for (int j = 0; j < 4; ++j) { g0[j] = fsig(g0[j]); g1[j] = fsig(g1[j]); }
                    pk[bj] = pack8(p0 * rp[m] * gp[bj][0] * g0, p1 * rp[m] * gp[bj][1] * g1); }
                u32x4 a, b; line_pair(pk[0], pk[1], odd, a, b); bf16* up = UPD + (size_t)row * D + cl; *(u32x4*)up = a; *(u32x4*)(up + D) = b; }
        }
    }
};
struct EpiPleGateQ {
    static constexpr bool PERM = true, I8 = true;
    bf16* UPD; const bf16* PL; const float* rstd3; const float* rstdp; const float* gple; const float* cmax;
    __device__ __forceinline__ void operator()(const f32x4 (&acc)[2][2][4][2], const Unit& u, int wr, int wc, int fr, int fq) const {
        const bool odd = fr & 1; const int row0 = u.pm * BM + wr * 64 + fr, cb = u.pn * BM + wc * 64 + 8 * fq, cl = cb + (odd ? 32 : 0);
        const unsigned char* pimg = (const unsigned char*)PL + (size_t)(u.pm * 8 + u.pn) * 131072 + (wr * 4 + wc) * 1024 + (fq * 16 + fr) * 16;
        f32x4 gp[2][2], sw[2][2];
#pragma unroll
        for (int bj = 0; bj < 2; ++bj)
#pragma unroll
            for (int n = 0; n < 2; ++n) { gp[bj][n] = *(const f32x4*)(gple + cb + bj * 32 + 4 * n); sw[bj][n] = *(const f32x4*)(cmax + cb + bj * 32 + 4 * n) * (1.f / 127.f); }
#pragma unroll
        for (int ai = 0; ai < 2; ++ai) {
            u32x4 pp[4][2]; float r3[4], rp[4];
#pragma unroll
            for (int m = 0; m < 4; ++m) { const int row = row0 + ai * HALF + m * 16; r3[m] = rstd3[row]; rp[m] = rstdp[row];
#pragma unroll
                for (int bj = 0; bj < 2; ++bj) pp[m][bj] = __builtin_nontemporal_load((const u32x4*)(pimg + ((ai * 4 + m) * 2 + bj) * 8192)); }
#pragma unroll
            for (int m = 0; m < 4; ++m) { const int row = (row0 & ~1) + ai * HALF + m * 16; u32x4 pk[2];
#pragma unroll
                for (int bj = 0; bj < 2; ++bj) {
                    f32x4 p0, p1; unpack8(pp[m][bj], p0, p1);
                    const i32x4 i0 = __builtin_bit_cast(i32x4, acc[ai][bj][m][0]), i1 = __builtin_bit_cast(i32x4, acc[ai][bj][m][1]);
                    f32x4 g0 = __builtin_convertvector(i0, f32x4) * r3[m] * sw[bj][0], g1 = __builtin_convertvector(i1, f32x4) * r3[m] * sw[bj][1];
#pragma unroll
                    for (int j = 0; j < 4; ++j) { g0[j] = fsig(g0[j]); g1[j] = fsig(g1[j]); }
                    pk[bj] = pack8(p0 * rp[m] * gp[bj][0] * g0, p1 * rp[m] * gp[bj][1] * g1); }
                u32x4 a, b; line_pair(pk[0], pk[1], odd, a, b); bf16* up = UPD + (size_t)row * D + cl; *(u32x4*)up = a; *(u32x4*)(up + D) = b; }
        }
    }
};

struct MoeOrder {
    static constexpr bool VARK = false;
    const LAS int* eoff; const LAS int* ecnt; int NT, G, c, total_rb; const char* A; const char* W; size_t wexp, tstepB, arow_bytes; const unsigned short* LIST; int gather;
    __device__ __forceinline__ bool next(int i, Unit& u) const {
        const int it = i * G + c; if (it >= total_rb * NT) return false;
        const int rb = it / NT, pn = it % NT, row0 = rb * BM;
        int e = 0; { int hi = NEXP;
#pragma unroll
            for (int st = 0; st < 6; ++st) { const int mid = (e + hi) >> 1; if (eoff[mid] <= row0) e = mid; else hi = mid; } }
        e = __builtin_amdgcn_readfirstlane(e);
        u.pm = rb; u.pn = pn; u.e = e; u.r0 = __builtin_amdgcn_readfirstlane(row0 - eoff[e]); u.cnt = __builtin_amdgcn_readfirstlane(ecnt[e]); u.row0 = row0;
        u.a = gather ? A : A + (size_t)row0 * arow_bytes; u.b = W + (size_t)e * wexp + (size_t)pn * tstepB; return true;
    }
    __device__ __forceinline__ void pace_arrive_wait(int, int, int) const {}
    __device__ __forceinline__ void pace_finish(int, int, int) const {}
    __device__ __forceinline__ unsigned row_off(const Unit& u, int row) const {
        const unsigned short* lp = LIST + (size_t)u.e * NTOK + u.r0;
        const unsigned tok = (row < u.cnt - u.r0) ? (unsigned)(lp[row] & 0x7fffu) : 0u; return tok * (unsigned)arow_bytes;
    }
};
struct EpiGateUp {
    static constexpr bool PERM = true, I8 = false;
    bf16* HID; const unsigned short* LIST; const float* RSTD2;
    __device__ __forceinline__ void operator()(const f32x4 (&acc)[2][2][4][2], const Unit& u, int wr, int wc, int fr, int fq) const {
        const int row0 = u.row0 + wr * 64 + fr, cb = u.pn * HALF + wc * 32 + 8 * fq;
        const unsigned short* lp = LIST + (size_t)u.e * NTOK + u.r0;
        unsigned tk[2][4]; float rs[2][4];
#pragma unroll
        for (int ai = 0; ai < 2; ++ai)
#pragma unroll
            for (int m = 0; m < 4; ++m) { const int lr = ai * HALF + wr * 64 + m * 16 + fr; tk[ai][m] = (lr < u.cnt - u.r0) ? (unsigned)(lp[lr] & 0x7fffu) : 0u; }
#pragma unroll
        for (int ai = 0; ai < 2; ++ai)
#pragma unroll
            for (int m = 0; m < 4; ++m) rs[ai][m] = RSTD2[tk[ai][m]];
#pragma unroll
        for (int ai = 0; ai < 2; ++ai)
#pragma unroll
            for (int m = 0; m < 4; ++m) { f32x4 v[2];
#pragma unroll
                for (int n = 0; n < 2; ++n) { const f32x4 g = acc[ai][0][m][n] * rs[ai][m], up = acc[ai][1][m][n] * rs[ai][m];
#pragma unroll
                    for (int j = 0; j < 4; ++j) v[n][j] = g[j] * fsig(g[j]) * up[j]; }
                *(u32x4*)(HID + (size_t)(row0 + ai * HALF + m * 16) * MH + cb) = pack8(v[0], v[1]); }
    }
};
struct EpiGateUpQ {
    static constexpr bool PERM = true, I8 = true;
    bf16* HID; const unsigned short* LIST; const float* RSTD2; const float* SA1; const float* CMU;
    __device__ __forceinline__ void operator()(const f32x4 (&acc)[2][2][4][2], const Unit& u, int wr, int wc, int fr, int fq) const {
        asm volatile("" : "+v"(fr), "+v"(fq));
        const int row0 = u.row0 + wr * 64 + fr, cb = u.pn * HALF + wc * 32 + 8 * fq;
        const float* cmp_ = CMU + (size_t)u.e * 1024 + u.pn * BM + wc * 64 + 8 * fq; f32x4 sw[2][2];
#pragma unroll
        for (int bj = 0; bj < 2; ++bj)
#pragma unroll
            for (int n = 0; n < 2; ++n) sw[bj][n] = *(const f32x4*)(cmp_ + bj * 32 + 4 * n) * (1.f / 127.f);
        const unsigned short* lp = LIST + (size_t)u.e * NTOK + u.r0;
        unsigned tk[2][4]; float rs[2][4];
#pragma unroll
        for (int ai = 0; ai < 2; ++ai)
#pragma unroll
            for (int m = 0; m < 4; ++m) { const int lr = ai * HALF + wr * 64 + m * 16 + fr; tk[ai][m] = (lr < u.cnt - u.r0) ? (unsigned)(lp[lr] & 0x7fffu) : 0u; }
#pragma unroll
        for (int ai = 0; ai < 2; ++ai)
#pragma unroll
            for (int m = 0; m < 4; ++m) rs[ai][m] = RSTD2[tk[ai][m]] * SA1[tk[ai][m]];
#pragma unroll
        for (int ai = 0; ai < 2; ++ai)
#pragma unroll
            for (int m = 0; m < 4; ++m) { f32x4 v[2];
#pragma unroll
                for (int n = 0; n < 2; ++n) { const f32x4 g = __builtin_convertvector(__builtin_bit_cast(i32x4, acc[ai][0][m][n]), f32x4) * rs[ai][m] * sw[0][n], up = __builtin_convertvector(__builtin_bit_cast(i32x4, acc[ai][1][m][n]), f32x4) * rs[ai][m] * sw[1][n];
#pragma unroll
                    for (int j = 0; j < 4; ++j) v[n][j] = g[j] * fsig(g[j]) * up[j]; }
                *(u32x4*)(HID + (size_t)(row0 + ai * HALF + m * 16) * MH + cb) = pack8(v[0], v[1]); }
    }
};
struct EpiDown {
    static constexpr bool PERM = true, I8 = false;
    const unsigned short* LIST; const float* TW; bf16* Y;
    __device__ __forceinline__ void operator()(const f32x4 (&acc)[2][2][4][2], const Unit& u, int wr, int wc, int fr, int fq) const {
        const bool odd = fr & 1; const int cl = u.pn * BM + wc * 64 + 8 * fq + (odd ? 32 : 0);
        const unsigned short* lp = LIST + (size_t)u.e * NTOK + u.r0;
        unsigned entE[2][4], entO[2][4]; float w[2][4];
#pragma unroll
        for (int ai = 0; ai < 2; ++ai)
#pragma unroll
            for (int m = 0; m < 4; ++m) { const int lr = ai * HALF + wr * 64 + m * 16 + (fr & ~1), nv = u.cnt - u.r0;
                entE[ai][m] = (lr < nv) ? (unsigned)lp[lr] : 0x10000u; entO[ai][m] = (lr + 1 < nv) ? (unsigned)lp[lr + 1] : 0x10000u; }
#pragma unroll
        for (int ai = 0; ai < 2; ++ai)
#pragma unroll
            for (int m = 0; m < 4; ++m) { const unsigned a = entE[ai][m], b = entO[ai][m], eo = odd ? b : a; w[ai][m] = TW[(eo & 0x7fffu) * 2 + ((eo >> 15) & 1u)]; }
#pragma unroll
        for (int ai = 0; ai < 2; ++ai)
#pragma unroll
            for (int m = 0; m < 4; ++m) { u32x4 a, b;
                line_pair(pack8(acc[ai][0][m][0] * w[ai][m], acc[ai][0][m][1] * w[ai][m]), pack8(acc[ai][1][m][0] * w[ai][m], acc[ai][1][m][1] * w[ai][m]), odd, a, b);
#pragma unroll
                for (int o = 0; o < 2; ++o) { const unsigned e = o ? entO[ai][m] : entE[ai][m]; if (!(e & 0x10000u)) { const unsigned tok = e & 0x7fffu, k = (e >> 15) & 1u;
                    *(u32x4*)(Y + (size_t)k * NTOK * D + (size_t)tok * D + cl) = o ? b : a; } } }
    }
};
}

namespace hg {
typedef short s16x4 __attribute__((ext_vector_type(4)));
typedef short bf16x8 __attribute__((ext_vector_type(8)));
typedef __bf16 bfv2 __attribute__((ext_vector_type(2)));
typedef float fv2 __attribute__((ext_vector_type(2)));
constexpr int RS = 272, IMG = 64 * RS;
constexpr int L_QI = 0, L_QR = IMG, L_KR = 2 * IMG, L_KL = 3 * IMG, L_V = 4 * IMG;
constexpr int L_SEG = 5 * IMG, L_D = L_SEG + 4096, L_RED = L_D + 512, L_RSTD = L_RED + 2048, L_END = L_RSTD + 256;
__device__ __forceinline__ unsigned cvtpk(float lo, float hi) { fv2 v; v.x = lo; v.y = hi; return __builtin_bit_cast(unsigned, __builtin_convertvector(v, bfv2)); }
__device__ __forceinline__ float blo(unsigned u) { return __uint_as_float(u << 16); }
__device__ __forceinline__ float bhi(unsigned u) { return __uint_as_float(u & 0xffff0000u); }
__device__ __forceinline__ bf16x8 frag_from2(const f32x4 a, const f32x4 b) { v4u w; w.x = cvtpk(a[0], a[1]); w.y = cvtpk(a[2], a[3]); w.z = cvtpk(b[0], b[1]); w.w = cvtpk(b[2], b[3]); return __builtin_bit_cast(bf16x8, w); }
__device__ __forceinline__ bf16x8 frag_tr2(LAS unsigned char* p0, LAS unsigned char* p1) {
    const s16x4 lo = __builtin_amdgcn_ds_read_tr16_b64_v4i16((LAS s16x4*)p0), hi = __builtin_amdgcn_ds_read_tr16_b64_v4i16((LAS s16x4*)p1);
    return __builtin_shufflevector(lo, hi, 0, 1, 2, 3, 4, 5, 6, 7); }
__device__ __forceinline__ bf16x8 frag_2x8(LAS unsigned char* p0, LAS unsigned char* p1) { v4u w; const v2u a = *(const LAS v2u*)p0, b = *(const LAS v2u*)p1; w.x = a.x; w.y = a.y; w.z = b.x; w.w = b.y; return __builtin_bit_cast(bf16x8, w); }
__device__ __forceinline__ float row_sum16(float s) {
    s += __int_as_float(__builtin_amdgcn_update_dpp(0, __float_as_int(s), 0x128, 0xf, 0xf, false));
    s += __int_as_float(__builtin_amdgcn_update_dpp(0, __float_as_int(s), 0x124, 0xf, 0xf, false));
    s += __int_as_float(__builtin_amdgcn_update_dpp(0, __float_as_int(s), 0x122, 0xf, 0xf, false));
    s += __int_as_float(__builtin_amdgcn_update_dpp(0, __float_as_int(s), 0x121, 0xf, 0xf, false));
    return s; }
#define HG_MFMA(a, b, c) __builtin_amdgcn_mfma_f32_16x16x32_bf16((a), (b), (c), 0, 0, 0)

template <bool P1>
__device__ __forceinline__ void unit(LAS unsigned char* lds, const bf16* HG, bf16* OREC, float* UST, float* DST, const float* ghg, const int u, const int tid) {
    const int lane = tid & 63, w = __builtin_amdgcn_readfirstlane(tid >> 6), r = lane & 15, q = lane >> 4;
    const int bh = u >> 5, j = u & 31, b = bh >> 3, h = bh & 7;
    const size_t row0 = (size_t)b * SEQ + (size_t)j * 512;
    f32x4 Sacc[8];
    float* ust = UST + (size_t)u * 16384 + (size_t)w * 2048 + lane;
#pragma unroll
    for (int kt = 0; kt < 8; ++kt)
#pragma unroll
        for (int rg = 0; rg < 4; ++rg) Sacc[kt][rg] = P1 ? 0.f : ust[(kt * 4 + rg) * 64];
    fv2 btot; btot.x = 0.f; btot.y = 0.f;
    unsigned gq[8], gg[8]; v4u rv[2], rgr[2];
#define HG_LOAD_RAW(c) do { const bf16* gp_ = HG + (size_t)h * HGPS + (row0 + (size_t)(c) * 64 + 8 * w) * 128 + 2 * lane; \
        _Pragma("unroll") for (int i = 0; i < 8; ++i) { if (!P1) { gq[i] = __builtin_nontemporal_load((const unsigned*)(gp_ + (size_t)i * 128)); gg[i] = __builtin_nontemporal_load((const unsigned*)(gp_ + (size_t)i * 128 + 8 * HGPS)); } else gg[i] = *(const unsigned*)(gp_ + (size_t)i * 128 + 8 * HGPS); } \
        _Pragma("unroll") for (int i = 0; i < 2; ++i) { const int ci_ = tid + 512 * i; const bf16* vp_ = HG + (size_t)h * HGPS + (row0 + (size_t)(c) * 64 + (ci_ >> 4)) * 128 + (ci_ & 15) * 8; \
            if (!P1) { rv[i] = __builtin_nontemporal_load((const v4u*)(vp_ + 16 * HGPS)); rgr[i] = __builtin_nontemporal_load((const v4u*)(vp_ + 24 * HGPS)); } else rv[i] = *(const v4u*)(vp_ + 16 * HGPS); } } while (0)
    HG_LOAD_RAW(0);
#pragma unroll 1
    for (int c = 0; c < 8; ++c) {
        const size_t rowc = row0 + (size_t)c * 64;
#pragma unroll
        for (int i = 0; i < 2; ++i) { const int ci = tid + 512 * i; *(LAS v4u*)(lds + L_V + (ci >> 4) * RS + (ci & 15) * 16) = rv[i]; }
        float c0[8], c1[8]; { float r0 = 0.f, r1 = 0.f;
#pragma unroll
            for (int i = 0; i < 8; ++i) { r0 += blo(gg[i]); r1 += bhi(gg[i]); c0[i] = r0; c1[i] = r1; }
            fv2 sv; sv.x = r0; sv.y = r1; *(LAS fv2*)(lds + L_SEG + (w * 128 + 2 * lane) * 4) = sv; }
        v4u grk[2];
        if (!P1) { grk[0] = rgr[0]; grk[1] = rgr[1]; }
        __syncthreads();
        float off0 = 0.f, off1 = 0.f, ref0 = 0.f, ref1 = 0.f, tot0 = 0.f, tot1 = 0.f;
#pragma unroll
        for (int s = 0; s < 8; ++s) { const fv2 sv = *(const LAS fv2*)(lds + L_SEG + (s * 128 + 2 * lane) * 4);
            if (s < w) { off0 += sv.x; off1 += sv.y; } if (s < 4) { ref0 += sv.x; ref1 += sv.y; } tot0 += sv.x; tot1 += sv.y; }
        if (w == 0) { fv2 dv; dv.x = fexp2(tot0); dv.y = fexp2(tot1); *(LAS fv2*)(lds + L_D + 2 * lane * 4) = dv; btot.x += tot0; btot.y += tot1; }
#pragma unroll
        for (int i = 0; i < 8; ++i) {
            const int t = 8 * w + i; const float b0 = off0 + c0[i], b1 = off1 + c1[i];
            const float k0 = 1.f - fexp2(blo(gg[i])), k1 = 1.f - fexp2(bhi(gg[i]));
            *(LAS unsigned*)(lds + L_KL + t * RS + 4 * lane) = cvtpk(k0 * fexp2(tot0 - b0), k1 * fexp2(tot1 - b1));
            if (!P1) { const float q0 = blo(gq[i]), q1 = bhi(gq[i]);
                *(LAS unsigned*)(lds + L_QI + t * RS + 4 * lane) = cvtpk(q0 * fexp2(b0), q1 * fexp2(b1));
                *(LAS unsigned*)(lds + L_QR + t * RS + 4 * lane) = cvtpk(q0 * fexp2(b0 - ref0), q1 * fexp2(b1 - ref1));
                *(LAS unsigned*)(lds + L_KR + t * RS + 4 * lane) = cvtpk(k0 * fexp2(ref0 - b0), k1 * fexp2(ref1 - b1)); }
        }
        __syncthreads();
        if (c + 1 < 8) HG_LOAD_RAW(c + 1);
        bf16x8 Vf[2];
#pragma unroll
        for (int cp = 0; cp < 2; ++cp) { LAS unsigned char* p0 = lds + L_V + (32 * cp + 4 * q + (r >> 2)) * RS + (16 * w + 4 * (r & 3)) * 2; Vf[cp] = frag_tr2(p0, p0 + 16 * RS); }
        f32x4 Oacc[4];
        if (!P1) {
#pragma unroll
            for (int ti = 0; ti < 4; ++ti) Oacc[ti] = (f32x4){0.f, 0.f, 0.f, 0.f};
#pragma unroll
            for (int cc = 0; cc < 4; ++cc) { const bf16x8 Sf = frag_from2(Sacc[2 * cc], Sacc[2 * cc + 1]);
#pragma unroll
                for (int ti = 0; ti < 4; ++ti) { LAS unsigned char* p = lds + L_QI + (16 * ti + r) * RS + 64 * cc + 8 * q; Oacc[ti] = HG_MFMA(frag_2x8(p, p + 32), Sf, Oacc[ti]); } }
#pragma unroll
            for (int ti = 0; ti < 4; ++ti) {
                f32x4 AT[4];
#pragma unroll
                for (int si = 0; si < 4; ++si) { AT[si] = (f32x4){0.f, 0.f, 0.f, 0.f};
                    if (si <= ti) {
#pragma unroll
                        for (int cc = 0; cc < 4; ++cc) { const bf16x8 A = *(const LAS bf16x8*)(lds + L_KR + (16 * si + r) * RS + 64 * cc + 16 * q); const bf16x8 B = *(const LAS bf16x8*)(lds + L_QR + (16 * ti + r) * RS + 64 * cc + 16 * q);
                            AT[si] = HG_MFMA(A, B, AT[si]); }
                        if (si == ti) {
#pragma unroll
                            for (int rg = 0; rg < 4; ++rg) if (4 * q + rg > r) AT[si][rg] = 0.f; }
                    } }
#pragma unroll
                for (int cp = 0; cp < 2; ++cp) if (cp <= (ti >> 1)) Oacc[ti] = HG_MFMA(frag_from2(AT[2 * cp], AT[2 * cp + 1]), Vf[cp], Oacc[ti]);
            }
        }
#pragma unroll
        for (int kt = 0; kt < 8; ++kt) { const f32x4 dv = *(const LAS f32x4*)(lds + L_D + (16 * kt + 4 * q) * 4); Sacc[kt] = Sacc[kt] * dv;
#pragma unroll
            for (int cp = 0; cp < 2; ++cp) { LAS unsigned char* p0 = lds + L_KL + (32 * cp + 4 * q + (r >> 2)) * RS + (16 * kt + 4 * (r & 3)) * 2; Sacc[kt] = HG_MFMA(frag_tr2(p0, p0 + 16 * RS), Vf[cp], Sacc[kt]); } }
        if (P1) { __syncthreads(); }
        else {
#pragma unroll
            for (int ti = 0; ti < 4; ++ti)
#pragma unroll
                for (int rg = 0; rg < 4; ++rg) { float s = Oacc[ti][rg] * Oacc[ti][rg];
                    s = row_sum16(s);
                    if (r == 0) *(LAS float*)(lds + L_RED + ((16 * ti + 4 * q + rg) * 8 + w) * 4) = s; }
            __syncthreads();
            if (tid < 64) { const f32x4 a = *(const LAS f32x4*)(lds + L_RED + tid * 32), bq = *(const LAS f32x4*)(lds + L_RED + tid * 32 + 16);
                *(LAS float*)(lds + L_RSTD + tid * 4) = rsqrtf((((a[0] + a[1]) + (a[2] + a[3])) + ((bq[0] + bq[1]) + (bq[2] + bq[3]))) * (1.f / 128.f) + EPS); }
            __syncthreads();
            { const float gv = ghg[16 * w + r];
#pragma unroll
                for (int ti = 0; ti < 4; ++ti) { const f32x4 rs = *(const LAS f32x4*)(lds + L_RSTD + (16 * ti + 4 * q) * 4);
#pragma unroll
                    for (int rg = 0; rg < 4; ++rg) *(LAS bf16*)(lds + L_QI + (16 * ti + 4 * q + rg) * RS + (16 * w + r) * 2) = (bf16)(cvtpk(Oacc[ti][rg] * rs[rg] * gv, 0.f) & 0xffffu); } }
            __syncthreads();
#pragma unroll
            for (int i = 0; i < 2; ++i) { const int ci = tid + 512 * i, row = ci >> 4, c16 = ci & 15;
                const v4u ov = *(const LAS v4u*)(lds + L_QI + row * RS + c16 * 16); const v4u gv = grk[i]; v4u o;
                o.x = cvtpk(blo(ov.x) * blo(gv.x), bhi(ov.x) * bhi(gv.x)); o.y = cvtpk(blo(ov.y) * blo(gv.y), bhi(ov.y) * bhi(gv.y));
                o.z = cvtpk(blo(ov.z) * blo(gv.z), bhi(ov.z) * bhi(gv.z)); o.w = cvtpk(blo(ov.w) * blo(gv.w), bhi(ov.w) * bhi(gv.w));
                *(v4u*)(OREC + (rowc + row) * HW + h * 128 + c16 * 8) = o; }
        }
    }
    if (P1) {
#pragma unroll
        for (int kt = 0; kt < 8; ++kt)
#pragma unroll
            for (int rg = 0; rg < 4; ++rg) ust[(kt * 4 + rg) * 64] = Sacc[kt][rg];
        if (w == 0) { fv2 dv; dv.x = fexp2(btot.x); dv.y = fexp2(btot.y); *(fv2*)(DST + (size_t)u * 128 + 2 * lane) = dv; }
    }
    __syncthreads();
#undef HG_LOAD_RAW
}
__device__ __forceinline__ void scan(float* UST, const float* DST, int gtid, int nthr) {
    for (int e = gtid; e < 16 * 16384; e += nthr) {
        const int bh = e >> 14, el = e & 16383, ln = el & 63, rg = (el >> 6) & 3, kt = (el >> 8) & 7, k = 16 * kt + 4 * (ln >> 4) + rg;
        float uu[32], dd[32];
        float* p0 = UST + (size_t)bh * 32 * 16384 + el; const float* d0 = DST + (size_t)bh * 32 * 128 + k;
#pragma unroll
        for (int j = 0; j < 32; ++j) { uu[j] = p0[(size_t)j * 16384]; dd[j] = d0[j * 128]; }
        float T = 0.f;
#pragma unroll
        for (int j = 0; j < 32; ++j) { p0[(size_t)j * 16384] = T; T = dd[j] * T + uu[j]; }
    }
}
}

namespace at {
typedef short bf16x8 __attribute__((ext_vector_type(8)));
constexpr int RSK = 144;
constexpr int L_K = 0, L_V = 272 * RSK, L_B = 2 * 272 * RSK, L_O = L_B + 4096, OW = 16 * RSK, L_END = L_O + 8 * OW;
__device__ __forceinline__ void item(LAS unsigned char* lds, bf16* QB, const bf16* KVB, const float* sinks, const float* rel, const int it, const int tid) {
    const int lane = tid & 63, w = __builtin_amdgcn_readfirstlane(tid >> 6), r = lane & 15, q = lane >> 4;
    const int kvh = it & 1, blk = (it >> 1) & 127, b = it >> 8, head = kvh * 8 + w;
    const size_t tok0 = (size_t)b * SEQ + (size_t)blk * 128;
    __syncthreads();
#pragma unroll
    for (int i = 0; i < 4; ++i) { const int ci = tid + 512 * i, row = ci >> 3, c8 = ci & 7; v4u kk = (v4u){0u, 0u, 0u, 0u}, vv = (v4u){0u, 0u, 0u, 0u};
        if (blk > 0 || row >= 128) { const bf16* p = KVB + (tok0 - 128 + row) * 256 + kvh * 64 + c8 * 8; kk = *(const v4u*)p; vv = *(const v4u*)(p + 128); }
        *(LAS v4u*)(lds + L_K + row * RSK + c8 * 16) = kk; *(LAS v4u*)(lds + L_V + row * RSK + c8 * 16) = vv; }
    if (tid < 128) *(LAS v4u*)(lds + L_V + (256 + (tid >> 3)) * RSK + (tid & 7) * 16) = (v4u){0u, 0u, 0u, 0u};
#pragma unroll
    for (int i = 0; i < 2; ++i) { const int e = tid + 512 * i, g = e >> 7, d = e & 127; int bk;
        if (d < 16) bk = d; else { bk = 16 + (int)(__logf((float)d * (1.f / 16.f)) / 2.0794415416798357f * 16.f); if (bk > 31) bk = 31; }
        *(LAS float*)(lds + L_B + e * 4) = rel[bk * 16 + kvh * 8 + g] * LOG2E; }
    __syncthreads();
    float bv[9][4];
#pragma unroll
    for (int kt = 0; kt < 9; ++kt)
#pragma unroll
        for (int rg = 0; rg < 4; ++rg) { const int dist = 128 - 16 * kt + r - 4 * q - rg; const bool ok = dist >= 0 && dist < 128;
            const float bb = *(const LAS float*)(lds + L_B + (w * 128 + (ok ? dist : 0)) * 4); bv[kt][rg] = ok ? bb : -1e30f; }
    const float sink = sinks[head] * LOG2E;
    bf16x8 Qn0, Qn1; { const bf16* qrow = QB + (tok0 + r) * QW + head * 64 + 8 * q; Qn0 = *(const bf16x8*)qrow; Qn1 = *(const bf16x8*)(qrow + 32); }
#pragma unroll 1
    for (int qt = 0; qt < 8; ++qt) {
        const bf16x8 Qf0 = Qn0, Qf1 = Qn1;
        if (qt + 1 < 8) { const bf16* qrow = QB + (tok0 + 16 * (qt + 1) + r) * QW + head * 64 + 8 * q; Qn0 = *(const bf16x8*)qrow; Qn1 = *(const bf16x8*)(qrow + 32); }
        f32x4 ST[9];
#pragma unroll
        for (int kt = 0; kt < 9; ++kt) {
            if (blk == 0 && qt + kt < 8) { ST[kt] = (f32x4){-1e30f, -1e30f, -1e30f, -1e30f}; }
            else { LAS unsigned char* kp = lds + L_K + (16 * (qt + kt) + r) * RSK + 16 * q; f32x4 a = (f32x4){0.f, 0.f, 0.f, 0.f};
                a = __builtin_amdgcn_mfma_f32_16x16x32_bf16(*(const LAS bf16x8*)kp, Qf0, a, 0, 0, 0); a = __builtin_amdgcn_mfma_f32_16x16x32_bf16(*(const LAS bf16x8*)(kp + 64), Qf1, a, 0, 0, 0);
#pragma unroll
                for (int rg = 0; rg < 4; ++rg) ST[kt][rg] = a[rg] + bv[kt][rg]; } }
        float m = sink;
#pragma unroll
        for (int kt = 0; kt < 9; ++kt)
#pragma unroll
            for (int rg = 0; rg < 4; ++rg) m = fmaxf(m, ST[kt][rg]);
        m = fmaxf(m, shx(m, 16, lane)); m = fmaxf(m, shx(m, 32, lane));
        float l = 0.f;
#pragma unroll
        for (int kt = 0; kt < 9; ++kt)
#pragma unroll
            for (int rg = 0; rg < 4; ++rg) { const float p = fexp2(ST[kt][rg] - m); ST[kt][rg] = p; l += p; }
        l += shx(l, 16, lane); l += shx(l, 32, lane);
        const float inv = 1.f / (l + fexp2(sink - m));
        f32x4 O[4];
#pragma unroll
        for (int dt = 0; dt < 4; ++dt) O[dt] = (f32x4){0.f, 0.f, 0.f, 0.f};
#pragma unroll
        for (int cp = 0; cp < 5; ++cp) {
            const f32x4 pa = ST[2 * cp] * inv, pb = (2 * cp + 1 < 9) ? ST[(2 * cp + 1 < 9) ? 2 * cp + 1 : 8] * inv : (f32x4){0.f, 0.f, 0.f, 0.f};
            const bf16x8 P = hg::frag_from2(pa, pb);
#pragma unroll
            for (int dt = 0; dt < 4; ++dt) { LAS unsigned char* p0 = lds + L_V + (16 * (qt + 2 * cp) + 4 * q + (r >> 2)) * RSK + (16 * dt + 4 * (r & 3)) * 2;
                O[dt] = __builtin_amdgcn_mfma_f32_16x16x32_bf16(P, hg::frag_tr2(p0, p0 + 16 * RSK), O[dt], 0, 0, 0); } }
        LAS unsigned char* ow = lds + L_O + w * OW;
#pragma unroll
        for (int dt = 0; dt < 4; ++dt)
#pragma unroll
            for (int rg = 0; rg < 4; ++rg) *(LAS bf16*)(ow + (4 * q + rg) * RSK + (16 * dt + r) * 2) = (bf16)(hg::cvtpk(O[dt][rg], 0.f) & 0xffffu);
#pragma unroll
        for (int i = 0; i < 2; ++i) { const int ci = lane + 64 * i, row = ci >> 3, c8 = ci & 7;
            const v4u v = *(const LAS v4u*)(ow + row * RSK + c8 * 16); *(v4u*)(QB + (tok0 + 16 * qt + row) * QW + head * 64 + c8 * 8) = v; }
    }
}
}

namespace rt {
typedef short bf16x8 __attribute__((ext_vector_type(8)));
__device__ __forceinline__ void prep_w(const float* wco, const float* wfi, const float* gf, bf16* WRH, bf16* WRL, int gtid, int nthr) {
    for (int e = gtid; e < 80 * D; e += nthr) { const int n = e >> 11, k = e & 2047;
        const float w = (n < 8) ? wco[k * 8 + n] : (n < 72 ? wfi[k * 64 + (n - 8)] : 0.f); const float v = w * gf[k];
        const unsigned h = hg::cvtpk(v, 0.f) & 0xffffu; const float l = v - __uint_as_float(h << 16);
        WRH[e] = (bf16)h; WRL[e] = (bf16)(hg::cvtpk(l, 0.f) & 0xffffu); }
}
constexpr int RSB = 272, BUFB = 2 * 80 * RSB, L_G = 2 * BUFB, L_LW = L_G + 8192, L_HIST = L_LW + 8 * 5120;
__device__ __forceinline__ void pass(LAS unsigned char* lds, const float* x, const bf16* DL, float* RSTD2, const float* gf, const bf16* WRH, const bf16* WRL, const float* bco, const float* bfi,
                                     bf16* XN, float* TW, const int tl, const bool live, const int tid, int& ea_out, int& eb_out) {
    const int lane = tid & 63, w = __builtin_amdgcn_readfirstlane(tid >> 6), r = lane & 15, q = lane >> 4;
    const int tok = live ? tl * 16 + r : r;
    LAS float* lw = (LAS float*)(lds + L_LW + w * 5120);
    v4u st[5];
#define RT_BLOAD(ck_) do { _Pragma("unroll") for (int i = 0; i < 5; ++i) { const int p_ = tid + 512 * i, mat_ = p_ >= 1280, rem_ = p_ - 1280 * mat_, n_ = rem_ >> 4, j_ = rem_ & 15; \
        st[i] = *(const v4u*)((mat_ ? WRL : WRH) + (size_t)n_ * D + (ck_) * 128 + j_ * 8); } } while (0)
#define RT_BSTORE(buf_) do { _Pragma("unroll") for (int i = 0; i < 5; ++i) { const int p_ = tid + 512 * i, mat_ = p_ >= 1280, rem_ = p_ - 1280 * mat_, n_ = rem_ >> 4, j_ = rem_ & 15; \
        *(LAS v4u*)(lds + (buf_) * BUFB + mat_ * 80 * RSB + n_ * RSB + j_ * 16) = st[i]; } } while (0)
    RT_BLOAD(0);
    const float* xr = x + (size_t)tok * D + 8 * q; bf16* xo = XN + (size_t)tok * D + 8 * q;
    const int tl0 = live ? tl : 0, t0 = (tl0 & 15) * 16;
    const unsigned char* dbase = (const unsigned char*)DL + (size_t)(tl0 >> 4) * 8 * 131072 + (((t0 >> 7) * 4 + ((t0 >> 4) & 3)) * 2) * 8192 + (((t0 >> 6) & 1) * 4) * 1024 + (q * 16 + r) * 16;
    f32x4 X[4][2]; v4u Dl[4];
#define RT_XLOAD(ck_) do { _Pragma("unroll") for (int s_ = 0; s_ < 4; ++s_) { const int c_ = 4 * (ck_) + s_; X[s_][0] = __builtin_nontemporal_load((const f32x4*)(xr + 32 * c_)); \
        X[s_][1] = __builtin_nontemporal_load((const f32x4*)(xr + 32 * c_ + 4)); Dl[s_] = __builtin_nontemporal_load((const v4u*)(dbase + (size_t)(c_ >> 3) * 131072 + (c_ & 1) * 8192 + ((c_ >> 1) & 3) * 1024)); } } while (0)
    RT_XLOAD(0);
    RT_BSTORE(0);
    __syncthreads();
    f32x4 acc[5];
#pragma unroll
    for (int nt = 0; nt < 5; ++nt) acc[nt] = (f32x4){0.f, 0.f, 0.f, 0.f};
    float ssq = 0.f;
#pragma unroll 1
    for (int ck = 0; ck < 16; ++ck) {
        f32x4 Xc[4][2]; v4u Dc[4];
#pragma unroll
        for (int s_ = 0; s_ < 4; ++s_) { Xc[s_][0] = X[s_][0]; Xc[s_][1] = X[s_][1]; Dc[s_] = Dl[s_]; }
        if (ck + 1 < 16) { RT_BLOAD(ck + 1); RT_XLOAD(ck + 1); }
        LAS unsigned char* bb = lds + (ck & 1) * BUFB + r * RSB + 16 * q;
#pragma unroll
        for (int s_ = 0; s_ < 4; ++s_) {
            const int c = 4 * ck + s_;
            f32x4 x0 = Xc[s_][0], x1 = Xc[s_][1]; { f32x4 d0, d1; pg8::unpack8(Dc[s_], d0, d1); x0 += d0; x1 += d1; }
            ssq += ((x0[0] * x0[0] + x0[1] * x0[1]) + (x0[2] * x0[2] + x0[3] * x0[3])) + ((x1[0] * x1[0] + x1[1] * x1[1]) + (x1[2] * x1[2] + x1[3] * x1[3]));
            v4u hi; hi.x = hg::cvtpk(x0[0], x0[1]); hi.y = hg::cvtpk(x0[2], x0[3]); hi.z = hg::cvtpk(x1[0], x1[1]); hi.w = hg::cvtpk(x1[2], x1[3]);
            if (live) *(v4u*)(xo + 32 * c) = hi;
            v4u lo; lo.x = hg::cvtpk(x0[0] - hg::blo(hi.x), x0[1] - hg::bhi(hi.x)); lo.y = hg::cvtpk(x0[2] - hg::blo(hi.y), x0[3] - hg::bhi(hi.y));
            lo.z = hg::cvtpk(x1[0] - hg::blo(hi.z), x1[1] - hg::bhi(hi.z)); lo.w = hg::cvtpk(x1[2] - hg::blo(hi.w), x1[3] - hg::bhi(hi.w));
            const bf16x8 Ah = __builtin_bit_cast(bf16x8, hi), Al = __builtin_bit_cast(bf16x8, lo);
#pragma unroll
            for (int nt = 0; nt < 5; ++nt) { const bf16x8 Bh = *(const LAS bf16x8*)(bb + nt * 16 * RSB + 64 * s_), Bl = *(const LAS bf16x8*)(bb + 80 * RSB + nt * 16 * RSB + 64 * s_);
                acc[nt] = __builtin_amdgcn_mfma_f32_16x16x32_bf16(Ah, Bh, acc[nt], 0, 0, 0); acc[nt] = __builtin_amdgcn_mfma_f32_16x16x32_bf16(Ah, Bl, acc[nt], 0, 0, 0);
                acc[nt] = __builtin_amdgcn_mfma_f32_16x16x32_bf16(Al, Bh, acc[nt], 0, 0, 0); }
        }
        if (ck + 1 < 16) RT_BSTORE((ck + 1) & 1);
        __syncthreads();
    }
#undef RT_BLOAD
#undef RT_BSTORE
#undef RT_XLOAD
    ssq += shx(ssq, 16, lane); ssq += shx(ssq, 32, lane);
    const float rstd = rsqrtf(ssq * (1.f / D) + EPS);
    if (live && q == 0) RSTD2[tok] = rstd;
#pragma unroll
    for (int nt = 0; nt < 5; ++nt)
#pragma unroll
        for (int rg = 0; rg < 4; ++rg) lw[(4 * q + rg) * 80 + 16 * nt + r] = acc[nt][rg];
    asm volatile("s_waitcnt lgkmcnt(0)" ::: "memory");
    if (live && lane < 16) {
        const LAS float* L = lw + lane * 80;
        float cm = L[0] * rstd + bco[0]; int grp = 0; float cv[8]; cv[0] = cm;
#pragma unroll
        for (int j = 1; j < 8; ++j) { cv[j] = L[j] * rstd + bco[j]; if (cv[j] > cm) { cm = cv[j]; grp = j; } }
        float den = 0.f;
#pragma unroll
        for (int j = 0; j < 8; ++j) den += fexp(cv[j] - cm);
        const float psel = 1.f / den;
        float f[8];
#pragma unroll
        for (int j = 0; j < 8; ++j) f[j] = L[8 + grp * 8 + j] * rstd + bfi[grp * 8 + j];
        int i0 = 0; float f0 = f[0];
#pragma unroll
        for (int j = 1; j < 8; ++j) if (f[j] > f0) { f0 = f[j]; i0 = j; }
        int i1 = -1; float f1 = 0.f;
#pragma unroll
        for (int j = 0; j < 8; ++j) if (j != i0 && (i1 < 0 || f[j] > f1)) { f1 = f[j]; i1 = j; }
        const float e1 = fexp(f1 - f0), w0 = psel / (1.f + e1), w1 = psel * e1 / (1.f + e1);
        ea_out = grp * 8 + i0; eb_out = grp * 8 + i1;
        TW[tok * 2] = w0; TW[tok * 2 + 1] = w1;
    }
}
}

constexpr int LDS_BYTES = 155648;
constexpr int LDS_MISC = 152576;

__global__ void __launch_bounds__(NTHR, 2) fwd_kernel(Args args) {
    extern __shared__ __attribute__((aligned(16))) unsigned char lds_raw[];
    LAS unsigned char* lds = (LAS unsigned char*)lds_raw;
    LAS float* ldsf = (LAS float*)lds;
    volatile LAS unsigned* MISC = (volatile LAS unsigned*)(lds + LDS_MISC);
    int tid = threadIdx.x; asm volatile("" : "+v"(tid));
    int lane = tid & 63, wave = __builtin_amdgcn_readfirstlane(tid >> 6);
#define GRID_SYNC() do { xcd_barrier(bar, tid); asm volatile("" : "+v"(tid)); lane = tid & 63; wave = __builtin_amdgcn_readfirstlane(tid >> 6); gw = bx * NWAVES + wave; } while (0)
    const int G = gridDim.x, bx = blockIdx.x;
    int gw = bx * NWAVES + wave; const int NGW = G * NWAVES;
    unsigned char* ws = args.ws;
    unsigned* ctl = (unsigned*)(ws + WS_CTL);
    if (tid < 64) MISC[tid] = 0u;
    __syncthreads();
    XcdBarrier bar = xcd_barrier_post(ctl + CW_BAR, MISC + 8, tid);

    const float* x = args.in[I_X];
    float* hbuf = args.out;
    float* LB = (float*)(ws + WS_SMALL);
    float* TW = (float*)(ws + WS_SMALL + 65536);
    unsigned short* LIST = (unsigned short*)(ws + WS_LIST);
    bf16* W_IN_T = (bf16*)(ws + WS_WIN); bf16* W_UA_T = (bf16*)(ws + WS_WUA); bf16* W_UR_T = (bf16*)(ws + WS_WUR);
    bf16* W_OUT_T = (bf16*)(ws + WS_WOUT); bf16* W_PG_T = (bf16*)(ws + WS_WPG); bf16* W_PI_T = (bf16*)(ws + WS_WPI);
    bf16* U = (bf16*)(ws + WS_RA); bf16* OREC = (bf16*)(ws + WS_RA); bf16* XN = (bf16*)(ws + WS_RA);
    bf16* QB = (bf16*)(ws + WS_RB); bf16* KVB = (bf16*)(ws + WS_RB + 64 * MiB); bf16* HID = (bf16*)(ws + WS_RB); unsigned char* H2Q = (unsigned char*)(ws + WS_RB)  ; bf16* PB = (bf16*)(ws + WS_PB);
    bf16* HG = (bf16*)(ws + WS_RC); bf16* MIX = (bf16*)(ws + WS_RC); bf16* Y = (bf16*)(ws + WS_RE);
    bf16* GT = (bf16*)(ws + WS_RD); bf16* W_DN_T = (bf16*)(ws + WS_RD); bf16* PL = (bf16*)(ws + WS_RD + 128 * MiB);
    bf16* W_GU_T = (bf16*)(ws + WS_RE);
    float* RSTDP = (float*)(ws + WS_SMALL + 393216); float* RSTD3 = (float*)(ws + WS_SMALL + 524288); float* RSTD2 = (float*)(ws + WS_SMALL + 655360);
    bf16* DELTA = (bf16*)(ws + WS_RC + 128 * MiB);
    bf16* H3B = (bf16*)(ws + WS_RC);
    bf16* WRH = (bf16*)(ws + 6 * MiB); bf16* WRL = (bf16*)(ws + 6 * MiB + 512 * 1024);
    float* UST = (float*)(ws + WS_RA + 64 * MiB); float* DST = (float*)(ws + WS_RA + 96 * MiB);
    float* SS_H1 = (float*)(ws + WS_SS); float* SS_PL = (float*)(ws + WS_SS + 4 * MiB); float* SS_FIN = (float*)(ws + WS_SS + 8 * MiB);
    unsigned* CNT = ctl + CW_CNT; unsigned* CMAX = ctl + 24576;
    unsigned* CMG = ctl + 32768;
    unsigned* CMO = ctl + 32768 + INC;
    unsigned char* H1Q = (unsigned char*)args.out; float* SA1 = (float*)((unsigned char*)args.out + 64 * MiB);
    float* CMU = (float*)(ws + WS_SS + MiB);
    LAS float* xchL = ldsf + 8 * 4096; LAS float* gsL = xchL + 256;
    unsigned char* MIXQ = (unsigned char*)(ws + WS_RD);
    float* SAM = (float*)(ws + WS_SMALL + 917504);
    unsigned char* U8 = (unsigned char*)args.out;
    float* SAU = (float*)(ws + WS_SMALL + 786432);
    LAS unsigned char* ring = lds;

#ifndef REP_P0
#define REP_P0 1
#endif
#ifndef REP_P1
#define REP_P1 1
#endif
#pragma unroll 1
    for (int rep = 0; rep < REP_P0; ++rep) {
        LAS float* scr = ldsf + wave * 4096;
        transpose_all(args.in[I_WUA], QW, D, W_UA_T, scr, gw, NGW, lane, QW);
        transpose_all(args.in[I_WUR], HW, D, W_UR_T, scr, gw, NGW, lane, HW);
        transpose_all(args.in[I_WPI], PLE, D, W_PI_T, scr, gw, NGW, lane, PLE);
        for (int i = tid; i < D; i += NTHR) gsL[i] = args.in[I_GFFN][i];
        __syncthreads();
        constexpr int NI_E = (NEXP - 16) * 32, NI_IN = INC / 32, NI_O = D / 32;
        for (int wi = bx; wi < NI_E + NI_IN + 2 * NI_O; wi += G) {
            if (wi < NI_E) { const int e = wi >> 5, mat = (wi >> 4) & 1, nb = wi & 15;
                wgu_item_q(args.in[mat ? I_WU : I_WG] + (size_t)e * D * MH, (unsigned char*)W_GU_T + (size_t)e * 1024 * D, CMU + (size_t)e * 1024, nb, 1 + mat, scr, xchL, gsL, wave, lane); }
            else if (wi < NI_E + NI_IN) { const int n0 = 32 * (wi - NI_E); coop_item_q(args.in[I_WIN], INC, (unsigned char*)W_IN_T, 2 * D, (float*)CMG, n0, n0, nullptr, scr, xchL, wave, lane); }
            else if (wi < NI_E + NI_IN + NI_O) { const int n0 = 32 * (wi - NI_E - NI_IN); coop_item_q(args.in[I_WOUT], D, (unsigned char*)W_OUT_T, D, (float*)CMO, n0, n0, nullptr, scr, xchL, wave, lane); }
            else { const int n0 = 32 * (wi - NI_E - NI_IN - NI_O); coop_item_q(args.in[I_WPG], D, (unsigned char*)W_PG_T, D, (float*)CMAX, n0, n0, nullptr, scr, xchL, wave, lane); } }
        for (int m = gw; m < NTOK; m += NGW) { const f32x4 pv = __builtin_nontemporal_load((const f32x4*)(args.in[I_P] + (size_t)m * PLE) + lane);
            v2u w; w.x = pk2(pv.x, pv.y); w.y = pk2(pv.z, pv.w); *((v2u*)(PB + (size_t)m * PLE) + lane) = w; }
        const float* gm = args.in[I_GMIX];
        for (int m = gw; m < NTOK; m += NGW) {
            const f32x4* xr = (const f32x4*)(x + (size_t)m * D) + lane;
            f32x4 v[8]; float s = 0.f;
#pragma unroll
            for (int j = 0; j < 8; ++j) { v[j] = __builtin_nontemporal_load(xr + 64 * j); s += (v[j].x * v[j].x + v[j].y * v[j].y) + (v[j].z * v[j].z + v[j].w * v[j].w); }
            const float rstd = rsqrtf(wave_sum(s, lane) * (1.f / D) + EPS);
            float amax = 0.f;
#pragma unroll
            for (int j = 0; j < 8; ++j) { const f32x4 g = *((const f32x4*)gm + 64 * j + lane); v[j] = v[j] * rstd * g;
                amax = fmaxf(fmaxf(amax, fmaxf(fabsf(v[j].x), fabsf(v[j].y))), fmaxf(fabsf(v[j].z), fabsf(v[j].w))); }
#pragma unroll
            for (int o2 = 1; o2 < 64; o2 <<= 1) amax = fmaxf(amax, shx(amax, o2, lane));
            { const float qs = amax > 0.f ? 127.f / amax : 0.f; unsigned* q = (unsigned*)(U8 + (size_t)m * (2 * D)) + lane;
#pragma unroll
                for (int j = 0; j < 8; ++j) q[64 * j] = ((unsigned)(int)rintf(v[j].x * qs) & 0xffu) | (((unsigned)(int)rintf(v[j].y * qs) & 0xffu) << 8) | (((unsigned)(int)rintf(v[j].z * qs) & 0xffu) << 16) | ((unsigned)(int)rintf(v[j].w * qs) << 24);
                if (lane == 0) SAU[m] = amax * (1.f / 127.f); }
        }
        rt::prep_w(args.in[I_WCO], args.in[I_WFI], args.in[I_GFFN], WRH, WRL, bx * NTHR + tid, G * NTHR);
        const float* lbl = args.in[I_LBL];
        for (int j = bx * NTHR + tid; j < HW; j += G * NTHR) LB[j] = 1.f / (1.f + __expf(lbl[HW + j] - lbl[j]));
    }
    GRID_SYNC();

#pragma unroll 1
    for (int rep = 0; rep < REP_P1; ++rep) {
        pg8::StaticOrder S; S.init(U, W_IN_T, NTOK, INC, D, D, G, bx);
        pg8::EpiZ E{args.in[I_BQKV], LB, QB, KVB, HG, GT, SAU, (const float*)CMG};
        pg8::ZOrder SZ{S, (const char*)U8, D / 64, D / 128};
        pg8::gemm_phase<pg8::EpiZ, pg8::ZOrder, true, false>(ring, D, D, D, SZ, E, tid);
        const int nshort = G - (S.nwg % G);
        if (S.nwg % G == 0 || bx >= S.nwg % G) { LAS float* scr = ldsf + wave * 4096; const int first = (S.nwg % G == 0) ? bx : bx - S.nwg % G, step = (S.nwg % G == 0) ? G : nshort;
            for (int i = tid; i < D; i += NTHR) gsL[i] = args.in[I_GFFN][i];
            __syncthreads();
            for (int wi = first; wi < 16 * 32; wi += step) { const int e = (NEXP - 16) + (wi >> 5), mat = (wi >> 4) & 1, nb = wi & 15;
                wgu_item_q(args.in[mat ? I_WU : I_WG] + (size_t)e * D * MH, (unsigned char*)W_GU_T + (size_t)e * 1024 * D, CMU + (size_t)e * 1024, nb, 1 + mat, scr, xchL, gsL, wave, lane); } }
    }
    GRID_SYNC();

    for (int u = bx; u < 512; u += G) hg::unit<true>(lds, HG, OREC, UST, DST, args.in[I_GHGRN], u, tid);
    for (int it = bx; it < 2 * 128 * 2; it += G) at::item(lds, QB, KVB, args.in[I_SINKS], args.in[I_REL], it, tid);
    GRID_SYNC();

    hg::scan(UST, DST, bx * NTHR + tid, G * NTHR);
    GRID_SYNC();
    for (int u = bx; u < 512; u += G) hg::unit<false>(lds, HG, OREC, UST, DST, args.in[I_GHGRN], u, tid);
    GRID_SYNC();

    {
        pg8::PairOrder S; S.s0.init(QB, W_UA_T, NTOK, D, QW, QW, G, bx); S.A1 = (const char*)OREC; S.B1 = (const char*)W_UR_T;
        pg8::EpiMix E{GT, MIX, (unsigned char*)UST + (size_t)bx * 131072};
        pg8::gemm_phase<pg8::EpiMix, pg8::PairOrder, true, false>(ring, QW, QW, QW, S, E, tid);
    }
    GRID_SYNC();

    for (int m = gw; m < NTOK; m += NGW) {
        const v2u* mr = (const v2u*)(MIX + (size_t)m * D) + lane; f32x4 v[8]; float amax = 0.f;
#pragma unroll
        for (int j = 0; j < 8; ++j) { const v2u a = __builtin_nontemporal_load(mr + 64 * j);
            v[j].x = __uint_as_float(a.x << 16); v[j].y = __uint_as_float(a.x & 0xffff0000u); v[j].z = __uint_as_float(a.y << 16); v[j].w = __uint_as_float(a.y & 0xffff0000u);
            amax = fmaxf(fmaxf(amax, fmaxf(fabsf(v[j].x), fabsf(v[j].y))), fmaxf(fabsf(v[j].z), fabsf(v[j].w))); }
#pragma unroll
        for (int o2 = 1; o2 < 64; o2 <<= 1) amax = fmaxf(amax, shx(amax, o2, lane));
        const float qs = amax > 0.f ? 127.f / amax : 0.f; unsigned* q = (unsigned*)(MIXQ + (size_t)m * D) + lane;
#pragma unroll
        for (int j = 0; j < 8; ++j) q[64 * j] = ((unsigned)(int)rintf(v[j].x * qs) & 0xffu) | (((unsigned)(int)rintf(v[j].y * qs) & 0xffu) << 8) | (((unsigned)(int)rintf(v[j].z * qs) & 0xffu) << 16) | ((unsigned)(int)rintf(v[j].w * qs) << 24);
        if (lane == 0) SAM[m] = amax * (1.f / 127.f);
    }
    GRID_SYNC();

    {
        pg8::StaticOrder S; S.init((const bf16*)MIXQ, W_OUT_T, NTOK, D, D / 2, D / 2, G, bx);
        pg8::EpiDeltaQ E{DELTA, SAM, (const float*)CMO};
        pg8::gemm_phase<pg8::EpiDeltaQ, pg8::StaticOrder, true, false>(ring, D / 2, D / 2, D / 2, S, E, tid);
    }
    GRID_SYNC();

    {
        {
            LAS float* scr = ldsf + wave * 4096;
            for (int it = gw; it < NEXP * 512; it += NGW) { const int e = it >> 9, item = it & 511;
                transpose_item(args.in[I_WD] + (size_t)e * MH * D, MH, D, W_DN_T + (size_t)e * D * MH, scr, item, lane, 0, MH); }
        }
        __syncthreads();
        LAS unsigned* hist = (LAS unsigned*)(lds + rt::L_HIST);
        for (int i = 0; i * NGW < NTOK / 16; ++i) {
            const int tl = gw + i * NGW; const bool live = tl < NTOK / 16;
            __syncthreads();
            if (tid < 64) hist[tid] = 0u;
            int ea = 0, eb = 0; unsigned ra = 0u, rb = 0u;
            rt::pass(lds, x, DELTA, RSTD2, args.in[I_GFFN], WRH, WRL, args.in[I_BCO], args.in[I_BFI], XN, TW, tl, live, tid, ea, eb);
            if (live && lane < 16) { ra = atomicAdd((unsigned*)(hist + ea), 1u); rb = atomicAdd((unsigned*)(hist + eb), 1u); }
            __syncthreads();
            if (tid < 64) { const unsigned c = hist[tid]; hist[64 + tid] = c ? atomicAdd(CNT + 64 * tid, c) : 0u; }
            __syncthreads();
            if (live && lane < 16) { const int m = tl * 16 + lane;
                LIST[(size_t)ea * NTOK + hist[64 + ea] + ra] = (unsigned short)m; LIST[(size_t)eb * NTOK + hist[64 + eb] + rb] = (unsigned short)(m | 0x8000); }
        }
    }
    GRID_SYNC();

    LAS int* eoff = (LAS int*)(lds + 150528);
    LAS int* ecnt = (LAS int*)(lds + 150528 + 512);
    if (tid < 64) {
        const int c = (int)__hip_atomic_load(CNT + 64 * tid, __ATOMIC_RELAXED, __HIP_MEMORY_SCOPE_AGENT); int v = (c + 255) & ~255;
#pragma unroll
        for (int d = 1; d < 64; d <<= 1) { const int t = __builtin_amdgcn_ds_bpermute((lane - d) << 2, v); if (lane >= d) v += t; }
        ecnt[tid] = c; eoff[tid] = v - ((c + 255) & ~255); if (tid == 63) eoff[NEXP] = v;
    }
    __syncthreads();
    const int vcu = (G % 8 == 0) ? (bx % 8) * (G / 8) + bx / 8 : bx;
    const int nrb = eoff[NEXP] / 256;
    for (int m = gw; m < NTOK; m += NGW) {
        const v2u* mr = (const v2u*)(XN + (size_t)m * D) + lane; f32x4 v[8]; float amax = 0.f;
#pragma unroll
        for (int j = 0; j < 8; ++j) { const v2u a = mr[64 * j];
            v[j].x = __uint_as_float(a.x << 16); v[j].y = __uint_as_float(a.x & 0xffff0000u); v[j].z = __uint_as_float(a.y << 16); v[j].w = __uint_as_float(a.y & 0xffff0000u);
            amax = fmaxf(fmaxf(amax, fmaxf(fabsf(v[j].x), fabsf(v[j].y))), fmaxf(fabsf(v[j].z), fabsf(v[j].w))); }
#pragma unroll
        for (int o2 = 1; o2 < 64; o2 <<= 1) amax = fmaxf(amax, __int_as_float(__builtin_amdgcn_ds_bpermute((lane ^ o2) << 2, __float_as_int(amax))));
        const float qs = amax > 0.f ? 127.f / amax : 0.f; unsigned* q = (unsigned*)(H1Q + (size_t)m * D) + lane;
#pragma unroll
        for (int j = 0; j < 8; ++j) q[64 * j] = ((unsigned)(int)rintf(v[j].x * qs) & 0xffu) | (((unsigned)(int)rintf(v[j].y * qs) & 0xffu) << 8) | (((unsigned)(int)rintf(v[j].z * qs) & 0xffu) << 16) | ((unsigned)(int)rintf(v[j].w * qs) << 24);
        if (lane == 0) SA1[m] = amax * (1.f / 127.f);
    }
    GRID_SYNC();
    {
        pg8::MoeOrder S{eoff, ecnt, 4, G, vcu, nrb, (const char*)H1Q, (const char*)W_GU_T, (size_t)1024 * D, (size_t)256 * D, (size_t)D, LIST, 1};
        pg8::EpiGateUpQ E{HID, LIST, RSTD2, SA1, CMU};
        pg8::gemm_phase<pg8::EpiGateUpQ, pg8::MoeOrder, true, true>(ring, D / 2, D / 2, D / 2, S, E, tid);
    }
    const int r6 = (nrb * 4) % G, ple_early = r6 ? ((G - r6) * 4 < 1024 ? (G - r6) * 4 : 1024) : 0;
    if (r6 && vcu >= r6) {
        pg8::StaticOrder S; S.init(PB, W_PI_T, NTOK, D, PLE, PLE, 1, 0); S.lo = (vcu - r6) * 4; S.hi = S.lo + 4 < ple_early ? S.lo + 4 : ple_early;
        pg8::EpiPleRaw E{PL, SS_PL};
        pg8::gemm_phase<pg8::EpiPleRaw, pg8::StaticOrder, true, false>(ring, PLE, PLE, PLE, S, E, tid);
    }
    GRID_SYNC();
    {
        pg8::MoeOrder S{eoff, ecnt, 8, G, vcu, nrb, (const char*)HID, (const char*)W_DN_T, (size_t)D * MH * 2, (size_t)256 * MH * 2, (size_t)MH * 2, LIST, 0};
        pg8::EpiDown E{LIST, TW, Y};
        pg8::gemm_phase<pg8::EpiDown, pg8::MoeOrder, true, false>(ring, MH, MH, MH, S, E, tid);
    }
    {
        pg8::StaticOrder S; S.init(PB, W_PI_T, NTOK, D, PLE, PLE, G, bx); S.lo = ple_early;
        pg8::EpiPleRaw E{PL, SS_PL};
        pg8::gemm_phase<pg8::EpiPleRaw, pg8::StaticOrder, true, false>(ring, PLE, PLE, PLE, S, E, tid);
    }
    GRID_SYNC();

    {
        for (int m = gw; m < NTOK; m += NGW) {
            const v2u* hb = (const v2u*)(XN + (size_t)m * D) + lane;
            const v2u* y0 = (const v2u*)(Y + (size_t)m * D) + lane; const v2u* y1 = (const v2u*)(Y + (size_t)NTOK * D + (size_t)m * D) + lane;
            v2u* o = (v2u*)(XN + (size_t)m * D) + lane;
            float s = 0.f, amax = 0.f; f32x4 vv[8];
#pragma unroll
            for (int j = 0; j < 8; ++j) { const v2u a = __builtin_nontemporal_load(y0 + 64 * j), c = __builtin_nontemporal_load(y1 + 64 * j), dd = __builtin_nontemporal_load(hb + 64 * j);
                f32x4 v; v.x = __uint_as_float(dd.x << 16); v.y = __uint_as_float(dd.x & 0xffff0000u); v.z = __uint_as_float(dd.y << 16); v.w = __uint_as_float(dd.y & 0xffff0000u);
                v.x += __uint_as_float(a.x << 16) + __uint_as_float(c.x << 16); v.y += __uint_as_float(a.x & 0xffff0000u) + __uint_as_float(c.x & 0xffff0000u);
                v.z += __uint_as_float(a.y << 16) + __uint_as_float(c.y << 16); v.w += __uint_as_float(a.y & 0xffff0000u) + __uint_as_float(c.y & 0xffff0000u);
                s += (v.x * v.x + v.y * v.y) + (v.z * v.z + v.w * v.w); amax = fmaxf(fmaxf(amax, fmaxf(fabsf(v.x), fabsf(v.y))), fmaxf(fabsf(v.z), fabsf(v.w))); vv[j] = v;
                v2u w; w.x = hg::cvtpk(v.x, v.y); w.y = hg::cvtpk(v.z, v.w); o[64 * j] = w; }
#pragma unroll
            for (int o2 = 1; o2 < 64; o2 <<= 1) amax = fmaxf(amax, shx(amax, o2, lane));
            { const float qs = amax > 0.f ? 127.f / amax : 0.f; unsigned* q = (unsigned*)(H2Q + (size_t)m * D) + lane;
#pragma unroll
                for (int j = 0; j < 8; ++j) q[64 * j] = ((unsigned)(int)rintf(vv[j].x * qs) & 0xffu) | (((unsigned)(int)rintf(vv[j].y * qs) & 0xffu) << 8) | (((unsigned)(int)rintf(vv[j].z * qs) & 0xffu) << 16) | ((unsigned)(int)rintf(vv[j].w * qs) << 24); }
            const float ssum = wave_sum(s, lane);
            const float sp = wave_sum(lane < 32 ? SS_PL[(size_t)m * 32 + lane] : 0.f, lane);
            if (lane == 0) { RSTD3[m] = rsqrtf(ssum * (1.f / D) + EPS) * amax * (1.f / 127.f); RSTDP[m] = rsqrtf(sp * (1.f / D) + EPS); }
        }
    }
    GRID_SYNC();

    {
        pg8::StaticOrder S; S.init((const bf16*)H2Q, W_PG_T, NTOK, D, D / 2, D / 2, G, bx);
        pg8::EpiPleGateQ E{H3B, PL, RSTD3, RSTDP, args.in[I_GPLE], (const float*)CMAX};
        pg8::gemm_phase<pg8::EpiPleGateQ, pg8::StaticOrder, true, false>(ring, D / 2, D / 2, D / 2, S, E, tid);
    }
    GRID_SYNC();

    {
        const float* gfin = args.in[I_GFIN];
        f32x4 gv[8];
#pragma unroll
        for (int j = 0; j < 8; ++j) gv[j] = *((const f32x4*)gfin + 64 * j + lane);
        for (int m = gw; m < NTOK; m += 2 * NGW) {
            const int m1 = (m + NGW < NTOK) ? m + NGW : m;
            f32x4* o0 = (f32x4*)(hbuf + (size_t)m * D) + lane; f32x4* o1 = (f32x4*)(hbuf + (size_t)m1 * D) + lane;
            const v2u* u0 = (const v2u*)(H3B + (size_t)m * D) + lane; const v2u* u1 = (const v2u*)(H3B + (size_t)m1 * D) + lane;
            const v2u* h0 = (const v2u*)(XN + (size_t)m * D) + lane; const v2u* h1 = (const v2u*)(XN + (size_t)m1 * D) + lane;
            v2u a0[8], a1[8], b0[8], b1[8];
#pragma unroll
            for (int j = 0; j < 8; ++j) { a0[j] = __builtin_nontemporal_load(u0 + 64 * j); a1[j] = __builtin_nontemporal_load(u1 + 64 * j); b0[j] = __builtin_nontemporal_load(h0 + 64 * j); b1[j] = __builtin_nontemporal_load(h1 + 64 * j); }
            f32x4 y0[8], y1[8]; float s0 = 0.f, s1 = 0.f;
#pragma unroll
            for (int j = 0; j < 8; ++j) {
                y0[j].x = __uint_as_float(a0[j].x << 16) + __uint_as_float(b0[j].x << 16); y0[j].y = __uint_as_float(a0[j].x & 0xffff0000u) + __uint_as_float(b0[j].x & 0xffff0000u);
                y0[j].z = __uint_as_float(a0[j].y << 16) + __uint_as_float(b0[j].y << 16); y0[j].w = __uint_as_float(a0[j].y & 0xffff0000u) + __uint_as_float(b0[j].y & 0xffff0000u);
                y1[j].x = __uint_as_float(a1[j].x << 16) + __uint_as_float(b1[j].x << 16); y1[j].y = __uint_as_float(a1[j].x & 0xffff0000u) + __uint_as_float(b1[j].x & 0xffff0000u);
                y1[j].z = __uint_as_float(a1[j].y << 16) + __uint_as_float(b1[j].y << 16); y1[j].w = __uint_as_float(a1[j].y & 0xffff0000u) + __uint_as_float(b1[j].y & 0xffff0000u);
                s0 += (y0[j].x * y0[j].x + y0[j].y * y0[j].y) + (y0[j].z * y0[j].z + y0[j].w * y0[j].w); s1 += (y1[j].x * y1[j].x + y1[j].y * y1[j].y) + (y1[j].z * y1[j].z + y1[j].w * y1[j].w); }
            const float r0 = rsqrtf(wave_sum(s0, lane) * (1.f / D) + EPS), r1 = rsqrtf(wave_sum(s1, lane) * (1.f / D) + EPS);
#pragma unroll
            for (int j = 0; j < 8; ++j) { __builtin_nontemporal_store(y0[j] * r0 * gv[j], o0 + 64 * j); __builtin_nontemporal_store(y1[j] * r1 * gv[j], o1 + 64 * j); }
        }
    }
}

extern "C" void kernel_launch(void* const* d_in, const int* in_sizes, int n_in, void* d_out, int out_size, void* d_ws, size_t ws_size, hipStream_t stream) {
    static int grid = 0;
    if (grid == 0) {
        if (n_in != 24 || out_size != NTOK * D || ws_size < WS_END) { fprintf(stderr, "kernel_launch: unexpected shapes (n_in %d, out %d, ws %zu)\n", n_in, out_size, ws_size); grid = -1; return; }
        int dev = 0, cus = 0;
        if (hipGetDevice(&dev) != hipSuccess || hipDeviceGetAttribute(&cus, hipDeviceAttributeMultiprocessorCount, dev) != hipSuccess) { grid = -1; return; }
        if (hipFuncSetAttribute((const void*)fwd_kernel, hipFuncAttributeMaxDynamicSharedMemorySize, LDS_BYTES) != hipSuccess) { fprintf(stderr, "kernel_launch: hipFuncSetAttribute failed\n"); grid = -1; return; }
        int per_cu = 0;
        if (hipOccupancyMaxActiveBlocksPerMultiprocessor(&per_cu, (const void*)fwd_kernel, NTHR, LDS_BYTES) != hipSuccess || per_cu < 1) { fprintf(stderr, "kernel_launch: occupancy query says %d\n", per_cu); }
        (void)hipGetLastError();
        grid = cus;
    }
    if (grid < 0) return;
    if (hipMemsetAsync((char*)d_ws + WS_CTL, 0, CTL_ZERO_BYTES, stream) != hipSuccess) return;
    Args a{};
    for (int i = 0; i < 24; ++i) a.in[i] = (const float*)d_in[i];
    a.out = (float*)d_out; a.ws = (unsigned char*)d_ws;
    hipLaunchKernelGGL(fwd_kernel, dim3(grid), dim3(NTHR), LDS_BYTES, stream, a);
}
```
